# Optimizing an MI355X kernel written in HIP

```python
import math
import jax, jax.numpy as jnp
from jax import lax
import numpy as np

D_MODEL = 1024
BATCH = 1
SEQ = 16384
DEPTH = 2

GRID_W = 64
CTX_LEN = 256
EPS = 1e-6

HY_WIDTH = D_MODEL // 4
HY_COLS = 3 * HY_WIDTH
HY_SHORT = 3
HY_FILTER_HIDDEN = 64
HY_POS_BANDS = 16
HY_POS_DIM = 1 + 2 * HY_POS_BANDS
HY_DECAY_TARGET = 1e-2
HY_SHORT_DECAY_PCT = 0.3
HY_LONG_DECAY_PCT = 1.5

RET_HEAD_DIM = 64
RET_HEADS = (D_MODEL // 4) // RET_HEAD_DIM
RET_WIDTH = RET_HEADS * RET_HEAD_DIM
RET_COLS = 4 * RET_WIDTH
RET_CHUNK = 128

ATT_HEAD_DIM = 64
ATT_HEADS = (D_MODEL // 2) // ATT_HEAD_DIM
ATT_KV_HEADS = ATT_HEADS // 4
ATT_WIDTH = ATT_HEADS * ATT_HEAD_DIM
ATT_KV_WIDTH = ATT_KV_HEADS * ATT_HEAD_DIM
Q_BLOCK = 128
ROPE_AXIS_DIM = ATT_HEAD_DIM // 2
ROPE_BASE = 10000.0

MIX_WIDTH = HY_WIDTH + RET_WIDTH + ATT_WIDTH
IN_COLS = HY_COLS + RET_COLS + ATT_WIDTH + 2 * ATT_KV_WIDTH

FFN_HIDDEN = ((8 * D_MODEL // 3 + 255) // 256) * 256
N_EXPERTS = 8
TOP_K = 2
EXPERT_HIDDEN = FFN_HIDDEN
MOE_BLOCK = 512
N_DENSE = (DEPTH + 1) // 2
N_MOE = DEPTH // 2

kernel_name = 'hybrid_hyena_retention_gqa_moe_dit'


def rms_norm(x, g):
    x32 = x.astype(jnp.float32)
    y = x32 * lax.rsqrt(jnp.mean(x32 * x32, axis=-1, keepdims=True) + EPS)
    return (y * g.astype(jnp.float32)).astype(x.dtype)


def modulate(h, shift, scale):
    return h * (1 + scale) + shift


def ada_modulation(cvec, w, b):
    m = jax.nn.silu(cvec) @ w + b
    return m.reshape(m.shape[:-1] + (6, D_MODEL))


def split_projection(p):
    return (p[..., :HY_COLS], p[..., HY_COLS:HY_COLS + RET_COLS], p[..., HY_COLS + RET_COLS:])


def short_conv3(u, w, b):
    up = jnp.pad(u, ((0, 0), (1, 1), (0, 0)))
    return up[:, :-2] * w[0] + up[:, 1:-1] * w[1] + up[:, 2:] * w[2] + b


def hyena_two_sided_filter(L, w1, b1, w2, b2, w3, b3, freq):
    n = jnp.arange(L, dtype=jnp.float32)
    t = n / max(L - 1, 1)
    bands = jnp.linspace(1e-4, HY_POS_BANDS - 1, HY_POS_BANDS, dtype=jnp.float32)
    ang = (2.0 * math.pi / L) * n[:, None] * bands[None, :]
    feat = jnp.concatenate([t[:, None], jnp.cos(ang), -jnp.sin(ang)], axis=-1)
    h = jnp.sin(freq * (feat @ w1 + b1))
    h = jnp.sin(freq * (h @ w2 + b2))
    h = (h @ w3 + b3).astype(jnp.float32).reshape(L, 2, HY_WIDTH)
    deltas = jnp.abs(jnp.linspace(math.log(HY_DECAY_TARGET) / HY_LONG_DECAY_PCT,
                                  math.log(HY_DECAY_TARGET) / HY_SHORT_DECAY_PCT,
                                  HY_WIDTH, dtype=jnp.float32))
    h = h * jnp.exp(-t[:, None] * deltas[None, :])[:, None, :]
    h_fwd, h_bwd = h[:, 0], h[:, 1]
    taps = jnp.concatenate([h_fwd, jnp.zeros((1, HY_WIDTH), jnp.float32), h_bwd[:0:-1]], axis=0)
    return taps / (jnp.sum(jnp.abs(taps), axis=0, keepdims=True) + EPS)


def hyena_mixer(p_hy, conv_w, conv_b, filt, bias):
    u = short_conv3(p_hy, conv_w, conv_b)
    x0, x1, v = jnp.split(u, 3, axis=-1)
    z = (x1 * v).astype(jnp.float32)
    L = z.shape[1]
    taps = hyena_two_sided_filter(L, *filt)
    zf = jnp.fft.rfft(z, n=2 * L, axis=1)
    tf = jnp.fft.rfft(taps, axis=0)
    conv = jnp.fft.irfft(zf * tf[None], n=2 * L, axis=1)[:, :L]
    y = x0.astype(jnp.float32) * (conv + bias.astype(jnp.float32) * z)
    return y.astype(p_hy.dtype)


def retention_heads(p_ret):
    B, L, _ = p_ret.shape
    q, k, v, g = jnp.split(p_ret, 4, axis=-1)

    def heads(t):
        return t.reshape(B, L, RET_HEADS, RET_HEAD_DIM).transpose(0, 2, 1, 3).astype(jnp.float32)
    return heads(q), heads(k) * RET_HEAD_DIM ** -0.5, heads(v), g


def retention_final_state(k, v, log_gamma):
    L = k.shape[2]
    w = jnp.exp(log_gamma[:, None] * (L - 1 - jnp.arange(L, dtype=jnp.float32))[None, :])
    return jnp.einsum('bhmd,hm,bhme->bhde', k, w, v)


def retention_chunkwise(q, k, v, log_gamma, s0):
    B, H, L, dk = q.shape
    dv = v.shape[-1]
    nc = L // RET_CHUNK
    qc = q.reshape(B, H, nc, RET_CHUNK, dk)
    kc = k.reshape(B, H, nc, RET_CHUNK, dk)
    vc = v.reshape(B, H, nc, RET_CHUNK, dv)
    pos = jnp.arange(RET_CHUNK, dtype=jnp.float32)
    lg = log_gamma[:, None]
    rel = pos[:, None] - pos[None, :]
    decay_mask = jnp.where(rel >= 0, jnp.exp(lg[:, :, None] * jnp.maximum(rel, 0.0)), 0.0)
    scores = jnp.einsum('bhcnd,bhcmd->bhcnm', qc, kc) * decay_mask[None, :, None]
    inner = jnp.einsum('bhcnm,bhcme->bhcne', scores, vc)
    zeta = jnp.exp(lg * (RET_CHUNK - 1 - pos)[None, :])
    xi = jnp.exp(lg * (pos + 1)[None, :])
    u = jnp.einsum('bhcmd,hm,bhcme->bhcde', kc, zeta, vc)
    chunk_decay = jnp.exp(log_gamma * RET_CHUNK)[None, :, None, None]

    def step(s, u_c):
        return chunk_decay * s + u_c, s
    s_final, s_prev = lax.scan(step, s0.astype(jnp.float32), jnp.moveaxis(u, 2, 0))
    cross = jnp.einsum('bhcnd,hn,bhcde->bhcne', qc, xi, jnp.moveaxis(s_prev, 0, 2))
    return (inner + cross).reshape(B, H, L, dv), s_final


def head_layer_norm(y):
    mu = jnp.mean(y, axis=-1, keepdims=True)
    var = jnp.mean(jnp.square(y - mu), axis=-1, keepdims=True)
    return (y - mu) * lax.rsqrt(var + EPS)


def bidirectional_retention(q, k, v, g, lg_f, lg_b, s_f, s_b):
    out_f, _ = retention_chunkwise(q, k, v, lg_f, s_f)
    out_b, _ = retention_chunkwise(jnp.flip(q, 2), jnp.flip(k, 2), jnp.flip(v, 2), lg_b, s_b)
    y = head_layer_norm(out_f + jnp.flip(out_b, 2))
    B, H, L, d = y.shape
    y = y.transpose(0, 2, 1, 3).reshape(B, L, H * d)
    return (jax.nn.silu(g.astype(jnp.float32)) * y).astype(g.dtype)


def rope_tables_2d(n_tokens):
    rows = n_tokens // GRID_W
    row_idx = jnp.repeat(jnp.arange(rows, dtype=jnp.float32), GRID_W)
    col_idx = jnp.tile(jnp.arange(GRID_W, dtype=jnp.float32), rows)
    inv_freq = ROPE_BASE ** (-jnp.arange(0, ROPE_AXIS_DIM, 2, dtype=jnp.float32) / ROPE_AXIS_DIM)
    ang_r = row_idx[:, None] * inv_freq[None, :]
    ang_c = col_idx[:, None] * inv_freq[None, :]
    return (jnp.cos(ang_r), jnp.sin(ang_r), jnp.cos(ang_c), jnp.sin(ang_c))


def apply_rope_2d(x, tables):
    cos_r, sin_r, cos_c, sin_c = tables

    def rotate(xp, cos, sin):
        half = xp.shape[-1] // 2
        x1, x2 = xp[..., :half], xp[..., half:]
        cos = cos[None, :, None, :]
        sin = sin[None, :, None, :]
        return jnp.concatenate([x1 * cos - x2 * sin, x2 * cos + x1 * sin], axis=-1)
    out = jnp.concatenate([rotate(x[..., :ROPE_AXIS_DIM], cos_r, sin_r),
                           rotate(x[..., ROPE_AXIS_DIM:], cos_c, sin_c)], axis=-1)
    return out.astype(x.dtype)


def attention_heads(p_att, q_g, k_g):
    B, L, _ = p_att.shape
    q = p_att[..., :ATT_WIDTH].reshape(B, L, ATT_HEADS, ATT_HEAD_DIM)
    k = p_att[..., ATT_WIDTH:ATT_WIDTH + ATT_KV_WIDTH].reshape(B, L, ATT_KV_HEADS, ATT_HEAD_DIM)
    v = p_att[..., ATT_WIDTH + ATT_KV_WIDTH:].reshape(B, L, ATT_KV_HEADS, ATT_HEAD_DIM)
    return rms_norm(q, q_g), rms_norm(k, k_g), v


def block_attention(q, k, v):
    B, Lq, H, d = q.shape
    Hkv = k.shape[2]
    G = H // Hkv
    nb = Lq // Q_BLOCK
    qb = q.reshape(B, nb, Q_BLOCK, Hkv, G, d).transpose(1, 0, 2, 3, 4, 5)
    scale = d ** -0.5

    def one_block(q_blk):
        s = jnp.einsum('bqhgd,bkhd->bhgqk', q_blk, k).astype(jnp.float32) * scale
        p = jax.nn.softmax(s, axis=-1).astype(v.dtype)
        return jnp.einsum('bhgqk,bkhd->bqhgd', p, v)
    o = lax.map(one_block, qb)
    return o.transpose(1, 0, 2, 3, 4, 5).reshape(B, Lq, H * d)


def swiglu(x, w_gate, w_up, w_down):
    return (jax.nn.silu(x @ w_gate) * (x @ w_up)) @ w_down


def moe_swiglu(x, router_w, router_b, w_gate, w_up, w_down):
    B, L, D = x.shape
    n_tok = B * L
    n_asg = n_tok * TOP_K
    xt = x.reshape(n_tok, D)
    logits = (xt @ router_w + router_b).astype(jnp.float32)
    top_val, top_idx = lax.top_k(logits, TOP_K)
    gates = jax.nn.softmax(top_val, axis=-1)
    expert = top_idx.reshape(-1).astype(jnp.int32)
    token = jnp.repeat(jnp.arange(n_tok, dtype=jnp.int32), TOP_K)
    order = jnp.argsort(expert)
    e_s = expert[order]
    t_s = token[order]
    g_s = gates.reshape(-1)[order]
    counts = jnp.bincount(expert, length=N_EXPERTS)
    starts = jnp.cumsum(counts) - counts
    padded = (counts + MOE_BLOCK - 1) // MOE_BLOCK * MOE_BLOCK
    pad_end = jnp.cumsum(padded)
    pad_start = pad_end - padded
    dest = pad_start[e_s] + jnp.arange(n_asg, dtype=jnp.int32) - starts[e_s]
    cap = -(-n_asg // MOE_BLOCK) * MOE_BLOCK + N_EXPERTS * MOE_BLOCK
    n_blk = cap // MOE_BLOCK
    buf = jnp.zeros((cap, D), x.dtype).at[dest].set(xt[t_s])
    blk_start = jnp.arange(n_blk, dtype=pad_end.dtype) * MOE_BLOCK
    blk_expert = jnp.minimum(jnp.searchsorted(pad_end, blk_start, side='right'), N_EXPERTS - 1)

    def expert_block(args):
        xb, e = args
        return swiglu(xb, w_gate[e], w_up[e], w_down[e])
    yb = lax.map(expert_block, (buf.reshape(n_blk, MOE_BLOCK, D), blk_expert))
    y_asg = yb.reshape(cap, D)[dest] * g_s[:, None].astype(yb.dtype)
    out = jnp.zeros((n_tok, D), y_asg.dtype).at[t_s].add(y_asg)
    return out.reshape(B, L, D)


def channel_mixer(h, l, ffn_w_gate, ffn_w_up, ffn_w_down,
                  moe_router_w, moe_router_b, moe_w_gate, moe_w_up, moe_w_down):
    i = l // 2
    if l % 2 == 0:
        return swiglu(h, ffn_w_gate[i], ffn_w_up[i], ffn_w_down[i])
    return moe_swiglu(h, moe_router_w[i], moe_router_b[i], moe_w_gate[i], moe_w_up[i], moe_w_down[i])


def setup_inputs(seed: int = 0) -> dict:
    key = jax.random.key(seed)
    keys = iter(jax.random.split(key, 40))

    def nrm(shape, scale):
        return jax.random.normal(next(keys), shape, jnp.float32) * scale
    D = D_MODEL
    h_idx = jnp.arange(RET_HEADS, dtype=jnp.float32)
    rate_base = jnp.stack([-(5.0 + h_idx), -(5.5 + h_idx)]) * math.log(2.0)
    return {
        'x': nrm((BATCH, SEQ, D), 1.0),
        'c': nrm((BATCH, D), 1.0),
        'ctx': nrm((BATCH, CTX_LEN, D), 1.0),
        'c_ctx': nrm((D,), 1.0),
        'ada_w': nrm((DEPTH, D, 6 * D), 0.5 * D ** -0.5),
        'ada_b': nrm((DEPTH, 6 * D), 0.02),
        'norm1_g': 1.0 + nrm((DEPTH, D), 0.02),
        'norm2_g': 1.0 + nrm((DEPTH, D), 0.02),
        'w_in': nrm((DEPTH, D, IN_COLS), D ** -0.5),
        'w_out': nrm((DEPTH, MIX_WIDTH, D), MIX_WIDTH ** -0.5),
        'hy_conv_w': nrm((DEPTH, HY_SHORT, HY_COLS), HY_SHORT ** -0.5),
        'hy_conv_b': nrm((DEPTH, HY_COLS), 0.02),
        'hy_filt_w1': nrm((DEPTH, HY_POS_DIM, HY_FILTER_HIDDEN), HY_POS_DIM ** -0.5),
        'hy_filt_b1': nrm((DEPTH, HY_FILTER_HIDDEN), 0.1),
        'hy_filt_w2': nrm((DEPTH, HY_FILTER_HIDDEN, HY_FILTER_HIDDEN), HY_FILTER_HIDDEN ** -0.5),
        'hy_filt_b2': nrm((DEPTH, HY_FILTER_HIDDEN), 0.1),
        'hy_filt_w3': nrm((DEPTH, HY_FILTER_HIDDEN, 2 * HY_WIDTH), HY_FILTER_HIDDEN ** -0.5),
        'hy_filt_b3': nrm((DEPTH, 2 * HY_WIDTH), 0.02),
        'hy_filt_freq': 1.0 + nrm((DEPTH, HY_FILTER_HIDDEN), 0.05),
        'hy_bias': nrm((DEPTH, HY_WIDTH), 0.3),
        'ret_log_rate': rate_base[None] + nrm((DEPTH, 2, RET_HEADS), 0.05),
        'attn_q_g': 1.0 + nrm((DEPTH, ATT_HEAD_DIM), 0.02),
        'attn_k_g': 1.0 + nrm((DEPTH, ATT_HEAD_DIM), 0.02),
        'ffn_w_gate': nrm((N_DENSE, D, FFN_HIDDEN), D ** -0.5),
        'ffn_w_up': nrm((N_DENSE, D, FFN_HIDDEN), D ** -0.5),
        'ffn_w_down': nrm((N_DENSE, FFN_HIDDEN, D), FFN_HIDDEN ** -0.5),
        'moe_router_w': nrm((N_MOE, D, N_EXPERTS), D ** -0.5),
        'moe_router_b': nrm((N_MOE, N_EXPERTS), 0.01),
        'moe_w_gate': nrm((N_MOE, N_EXPERTS, D, EXPERT_HIDDEN), D ** -0.5),
        'moe_w_up': nrm((N_MOE, N_EXPERTS, D, EXPERT_HIDDEN), D ** -0.5),
        'moe_w_down': nrm((N_MOE, N_EXPERTS, EXPERT_HIDDEN, D), EXPERT_HIDDEN ** -0.5),
        'final_norm_g': 1.0 + nrm((D,), 0.02),
    }


def reference(x, c, ctx, c_ctx, ada_w, ada_b, norm1_g, norm2_g, w_in, w_out,
              hy_conv_w, hy_conv_b, hy_filt_w1, hy_filt_b1, hy_filt_w2, hy_filt_b2,
              hy_filt_w3, hy_filt_b3, hy_filt_freq, hy_bias, ret_log_rate,
              attn_q_g, attn_k_g, ffn_w_gate, ffn_w_up, ffn_w_down,
              moe_router_w, moe_router_b, moe_w_gate, moe_w_up, moe_w_down, final_norm_g):
    rope = rope_tables_2d(x.shape[1])
    x_lat, x_ctx = x, ctx
    for l in range(DEPTH):
        last = l == DEPTH - 1
        mod = ada_modulation(c, ada_w[l], ada_b[l])[:, :, None, :]
        mod_c = ada_modulation(c_ctx, ada_w[l], ada_b[l])
        filt = (hy_filt_w1[l], hy_filt_b1[l], hy_filt_w2[l], hy_filt_b2[l],
                hy_filt_w3[l], hy_filt_b3[l], hy_filt_freq[l])
        lg_f = -jnp.exp(ret_log_rate[l, 0].astype(jnp.float32))
        lg_b = -jnp.exp(ret_log_rate[l, 1].astype(jnp.float32))

        h = modulate(rms_norm(x_lat, norm1_g[l]), mod[:, 0], mod[:, 1])
        hc = modulate(rms_norm(x_ctx, norm1_g[l]), mod_c[0], mod_c[1])
        p_hy, p_ret, p_att = split_projection(h @ w_in[l])
        pc_hy, pc_ret, pc_att = split_projection(hc @ w_in[l])

        qc_r, kc_r, vc_r, gc_r = retention_heads(pc_ret)
        s_fwd = retention_final_state(kc_r, vc_r, lg_f)
        s_bwd = retention_final_state(jnp.flip(kc_r, 2), jnp.flip(vc_r, 2), lg_b)
        qc_a, kc_a, vc_a = attention_heads(pc_att, attn_q_g[l], attn_k_g[l])

        y_hy = hyena_mixer(p_hy, hy_conv_w[l], hy_conv_b[l], filt, hy_bias[l])
        q_r, k_r, v_r, g_r = retention_heads(p_ret)
        y_ret = bidirectional_retention(q_r, k_r, v_r, g_r, lg_f, lg_b, s_fwd, s_bwd)
        q_a, k_a, v_a = attention_heads(p_att, attn_q_g[l], attn_k_g[l])
        y_att = block_attention(apply_rope_2d(q_a, rope),
                                jnp.concatenate([kc_a, apply_rope_2d(k_a, rope)], axis=1),
                                jnp.concatenate([vc_a, v_a], axis=1))
        y = jnp.concatenate([y_hy, y_ret, y_att], axis=-1) @ w_out[l]

        if not last:
            zero_state = jnp.zeros_like(s_fwd)
            yc_hy = hyena_mixer(pc_hy, hy_conv_w[l], hy_conv_b[l], filt, hy_bias[l])
            yc_ret = bidirectional_retention(qc_r, kc_r, vc_r, gc_r, lg_f, lg_b, zero_state, zero_state)
            yc_att = block_attention(qc_a, kc_a, vc_a)
            yc = jnp.concatenate([yc_hy, yc_ret, yc_att], axis=-1) @ w_out[l]
            x_ctx = x_ctx + mod_c[2] * yc
        x_lat = x_lat + mod[:, 2] * y

        h2 = modulate(rms_norm(x_lat, norm2_g[l]), mod[:, 3], mod[:, 4])
        x_lat = x_lat + mod[:, 5] * channel_mixer(h2, l, ffn_w_gate, ffn_w_up, ffn_w_down,
                                                  moe_router_w, moe_router_b, moe_w_gate, moe_w_up, moe_w_down)
        if not last:
            hc2 = modulate(rms_norm(x_ctx, norm2_g[l]), mod_c[3], mod_c[4])
            x_ctx = x_ctx + mod_c[5] * channel_mixer(hc2, l, ffn_w_gate, ffn_w_up, ffn_w_down,
                                                     moe_router_w, moe_router_b, moe_w_gate, moe_w_up, moe_w_down)
    return rms_norm(x_lat, final_norm_g)
```

```cpp
#include <hip/hip_runtime.h>
#include <cstdio>
#include <cstdint>
#include <cstring>

typedef unsigned short bf16;
typedef unsigned u32x4 __attribute__((ext_vector_type(4)));
typedef unsigned u32x2 __attribute__((ext_vector_type(2)));
typedef float f32x4 __attribute__((ext_vector_type(4)));
typedef float f32x2 __attribute__((ext_vector_type(2)));

#ifndef N_LAUNCH_MODE
#define N_LAUNCH_MODE 0
#endif

constexpr int D = 1024, SEQ = 16384, CTXL = 256, R = SEQ + CTXL;
constexpr int INC = 2560, FF = 2816, NE = 8;
constexpr int C_HX0 = 0, C_HX1 = 256, C_HV = 512, C_RQ = 768, C_RK = 1024, C_RV = 1280, C_RG = 1536, C_AQ = 1792, C_AK = 2304, C_AV = 2432;
constexpr int FN = 32768, FM = 16384;
constexpr int NCH = 130;
constexpr float EPS = 1e-6f;
constexpr float C2 = 0.125f * 1.4426950408889634f;
constexpr int NT = 512;
constexpr int MOE_MAXROWS = 34560;

constexpr size_t MiB = 1u << 20;
constexpr size_t WS_CTL = 0, CTL_BYTES = MiB;
constexpr size_t WS_MOD = 1 * MiB;
constexpr size_t WS_TW = 1 * MiB + 128 * 1024;
constexpr size_t WS_TWN = 1 * MiB + 256 * 1024;
constexpr size_t WS_XC = 2 * MiB;
constexpr size_t WS_ASGT = 3 * MiB;
constexpr size_t WS_ASGG = 3 * MiB + 512 * 1024;
constexpr size_t WS_ROWD = 4 * MiB;
constexpr size_t WS_ROWG = 4 * MiB + 256 * 1024;
constexpr size_t WS_TAPSC = 5 * MiB;
constexpr size_t WS_ZC = 5 * MiB + 512 * 1024;
constexpr size_t WS_HSPEC = 8 * MiB;
constexpr size_t WS_ZT = 72 * MiB;
constexpr size_t WS_RU = 88 * MiB;
constexpr size_t WS_WIN = 105 * MiB;
constexpr size_t WS_WOUT = 115 * MiB;
constexpr size_t WS_WGU = 119 * MiB;
constexpr size_t WS_WDN = 130 * MiB;
constexpr size_t WS_H = 136 * MiB;
constexpr size_t WS_P = 169 * MiB;
constexpr size_t WS_YMIX = 251 * MiB;
constexpr size_t WS_HID = 169 * MiB;
constexpr size_t WS_MOEW = 306 * MiB;
constexpr size_t WS_XS = 8 * MiB;
constexpr size_t WS_Y2 = 8 * MiB;
constexpr size_t WS_HIDM = 105 * MiB;
constexpr size_t WS_END = 438 * MiB;
constexpr size_t MOEW_E = (size_t)(5632 * 1024 + 1024 * 2816);
static_assert(WS_HIDM + (size_t)MOE_MAXROWS * FF * 2 <= WS_MOEW, "map");
static_assert(WS_XS + (size_t)MOE_MAXROWS * D * 2 <= WS_HIDM, "map");
static_assert(WS_MOEW + 8 * MOEW_E * 2 <= WS_END, "map");

constexpr int CW_CNT = 64;
constexpr int CW_BAR = 4096;

struct Params { const float* in[32]; float* out; unsigned char* ws; int ph_lo, ph_hi; };

__device__ __forceinline__ float bf2f(bf16 v) { return __uint_as_float((unsigned)v << 16); }
__device__ __forceinline__ unsigned f2bf(float f) { unsigned u = __float_as_uint(f); return (u + 0x7fffu + ((u >> 16) & 1u)) >> 16; }
__device__ __forceinline__ unsigned pk2(float lo, float hi) { return f2bf(lo) | (f2bf(hi) << 16); }
__device__ __forceinline__ float lo16(unsigned w) { return __uint_as_float(w << 16); }
__device__ __forceinline__ float hi16(unsigned w) { return __uint_as_float(w & 0xffff0000u); }
__device__ __forceinline__ float wave_sum(float v) {
#pragma unroll
    for (int o = 1; o < 64; o <<= 1) v += __shfl_xor(v, o);
    return v;
}
__device__ __forceinline__ float silu_f(float x) { return x / (1.f + __expf(-x)); }
__device__ __forceinline__ const float* xsrc_row(const Params& p, bool first, int row) {
    if (first) return row < SEQ ? p.in[0] + (size_t)row * D : p.in[2] + (size_t)(row - SEQ) * D;
    return row < SEQ ? p.out + (size_t)row * D : (const float*)(p.ws + WS_XC) + (size_t)(row - SEQ) * D;
}
__device__ __forceinline__ float* xdst_row(const Params& p, int row) {
    return row < SEQ ? p.out + (size_t)row * D : (float*)(p.ws + WS_XC) + (size_t)(row - SEQ) * D;
}
__device__ __forceinline__ const float* mod_vec(const Params& p, int l, int row, int j) {
    return (const float*)(p.ws + WS_MOD) + (size_t)((l * 2 + (row >= SEQ ? 1 : 0)) * 6 + j) * D;
}

__device__ __forceinline__ void ph_mod(const Params& p, float* sm, int bid, int nb) {
    const float* c = p.in[1]; const float* cc = p.in[3]; const float* W = p.in[4]; const float* B = p.in[5];
    float* MOD = (float*)(p.ws + WS_MOD);
    float* sc = sm; float* scc = sm + 1024; float* red = sm + 2048;
    const int tid = threadIdx.x;
    for (int i = tid; i < 1024; i += NT) { sc[i] = silu_f(c[i]); scc[i] = silu_f(cc[i]); }
    __syncthreads();
    for (int it = bid; it < 192; it += nb) {
        const int l = it / 96, cl = tid & 63, col = (it % 96) * 64 + cl, kg = tid >> 6;
        const float* w = W + (size_t)l * 1024 * 6144 + col;
        float a0 = 0.f, a1 = 0.f;
#pragma unroll 8
        for (int k = kg * 128; k < kg * 128 + 128; ++k) { const float wv = w[(size_t)k * 6144]; a0 += sc[k] * wv; a1 += scc[k] * wv; }
        red[(kg * 64 + cl) * 2] = a0; red[(kg * 64 + cl) * 2 + 1] = a1;
        __syncthreads();
        if (tid < 128) { const int c2 = tid & 63, s = tid >> 6; float sum = 0.f;
            for (int g = 0; g < 8; ++g) sum += red[(g * 64 + c2) * 2 + s];
            const int colg = (it % 96) * 64 + c2; MOD[(size_t)(l * 2 + s) * 6144 + colg] = sum + B[l * 6144 + colg]; }
        __syncthreads();
    }
}
__device__ __forceinline__ void ph_tw(const Params& p, int bid, int nb) {
    f32x2* TW = (f32x2*)(p.ws + WS_TW); f32x2* TWN = (f32x2*)(p.ws + WS_TWN);
    for (int k = bid * NT + threadIdx.x; k <= FM / 2; k += nb * NT) {
        float s, c;
        if (k < FM / 2) { const float x = (float)k * (2.0f / FM); s = sinpif(x); c = cospif(x); TW[k] = (f32x2){c, -s}; }
        { const float x = (float)k * (2.0f / FN); s = sinpif(x); c = cospif(x); TWN[k] = (f32x2){c, -s}; }
    }
}
__device__ __forceinline__ void transpose_item(const float* W, int K, int N, bf16* WT, int drow0, int k0, int n0, float* scr, int lane) {
#pragma unroll 8
    for (int i = 0; i < 32; ++i) { const int kk = 2 * i + (lane >> 5); scr[kk * 33 + (lane & 31)] = W[(size_t)(k0 + kk) * N + n0 + (lane & 31)]; }
    asm volatile("s_waitcnt vmcnt(0) lgkmcnt(0)" ::: "memory");
    const int c = lane & 7;
#pragma unroll
    for (int j = 0; j < 4; ++j) { const int n = (lane >> 3) + 8 * j; const float* s = scr + (8 * c) * 33 + n;
        u32x4 o; o.x = pk2(s[0 * 33], s[1 * 33]); o.y = pk2(s[2 * 33], s[3 * 33]); o.z = pk2(s[4 * 33], s[5 * 33]); o.w = pk2(s[6 * 33], s[7 * 33]);
        *(u32x4*)(WT + (size_t)(drow0 + n) * K + k0 + 8 * c) = o; }
    asm volatile("s_waitcnt lgkmcnt(0)" ::: "memory");
}
__device__ __forceinline__ int gu_row(int n, int up) { return (n >> 7) * 256 + (n & 127) + (up ? 128 : 0); }
__device__ __forceinline__ void ph_wconv(const Params& p, float* sm, int bid, int nb) {
    const int lane = threadIdx.x & 63, wave = threadIdx.x >> 6;
    float* scr = sm + wave * (64 * 33);
    const int gw = bid * 8 + wave, NGW = nb * 8;
    constexpr int I_IN = 16 * 80, I_OUT = 16 * 32, I_GU = 16 * 88, I_DN = 44 * 32;
    constexpr int PER_FFN = 3 * I_GU;
    static_assert(I_DN == I_GU, "");
    constexpr int NITEMS = 2 * I_IN + 2 * I_OUT + 9 * PER_FFN;
    for (int it = gw; it < NITEMS; it += NGW) {
        int r = it;
        if (r < 2 * I_IN) { const int l = r / I_IN; r %= I_IN; const int kb = r / 80, nb2 = r % 80;
            transpose_item(p.in[8] + (size_t)l * D * INC, D, INC, (bf16*)(p.ws + WS_WIN) + (size_t)l * INC * D, nb2 * 32, kb * 64, nb2 * 32, scr, lane); continue; }
        r -= 2 * I_IN;
        if (r < 2 * I_OUT) { const int l = r / I_OUT; r %= I_OUT; const int kb = r / 32, nb2 = r % 32;
            transpose_item(p.in[9] + (size_t)l * D * D, D, D, (bf16*)(p.ws + WS_WOUT) + (size_t)l * D * D, nb2 * 32, kb * 64, nb2 * 32, scr, lane); continue; }
        r -= 2 * I_OUT;
        const int f = r / PER_FFN; r %= PER_FFN;
        const int which = r / I_GU; r %= I_GU;
        const float* src; bf16* dgu; bf16* ddn;
        if (f == 0) { src = p.in[23 + which]; dgu = (bf16*)(p.ws + WS_WGU); ddn = (bf16*)(p.ws + WS_WDN); }
        else { src = p.in[28 + which] + (size_t)(f - 1) * D * FF; dgu = (bf16*)(p.ws + WS_MOEW) + (size_t)(f - 1) * MOEW_E; ddn = dgu + (size_t)5632 * 1024; }
        if (which < 2) { const int kb = r / 88, nb2 = r % 88; transpose_item(src, D, FF, dgu, gu_row(nb2 * 32, which), kb * 64, nb2 * 32, scr, lane); }
        else { const int kb = r / 32, nb2 = r % 32; transpose_item(src, FF, D, ddn, nb2 * 32, kb * 64, nb2 * 32, scr, lane); }
    }
}
__device__ __forceinline__ void ph_filt(const Params& p, float* sm, int bid, int nb) {
    const float dlo = -4.605170185988091f / 1.5f, dhi = -4.605170185988091f / 0.3f;
    float* col = sm + threadIdx.x;
    for (int it = bid; it < 260; it += nb) {
        int which, chunk, q;
        if (it < 256) { which = it >> 7; chunk = (it & 127) >> 2; q = it & 3; } else { which = 2; chunk = 0; q = it - 256; }
        const int l = (which == 2) ? 0 : which; const int Lf = (which == 2) ? CTXL : SEQ; const int NN = 2 * Lf;
        const int n = chunk * NT + threadIdx.x;
        if (n >= Lf) continue;
        float* taps = (which == 2) ? (float*)(p.ws + WS_TAPSC) : (float*)(p.ws + WS_HSPEC) + (size_t)which * 256 * FN;
        const float* w1 = p.in[12] + l * 33 * 64; const float* b1 = p.in[13] + l * 64; const float* w2 = p.in[14] + l * 4096; const float* b2 = p.in[15] + l * 64;
        const float* w3 = p.in[16] + l * 64 * 512; const float* b3 = p.in[17] + l * 512; const float* fr = p.in[18] + l * 64;
        const float t = (float)n / (float)(Lf - 1);
        float feat[33]; feat[0] = t;
#pragma unroll
        for (int b = 0; b < 16; ++b) { const float band = 1e-4f + (float)b * ((15.f - 1e-4f) / 15.f);
            const float rev2 = (2.0f / (float)Lf) * (float)n * band; feat[1 + b] = cospif(rev2); feat[17 + b] = -sinpif(rev2); }
#pragma unroll 1
        for (int j = 0; j < 64; ++j) { float a = b1[j];
#pragma unroll
            for (int i = 0; i < 33; ++i) a += feat[i] * w1[i * 64 + j];
            col[j * NT] = sinpif(fr[j] * a * 0.3183098861837907f); }
        float acc[64];
#pragma unroll
        for (int j = 0; j < 64; ++j) acc[j] = b2[j];
#pragma unroll 1
        for (int i = 0; i < 64; ++i) { const float x = col[i * NT];
#pragma unroll
            for (int j = 0; j < 64; ++j) acc[j] += x * w2[i * 64 + j]; }
#pragma unroll
        for (int j = 0; j < 64; ++j) col[j * NT] = acc[j];
#pragma unroll 1
        for (int j = 0; j < 64; ++j) col[j * NT] = sinpif(fr[j] * col[j * NT] * 0.3183098861837907f);
#pragma unroll
        for (int j = 0; j < 64; ++j) acc[j] = col[j * NT];
#pragma unroll 1
        for (int j = q * 128; j < q * 128 + 128; ++j) { float a = b3[j];
#pragma unroll
            for (int i = 0; i < 64; ++i) a += acc[i] * w3[i * 512 + j];
            const int dir = j >> 8, ch = j & 255;
            const float delta = fabsf(dlo + (float)ch * ((dhi - dlo) / 255.f));
            a *= __expf(-t * delta);
            if (dir == 0) taps[(size_t)ch * NN + n] = a;
            else { if (n >= 1) taps[(size_t)ch * NN + NN - n] = a; else taps[(size_t)ch * NN + Lf] = 0.f; } }
    }
}

__device__ __forceinline__ int brev14(int k) { return (int)(__brev((unsigned)k) >> 18); }
__device__ __forceinline__ void fft_dif(f32x2* buf, const f32x2* TW) {
    for (int half = FM / 2; half >= 1; half >>= 1) {
        const int tws = (FM / 2) / half;
        for (int j = threadIdx.x; j < FM / 2; j += NT) { const int pos = j & (half - 1), i0 = ((j - pos) << 1) + pos, i1 = i0 + half;
            const f32x2 u = buf[i0], v = buf[i1], w = TW[pos * tws]; const f32x2 d = u - v;
            buf[i0] = u + v; buf[i1] = (f32x2){d.x * w.x - d.y * w.y, d.x * w.y + d.y * w.x}; }
        __syncthreads();
    }
}
__device__ __forceinline__ void fft_dit_inv(f32x2* buf, const f32x2* TW) {
    for (int half = 1; half <= FM / 2; half <<= 1) {
        const int tws = (FM / 2) / half;
        for (int j = threadIdx.x; j < FM / 2; j += NT) { const int pos = j & (half - 1), i0 = ((j - pos) << 1) + pos, i1 = i0 + half;
            const f32x2 u = buf[i0], b = buf[i1], w = TW[pos * tws];
            const f32x2 v = (f32x2){b.x * w.x + b.y * w.y, b.y * w.x - b.x * w.y};
            buf[i0] = u + v; buf[i1] = u - v; }
        __syncthreads();
    }
}
__device__ __forceinline__ void ph_hfft(const Params& p, float* sm, int bid, int nb) {
    f32x2* buf = (f32x2*)sm; float* red = sm + 2 * FM;
    const f32x2* TW = (const f32x2*)(p.ws + WS_TW); const f32x2* TWN = (const f32x2*)(p.ws + WS_TWN);
    const int tid = threadIdx.x;
    for (int u = bid; u < 512; u += nb) {
        f32x2* g = (f32x2*)((float*)(p.ws + WS_HSPEC) + (size_t)u * FN);
        float asum = 0.f;
        for (int n = tid; n < FM; n += NT) { const f32x2 v = g[n]; buf[n] = v; asum += fabsf(v.x) + fabsf(v.y); }
        asum = wave_sum(asum);
        if ((tid & 63) == 0) red[tid >> 6] = asum;
        __syncthreads();
        float tot = 0.f;
#pragma unroll
        for (int w = 0; w < 8; ++w) tot += red[w];
        const float sc = 0.5f / (tot + EPS);
        fft_dif(buf, TW);
        for (int k = tid; k <= FM / 2; k += NT) {
            if (k == 0) { const f32x2 a = buf[0]; g[0] = (f32x2){(a.x + a.y) * 2.f * sc, (a.x - a.y) * 2.f * sc}; continue; }
            const int kk = FM - k; const f32x2 a = buf[brev14(k)], b = buf[brev14(kk)], w = TWN[k];
            const f32x2 E = (f32x2){a.x + b.x, a.y - b.y}, O = (f32x2){a.y + b.y, b.x - a.x};
            const f32x2 T = (f32x2){w.x * O.x - w.y * O.y, w.x * O.y + w.y * O.x};
            g[k] = (f32x2){(E.x + T.x) * sc, (E.y + T.y) * sc};
            g[kk] = (f32x2){(E.x - T.x) * sc, -(E.y - T.y) * sc};
        }
        __syncthreads();
    }
}
__device__ __forceinline__ void hconv_unit(const Params& p, int l, int ch, float* sm) {
    f32x2* buf = (f32x2*)sm;
    const f32x2* TW = (const f32x2*)(p.ws + WS_TW); const f32x2* TWN = (const f32x2*)(p.ws + WS_TWN);
    const f32x2* H = (const f32x2*)((const float*)(p.ws + WS_HSPEC) + (size_t)(l * 256 + ch) * FN);
    f32x2* z = (f32x2*)((float*)(p.ws + WS_ZT) + (size_t)ch * SEQ);
    const int tid = threadIdx.x;
    for (int n = tid; n < FM; n += NT) buf[n] = (n < SEQ / 2) ? z[n] : (f32x2){0.f, 0.f};
    __syncthreads();
    fft_dif(buf, TW);
    for (int k = tid; k <= FM / 2; k += NT) {
        if (k == 0) { const f32x2 a = buf[0], h = H[0]; const float y0 = (a.x + a.y) * h.x, ym = (a.x - a.y) * h.y; buf[0] = (f32x2){0.5f * (y0 + ym), 0.5f * (y0 - ym)}; continue; }
        const int kk = FM - k, rk = brev14(k), rkk = brev14(kk);
        const f32x2 a = buf[rk], b = buf[rkk], w = TWN[k], hk = H[k], hkk = H[kk];
        const f32x2 E = (f32x2){0.5f * (a.x + b.x), 0.5f * (a.y - b.y)}, O = (f32x2){0.5f * (a.y + b.y), 0.5f * (b.x - a.x)};
        const f32x2 T = (f32x2){w.x * O.x - w.y * O.y, w.x * O.y + w.y * O.x};
        const f32x2 Xk = E + T, Xkk = (f32x2){E.x - T.x, -(E.y - T.y)};
        const f32x2 Yk = (f32x2){Xk.x * hk.x - Xk.y * hk.y, Xk.x * hk.y + Xk.y * hk.x};
        const f32x2 Ykk = (f32x2){Xkk.x * hkk.x - Xkk.y * hkk.y, Xkk.x * hkk.y + Xkk.y * hkk.x};
        const f32x2 Ey = (f32x2){0.5f * (Yk.x + Ykk.x), 0.5f * (Yk.y - Ykk.y)};
        const f32x2 Dy = (f32x2){0.5f * (Yk.x - Ykk.x), 0.5f * (Yk.y + Ykk.y)};
        const f32x2 Oy = (f32x2){w.x * Dy.x + w.y * Dy.y, w.x * Dy.y - w.y * Dy.x};
        buf[rk] = (f32x2){Ey.x - Oy.y, Ey.y + Oy.x};
        if (kk != k) buf[rkk] = (f32x2){Ey.x + Oy.y, -(Ey.y - Oy.x)};
    }
    __syncthreads();
    fft_dit_inv(buf, TW);
    const float inv = 1.f / (float)FM;
    for (int n = tid; n < SEQ / 2; n += NT) { const f32x2 v = buf[n]; z[n] = (f32x2){v.x * inv, v.y * inv}; }
    __syncthreads();
}
__device__ __forceinline__ void hconv_ctx_unit(const Params& p, int ch, float* sm) {
    float* zc = (float*)(p.ws + WS_ZC) + ch * CTXL; const float* tc = (const float*)(p.ws + WS_TAPSC) + ch * 512;
    float* zs = sm; float* ts = sm + 256; float* red = sm + 768;
    const int tid = threadIdx.x;
    if (tid < 256) zs[tid] = zc[tid];
    const float tv = tc[tid]; ts[tid] = tv;
    const float a = wave_sum(fabsf(tv)); if ((tid & 63) == 0) red[tid >> 6] = a;
    __syncthreads();
    if (tid < 256) { float tot = 0.f;
#pragma unroll
        for (int w = 0; w < 8; ++w) tot += red[w];
        float acc = 0.f;
        for (int m = 0; m < 256; ++m) { const int lag = tid - m; acc += zs[m] * ts[lag >= 0 ? lag : 512 + lag]; }
        zc[tid] = acc / (tot + EPS); }
    __syncthreads();
}

__device__ __forceinline__ void ph_norm(const Params& p, int l, int which, bool first, int nrows, bool route, int bid, int nb) {
    const int lane = threadIdx.x & 63, wave = threadIdx.x >> 6;
    const float* g = p.in[which ? 7 : 6] + l * D;
    bf16* H = (bf16*)(p.ws + WS_H);
    for (int row = bid * 8 + wave; row < nrows; row += nb * 8) {
        const f32x4* xr = (const f32x4*)xsrc_row(p, first, row) + lane;
        const f32x4* sh = (const f32x4*)mod_vec(p, l, row, which ? 3 : 0) + lane; const f32x4* scv = (const f32x4*)mod_vec(p, l, row, which ? 4 : 1) + lane;
        f32x4 v[4]; float ss = 0.f;
#pragma unroll
        for (int j = 0; j < 4; ++j) { v[j] = xr[64 * j]; ss += (v[j].x * v[j].x + v[j].y * v[j].y) + (v[j].z * v[j].z + v[j].w * v[j].w); }
        const float r = rsqrtf(wave_sum(ss) * (1.f / D) + EPS);
        u32x2* o8 = (u32x2*)(H + (size_t)row * D) + lane;
#pragma unroll
        for (int j = 0; j < 4; ++j) { const f32x4 gg = ((const f32x4*)g)[lane + 64 * j], s1 = scv[64 * j], s0 = sh[64 * j];
            v[j] = v[j] * r * gg * (s1 + 1.f) + s0;
            o8[64 * j] = (u32x2){pk2(v[j].x, v[j].y), pk2(v[j].z, v[j].w)}; }
        if (route) {
            const float* rw = p.in[26]; const float* rb = p.in[27];
            float lg[8];
#pragma unroll
            for (int e = 0; e < 8; ++e) lg[e] = 0.f;
#pragma unroll
            for (int j = 0; j < 4; ++j)
#pragma unroll
                for (int i = 0; i < 4; ++i) { const int d = 4 * lane + 256 * j + i; const float hv = v[j][i];
                    const f32x4 w0 = *(const f32x4*)(rw + d * 8), w1 = *(const f32x4*)(rw + d * 8 + 4);
                    lg[0] += hv * w0.x; lg[1] += hv * w0.y; lg[2] += hv * w0.z; lg[3] += hv * w0.w; lg[4] += hv * w1.x; lg[5] += hv * w1.y; lg[6] += hv * w1.z; lg[7] += hv * w1.w; }
#pragma unroll
            for (int e = 0; e < 8; ++e) lg[e] = wave_sum(lg[e]) + rb[e];
            int i1 = 0; float v1 = lg[0];
#pragma unroll
            for (int e = 1; e < 8; ++e) if (lg[e] > v1) { v1 = lg[e]; i1 = e; }
            int i2 = -1; float v2 = -3.0e38f;
#pragma unroll
            for (int e = 0; e < 8; ++e) if (e != i1 && lg[e] > v2) { v2 = lg[e]; i2 = e; }
            const float ex = __expf(v2 - v1), g1 = 1.f / (1.f + ex), g2 = ex * g1;
            if (lane == 0) {
                unsigned* cnt = (unsigned*)(p.ws + WS_CTL) + CW_CNT;
                int* at = (int*)(p.ws + WS_ASGT); float* ag = (float*)(p.ws + WS_ASGG);
                const unsigned p1 = atomicAdd(&cnt[i1], 1u); at[i1 * SEQ + p1] = row * 2; ag[i1 * SEQ + p1] = g1;
                const unsigned p2 = atomicAdd(&cnt[i2], 1u); at[i2 * SEQ + p2] = row * 2 + 1; ag[i2 * SEQ + p2] = g2;
            }
        }
    }
}

template <class Epi, bool DUAL>
__device__ __forceinline__ void gemm_naive(const bf16* A, const bf16* Bt, int K, int mtiles, int ntiles, const Epi& E, float* sm, int bid, int nb) {
    float* As = sm; float* Bs = sm + 32 * 132; float* Bs2 = Bs + 32 * 68;
    const int tid = threadIdx.x, ty = tid >> 4, tx = tid & 15;
    for (int tile = bid; tile < mtiles * ntiles; tile += nb) {
        const int mt = tile / ntiles, nt = tile % ntiles;
        const bf16* Ab = A + (size_t)mt * 128 * K;
        const int brow = DUAL ? gu_row(nt * 64, 0) : nt * 64;
        const bf16* Bb = E.bt(Bt, mt) + (size_t)brow * K;
        float acc[4][4], acu[4][4];
#pragma unroll
        for (int i = 0; i < 4; ++i)
#pragma unroll
            for (int j = 0; j < 4; ++j) { acc[i][j] = 0.f; acu[i][j] = 0.f; }
        for (int k0 = 0; k0 < K; k0 += 32) {
            { const int row = tid >> 2, kc = (tid & 3) * 8; const u32x4 w = *(const u32x4*)(Ab + (size_t)row * K + k0 + kc);
              As[(kc + 0) * 132 + row] = lo16(w.x); As[(kc + 1) * 132 + row] = hi16(w.x); As[(kc + 2) * 132 + row] = lo16(w.y); As[(kc + 3) * 132 + row] = hi16(w.y);
              As[(kc + 4) * 132 + row] = lo16(w.z); As[(kc + 5) * 132 + row] = hi16(w.z); As[(kc + 6) * 132 + row] = lo16(w.w); As[(kc + 7) * 132 + row] = hi16(w.w); }
            if (tid < 256 || DUAL) { const int t2 = tid & 255; const int row = t2 >> 2, kc = (t2 & 3) * 8; float* dst = (tid < 256) ? Bs : Bs2;
              const u32x4 w = *(const u32x4*)(Bb + (size_t)(row + (tid < 256 ? 0 : 128)) * K + k0 + kc);
              dst[(kc + 0) * 68 + row] = lo16(w.x); dst[(kc + 1) * 68 + row] = hi16(w.x); dst[(kc + 2) * 68 + row] = lo16(w.y); dst[(kc + 3) * 68 + row] = hi16(w.y);
              dst[(kc + 4) * 68 + row] = lo16(w.z); dst[(kc + 5) * 68 + row] = hi16(w.z); dst[(kc + 6) * 68 + row] = lo16(w.w); dst[(kc + 7) * 68 + row] = hi16(w.w); }
            __syncthreads();
#pragma unroll 8
            for (int kk = 0; kk < 32; ++kk) { const f32x4 a = *(const f32x4*)&As[kk * 132 + ty * 4]; const f32x4 b = *(const f32x4*)&Bs[kk * 68 + tx * 4];
#pragma unroll
                for (int i = 0; i < 4; ++i)
#pragma unroll
                    for (int j = 0; j < 4; ++j) acc[i][j] += a[i] * b[j];
                if (DUAL) { const f32x4 b2 = *(const f32x4*)&Bs2[kk * 68 + tx * 4];
#pragma unroll
                    for (int i = 0; i < 4; ++i)
#pragma unroll
                        for (int j = 0; j < 4; ++j) acu[i][j] += a[i] * b2[j]; } }
            __syncthreads();
        }
#pragma unroll
        for (int i = 0; i < 4; ++i) E.store(mt * 128 + ty * 4 + i, nt * 64 + tx * 4, acc[i], acu[i]);
    }
}
struct EpiP {
    bf16* P;
    __device__ __forceinline__ const bf16* bt(const bf16* b, int) const { return b; }
    __device__ __forceinline__ void store(int row, int col, const float* a, const float*) const { *(u32x2*)(P + (size_t)row * INC + col) = (u32x2){pk2(a[0], a[1]), pk2(a[2], a[3])}; }
};
struct EpiRes {
    const Params* p; int l, gj; bool first;
    __device__ __forceinline__ const bf16* bt(const bf16* b, int) const { return b; }
    __device__ __forceinline__ void store(int row, int col, const float* a, const float*) const {
        const f32x4 s = *(const f32x4*)(xsrc_row(*p, first, row) + col), m = *(const f32x4*)(mod_vec(*p, l, row, gj) + col);
        *(f32x4*)(xdst_row(*p, row) + col) = (f32x4){s.x + m.x * a[0], s.y + m.y * a[1], s.z + m.z * a[2], s.w + m.w * a[3]}; }
};
struct EpiSwi {
    bf16* Hd; const int* tile_e;
    __device__ __forceinline__ const bf16* bt(const bf16* b, int mt) const { return tile_e ? b + (size_t)tile_e[mt] * MOEW_E : b; }
    __device__ __forceinline__ void store(int row, int col, const float* a, const float* u) const {
        *(u32x2*)(Hd + (size_t)row * FF + col) = (u32x2){pk2(silu_f(a[0]) * u[0], silu_f(a[1]) * u[1]), pk2(silu_f(a[2]) * u[2], silu_f(a[3]) * u[3])}; }
};
struct EpiMoeDown {
    bf16* Y2; const int* rowd; const float* rowg; const int* tile_e;
    __device__ __forceinline__ const bf16* bt(const bf16* b, int mt) const { return b + (size_t)tile_e[mt] * MOEW_E; }
    __device__ __forceinline__ void store(int row, int col, const float* a, const float*) const {
        const int d = rowd[row]; if (d < 0) return; const float g = rowg[row];
        *(u32x2*)(Y2 + (size_t)d * D + col) = (u32x2){pk2(a[0] * g, a[1] * g), pk2(a[2] * g, a[3] * g)}; }
};

__device__ __forceinline__ void prep_qk(const Params& p, int l, int nrows, int bid, int nb) {
    const int lane = threadIdx.x & 63, wave = threadIdx.x >> 6;
    bf16* P = (bf16*)(p.ws + WS_P);
    const float gq = p.in[21][l * 64 + lane], gk = p.in[22][l * 64 + lane];
    const int sec = lane >> 5, j = lane & 31, i = j & 15;
    const float invf = exp2f(-(float)i * (13.287712379549449f / 16.f));
    for (int row = bid * 8 + wave; row < nrows; row += nb * 8) {
        float cs = 1.f, sn = 0.f;
        if (row < SEQ) { const float pos = (float)(sec ? (row & 63) : (row >> 6)); const float x = pos * invf * 0.3183098861837907f; sn = sinpif(x); cs = cospif(x); }
        bf16* pr = P + (size_t)row * INC;
#pragma unroll
        for (int hv = 0; hv < 10; ++hv) {
            const int off = (hv < 8) ? C_AQ + hv * 64 : C_AK + (hv - 8) * 64;
            const float v = bf2f(pr[off + lane]);
            const float ss = wave_sum(v * v);
            float y = v * rsqrtf(ss * (1.f / 64.f) + EPS) * (hv < 8 ? gq : gk);
            const float o = __shfl_xor(y, 16);
            y = (j < 16) ? y * cs - o * sn : y * cs + o * sn;
            if (hv < 8) y *= C2;
            pr[off + lane] = (bf16)f2bf(y);
        }
    }
}
__device__ __forceinline__ float conv3(const bf16* P, const float* cw, const float* cb, int t, int lo, int hi, int col) {
    float a = cb[col] + cw[768 + col] * bf2f(P[(size_t)t * INC + col]);
    if (t - 1 >= lo) a += cw[col] * bf2f(P[(size_t)(t - 1) * INC + col]);
    if (t + 1 < hi) a += cw[1536 + col] * bf2f(P[(size_t)(t + 1) * INC + col]);
    return a;
}
__device__ __forceinline__ void prep_hyz(const Params& p, int l, bool with_ctx, float* sm, int bid, int nb) {
    const bf16* P = (const bf16*)(p.ws + WS_P);
    const float* cw = p.in[10] + l * 3 * 768; const float* cb = p.in[11] + l * 768;
    const int ntile = with_ctx ? 260 : 256, tid = threadIdx.x;
    for (int tile = bid; tile < ntile; tile += nb) {
        const int t0 = tile * 64; const int lo = tile < 256 ? 0 : SEQ, hi = tile < 256 ? SEQ : R;
        for (int e = tid; e < 64 * 256; e += NT) { const int tl = e >> 8, ch = e & 255;
            sm[ch * 65 + tl] = conv3(P, cw, cb, t0 + tl, lo, hi, C_HX1 + ch) * conv3(P, cw, cb, t0 + tl, lo, hi, C_HV + ch); }
        __syncthreads();
        for (int e = tid; e < 64 * 256; e += NT) { const int ch = e >> 6, tl = e & 63;
            if (tile < 256) ((float*)(p.ws + WS_ZT))[(size_t)ch * SEQ + t0 + tl] = sm[ch * 65 + tl];
            else ((float*)(p.ws + WS_ZC))[ch * CTXL + (t0 - SEQ) + tl] = sm[ch * 65 + tl]; }
        __syncthreads();
    }
}
__device__ __forceinline__ void prep_retu(const Params& p, int l, float* sm, int bid, int nb) {
    const bf16* P = (const bf16*)(p.ws + WS_P);
    float* Ks = sm; float* Vs = sm + 8192; float* wf = sm + 16384; float* wb = wf + 128;
    const int tid = threadIdx.x;
    for (int it = bid; it < NCH * 4; it += nb) {
        const int c = it >> 2, h = it & 3; const int r0 = c * 128;
        const float lgf = -__expf(p.in[20][l * 8 + h]), lgb = -__expf(p.in[20][l * 8 + 4 + h]);
        if (tid < 128) { wf[tid] = __expf(lgf * (float)(127 - tid)); wb[tid] = __expf(lgb * (float)tid); }
        for (int e = tid; e < 128 * 64; e += NT) { const int m = e >> 6, d = e & 63; const bf16* pr = P + (size_t)(r0 + m) * INC + h * 64 + d;
            Ks[e] = bf2f(pr[C_RK]) * 0.125f; Vs[e] = bf2f(pr[C_RV]); }
        __syncthreads();
        const int d = tid >> 3, e0 = (tid & 7) * 8;
        float af[8], ab[8];
#pragma unroll
        for (int j = 0; j < 8; ++j) { af[j] = 0.f; ab[j] = 0.f; }
        for (int m = 0; m < 128; ++m) { const float kd = Ks[m * 64 + d], kf = kd * wf[m], kb = kd * wb[m];
            const f32x4 v0 = *(const f32x4*)&Vs[m * 64 + e0], v1 = *(const f32x4*)&Vs[m * 64 + e0 + 4];
#pragma unroll
            for (int j = 0; j < 4; ++j) { af[j] += kf * v0[j]; ab[j] += kb * v0[j]; af[4 + j] += kf * v1[j]; ab[4 + j] += kb * v1[j]; } }
        float* U = (float*)(p.ws + WS_RU);
        float* uf = U + ((size_t)(0 * 4 + h) * NCH + c) * 4096 + d * 64 + e0; float* ub = U + ((size_t)(1 * 4 + h) * NCH + c) * 4096 + d * 64 + e0;
        *(f32x4*)uf = (f32x4){af[0], af[1], af[2], af[3]}; *(f32x4*)(uf + 4) = (f32x4){af[4], af[5], af[6], af[7]};
        *(f32x4*)ub = (f32x4){ab[0], ab[1], ab[2], ab[3]}; *(f32x4*)(ub + 4) = (f32x4){ab[4], ab[5], ab[6], ab[7]};
        __syncthreads();
    }
}
__device__ __forceinline__ void ph_retscan(const Params& p, int l, int bid, int nb) {
    float* U = (float*)(p.ws + WS_RU);
    for (int g = bid * NT + threadIdx.x; g < 8 * 4096; g += nb * NT) {
        const int dir = g >> 14, h = (g >> 12) & 3, e = g & 4095;
        const float lg = -__expf(p.in[20][l * 8 + dir * 4 + h]); const float Dc = __expf(lg * 128.f);
        float* u = U + (size_t)(dir * 4 + h) * NCH * 4096 + e;
        const float uc0 = u[(size_t)128 * 4096], uc1 = u[(size_t)129 * 4096];
        if (dir == 0) {
            float s = Dc * uc0 + uc1; u[(size_t)128 * 4096] = 0.f; u[(size_t)129 * 4096] = uc0;
            for (int c = 0; c < 128; ++c) { const float t = u[(size_t)c * 4096]; u[(size_t)c * 4096] = s; s = Dc * s + t; }
        } else {
            float s = uc0 + Dc * uc1; u[(size_t)129 * 4096] = 0.f; u[(size_t)128 * 4096] = uc1;
            for (int c = 127; c >= 0; --c) { const float t = u[(size_t)c * 4096]; u[(size_t)c * 4096] = s; s = Dc * s + t; }
        }
    }
}

__device__ __forceinline__ void post_ret(const Params& p, int l, int nchunks, unsigned char* smb, int bid, int nb) {
    const bf16* P = (const bf16*)(p.ws + WS_P); bf16* Y = (bf16*)(p.ws + WS_YMIX);
    bf16* Qs = (bf16*)smb; bf16* Ks = Qs + 128 * 72; bf16* Vs = Ks + 128 * 72; float* S = (float*)(smb + 3 * 128 * 72 * 2); float* pf = S + 128 * 132; float* pb = pf + 128;
    const int tid = threadIdx.x;
    for (int it = bid; it < nchunks * 4; it += nb) {
        const int c = it >> 2, h = it & 3, r0 = c * 128;
        const float lgf = -__expf(p.in[20][l * 8 + h]), lgb = -__expf(p.in[20][l * 8 + 4 + h]);
        if (tid < 128) { pf[tid] = __expf(lgf * (float)tid); pb[tid] = __expf(lgb * (float)tid); }
        for (int e = tid; e < 128 * 8; e += NT) { const int m = e >> 3, dc = e & 7; const bf16* pr = P + (size_t)(r0 + m) * INC + h * 64 + dc * 8;
            *(u32x4*)(Qs + m * 72 + dc * 8) = *(const u32x4*)(pr + C_RQ); *(u32x4*)(Ks + m * 72 + dc * 8) = *(const u32x4*)(pr + C_RK); *(u32x4*)(Vs + m * 72 + dc * 8) = *(const u32x4*)(pr + C_RV); }
        __syncthreads();
        {
            const int tn = tid >> 4, tm = tid & 15;
            float acc[4][8];
#pragma unroll
            for (int i = 0; i < 4; ++i)
#pragma unroll
                for (int j = 0; j < 8; ++j) acc[i][j] = 0.f;
            for (int dc = 0; dc < 8; ++dc) {
                u32x4 q[4], k[8];
#pragma unroll
                for (int i = 0; i < 4; ++i) q[i] = *(const u32x4*)(Qs + (tn + 32 * i) * 72 + dc * 8);
#pragma unroll
                for (int j = 0; j < 8; ++j) k[j] = *(const u32x4*)(Ks + (tm + 16 * j) * 72 + dc * 8);
#pragma unroll
                for (int i = 0; i < 4; ++i)
#pragma unroll
                    for (int j = 0; j < 8; ++j)
#pragma unroll
                        for (int w = 0; w < 4; ++w) acc[i][j] += lo16(q[i][w]) * lo16(k[j][w]) + hi16(q[i][w]) * hi16(k[j][w]);
            }
#pragma unroll
            for (int i = 0; i < 4; ++i)
#pragma unroll
                for (int j = 0; j < 8; ++j) { const int n = tn + 32 * i, m = tm + 16 * j;
                    const float f = (n > m) ? pf[n - m] : ((n < m) ? pb[m - n] : 2.f);
                    S[n * 132 + m] = acc[i][j] * 0.125f * f; }
        }
        __syncthreads();
        {
            const int n = tid >> 2, eq = tid & 3;
            float acc[16];
#pragma unroll
            for (int e = 0; e < 16; ++e) acc[e] = 0.f;
            for (int m = 0; m < 128; ++m) { const float sv = S[n * 132 + m];
                const u32x4 v0 = *(const u32x4*)(Vs + m * 72 + eq * 16), v1 = *(const u32x4*)(Vs + m * 72 + eq * 16 + 8);
#pragma unroll
                for (int w = 0; w < 4; ++w) { acc[2 * w] += sv * lo16(v0[w]); acc[2 * w + 1] += sv * hi16(v0[w]); acc[8 + 2 * w] += sv * lo16(v1[w]); acc[9 + 2 * w] += sv * hi16(v1[w]); } }
            const float* SPf = (const float*)(p.ws + WS_RU) + ((size_t)(0 * 4 + h) * NCH + c) * 4096 + eq * 16;
            const float* SPb = (const float*)(p.ws + WS_RU) + ((size_t)(1 * 4 + h) * NCH + c) * 4096 + eq * 16;
            const float xif = pf[n] * pf[1], xib = pb[127 - n] * pb[1];
            for (int d = 0; d < 64; ++d) { const float qd = bf2f(Qs[n * 72 + d]), qf = qd * xif, qb = qd * xib;
#pragma unroll
                for (int w = 0; w < 4; ++w) { const f32x4 a = *(const f32x4*)(SPf + d * 64 + 4 * w), b = *(const f32x4*)(SPb + d * 64 + 4 * w);
                    acc[4 * w] += qf * a.x + qb * b.x; acc[4 * w + 1] += qf * a.y + qb * b.y; acc[4 * w + 2] += qf * a.z + qb * b.z; acc[4 * w + 3] += qf * a.w + qb * b.w; } }
            float s = 0.f;
#pragma unroll
            for (int e = 0; e < 16; ++e) s += acc[e];
            s += __shfl_xor(s, 1); s += __shfl_xor(s, 2);
            const float mu = s * (1.f / 64.f); float vs = 0.f;
#pragma unroll
            for (int e = 0; e < 16; ++e) { acc[e] -= mu; vs += acc[e] * acc[e]; }
            vs += __shfl_xor(vs, 1); vs += __shfl_xor(vs, 2);
            const float rs = rsqrtf(vs * (1.f / 64.f) + EPS);
            const bf16* gr = P + (size_t)(r0 + n) * INC + C_RG + h * 64 + eq * 16;
            const u32x4 g0 = *(const u32x4*)gr, g1 = *(const u32x4*)(gr + 8);
            u32x4 o0, o1;
#pragma unroll
            for (int w = 0; w < 4; ++w) { o0[w] = pk2(silu_f(lo16(g0[w])) * acc[2 * w] * rs, silu_f(hi16(g0[w])) * acc[2 * w + 1] * rs);
                o1[w] = pk2(silu_f(lo16(g1[w])) * acc[8 + 2 * w] * rs, silu_f(hi16(g1[w])) * acc[9 + 2 * w] * rs); }
            bf16* yo = Y + (size_t)(r0 + n) * D + 256 + h * 64 + eq * 16;
            *(u32x4*)yo = o0; *(u32x4*)(yo + 8) = o1;
        }
        __syncthreads();
    }
}
__device__ __forceinline__ void post_hy(const Params& p, int l, bool with_ctx, float* sm, int bid, int nb) {
    const bf16* P = (const bf16*)(p.ws + WS_P); bf16* Y = (bf16*)(p.ws + WS_YMIX);
    const float* cw = p.in[10] + l * 3 * 768; const float* cb = p.in[11] + l * 768; const float* hb = p.in[19] + l * 256;
    const int ntile = with_ctx ? 260 : 256, tid = threadIdx.x;
    for (int tile = bid; tile < ntile; tile += nb) {
        const int t0 = tile * 64; const int lo = tile < 256 ? 0 : SEQ, hi = tile < 256 ? SEQ : R;
        for (int e = tid; e < 64 * 256; e += NT) { const int ch = e >> 6, tl = e & 63;
            sm[ch * 65 + tl] = (tile < 256) ? ((const float*)(p.ws + WS_ZT))[(size_t)ch * SEQ + t0 + tl] : ((const float*)(p.ws + WS_ZC))[ch * CTXL + (t0 - SEQ) + tl]; }
        __syncthreads();
        for (int e = tid; e < 64 * 256; e += NT) { const int tl = e >> 8, ch = e & 255, t = t0 + tl;
            const float x0 = conv3(P, cw, cb, t, lo, hi, C_HX0 + ch), z = conv3(P, cw, cb, t, lo, hi, C_HX1 + ch) * conv3(P, cw, cb, t, lo, hi, C_HV + ch);
            Y[(size_t)t * D + ch] = (bf16)f2bf(x0 * (sm[ch * 65 + tl] + hb[ch] * z)); }
        __syncthreads();
    }
}

__device__ __forceinline__ void attn_naive(const Params& p, bool with_ctx, float* sm, int bid, int nb) {
    const bf16* P = (const bf16*)(p.ws + WS_P); bf16* Y = (bf16*)(p.ws + WS_YMIX);
    float* Ks = sm; float* Vs = sm + 32 * 64;
    const int tid = threadIdx.x, nunits = with_ctx ? 264 : 256;
    for (int u = bid; u < nunits; u += nb) {
        int h, q0, nq, k0, nk;
        if (u < 256) { h = u >> 5; q0 = (u & 31) * 512; nq = 512; k0 = 0; nk = R; } else { h = u - 256; q0 = SEQ; nq = 256; k0 = SEQ; nk = CTXL; }
        const int kvh = h >> 2; const bool act = tid < nq; const int qrow = q0 + (act ? tid : 0);
        float qv[64], o[64];
        { const u32x4* qp = (const u32x4*)(P + (size_t)qrow * INC + C_AQ + h * 64);
#pragma unroll
          for (int c = 0; c < 8; ++c) { const u32x4 w = qp[c];
#pragma unroll
              for (int x = 0; x < 4; ++x) { qv[c * 8 + 2 * x] = lo16(w[x]); qv[c * 8 + 2 * x + 1] = hi16(w[x]); } } }
#pragma unroll
        for (int d = 0; d < 64; ++d) o[d] = 0.f;
        float m = -1.0e30f, ls = 0.f;
        for (int kt = 0; kt < nk; kt += 32) {
            __syncthreads();
            { const int e = tid * 4, kr = e >> 6, d = e & 63; const bf16* kp = P + (size_t)(k0 + kt + kr) * INC + kvh * 64 + d;
              const u32x2 kw = *(const u32x2*)(kp + C_AK), vw = *(const u32x2*)(kp + C_AV);
              Ks[e] = lo16(kw.x); Ks[e + 1] = hi16(kw.x); Ks[e + 2] = lo16(kw.y); Ks[e + 3] = hi16(kw.y);
              Vs[e] = lo16(vw.x); Vs[e + 1] = hi16(vw.x); Vs[e + 2] = lo16(vw.y); Vs[e + 3] = hi16(vw.y); }
            __syncthreads();
#pragma unroll 1
            for (int j = 0; j < 32; ++j) { float a = 0.f;
#pragma unroll
                for (int d4 = 0; d4 < 16; ++d4) { const f32x4 kk = *(const f32x4*)&Ks[j * 64 + d4 * 4]; a += qv[d4 * 4] * kk.x + qv[d4 * 4 + 1] * kk.y + qv[d4 * 4 + 2] * kk.z + qv[d4 * 4 + 3] * kk.w; }
                const float mn = fmaxf(m, a), sc = exp2f(m - mn), pj = exp2f(a - mn); m = mn; ls = ls * sc + pj;
#pragma unroll
                for (int d4 = 0; d4 < 16; ++d4) { const f32x4 vv = *(const f32x4*)&Vs[j * 64 + d4 * 4];
                    o[d4 * 4] = o[d4 * 4] * sc + pj * vv.x; o[d4 * 4 + 1] = o[d4 * 4 + 1] * sc + pj * vv.y; o[d4 * 4 + 2] = o[d4 * 4 + 2] * sc + pj * vv.z; o[d4 * 4 + 3] = o[d4 * 4 + 3] * sc + pj * vv.w; } }
        }
        if (act) { const float il = 1.f / ls; u32x4* yo = (u32x4*)(Y + (size_t)qrow * D + 512 + h * 64);
#pragma unroll
            for (int c = 0; c < 8; ++c) yo[c] = (u32x4){pk2(o[c * 8] * il, o[c * 8 + 1] * il), pk2(o[c * 8 + 2] * il, o[c * 8 + 3] * il), pk2(o[c * 8 + 4] * il, o[c * 8 + 5] * il), pk2(o[c * 8 + 6] * il, o[c * 8 + 7] * il)}; }
    }
}

__device__ __forceinline__ int moe_segments(const Params& p, int* seg  , int* tile_e  ) {
    const unsigned* cnt = (const unsigned*)(p.ws + WS_CTL) + CW_CNT;
    if (threadIdx.x == 0) { int s = 0; for (int e = 0; e < 8; ++e) { seg[e] = s; s += (int)((cnt[e] + 255u) >> 8) << 8; } seg[8] = s; }
    __syncthreads();
    const int total = seg[8];
    for (int t = threadIdx.x; t < total / 128; t += NT) { int e = 0; while (t * 128 >= seg[e + 1]) ++e; tile_e[t] = e; }
    __syncthreads();
    return total;
}
__device__ __forceinline__ void ph_gather(const Params& p, int* ism, int bid, int nb) {
    int* seg = ism; int* tile_e = ism + 16;
    const int total = moe_segments(p, seg, tile_e);
    const unsigned* cnt = (const unsigned*)(p.ws + WS_CTL) + CW_CNT;
    const int lane = threadIdx.x & 63, wave = threadIdx.x >> 6;
    const bf16* H = (const bf16*)(p.ws + WS_H); bf16* XS = (bf16*)(p.ws + WS_XS);
    int* rowd = (int*)(p.ws + WS_ROWD); float* rowg = (float*)(p.ws + WS_ROWG);
    const int* at = (const int*)(p.ws + WS_ASGT); const float* ag = (const float*)(p.ws + WS_ASGG);
    for (int s = bid * 8 + wave; s < total; s += nb * 8) {
        const int e = tile_e[s >> 7], pos = s - seg[e];
        u32x4 v0 = (u32x4){0u, 0u, 0u, 0u}, v1 = v0; int dd = -1; float gg = 0.f;
        if (pos < (int)cnt[e]) { dd = at[e * SEQ + pos]; gg = ag[e * SEQ + pos]; const u32x4* src = (const u32x4*)(H + (size_t)(dd >> 1) * D); v0 = src[lane]; v1 = src[64 + lane]; }
        u32x4* dst = (u32x4*)(XS + (size_t)s * D); dst[lane] = v0; dst[64 + lane] = v1;
        if (lane == 0) { rowd[s] = dd; rowg[s] = gg; }
    }
}
__device__ __forceinline__ void ph_final(const Params& p, int bid, int nb) {
    const int lane = threadIdx.x & 63, wave = threadIdx.x >> 6;
    const bf16* Y2 = (const bf16*)(p.ws + WS_Y2); const float* g = p.in[31];
    for (int row = bid * 8 + wave; row < SEQ; row += nb * 8) {
        f32x4* xr = (f32x4*)(p.out + (size_t)row * D) + lane; const f32x4* m5 = (const f32x4*)mod_vec(p, 1, row, 5) + lane;
        const u32x2* ya = (const u32x2*)(Y2 + (size_t)(2 * row) * D) + lane; const u32x2* yb = (const u32x2*)(Y2 + (size_t)(2 * row + 1) * D) + lane;
        f32x4 v[4]; float ss = 0.f;
#pragma unroll
        for (int j = 0; j < 4; ++j) { const u32x2 a = ya[64 * j], b = yb[64 * j]; const f32x4 m = m5[64 * j];
            const f32x4 y = (f32x4){lo16(a.x) + lo16(b.x), hi16(a.x) + hi16(b.x), lo16(a.y) + lo16(b.y), hi16(a.y) + hi16(b.y)};
            v[j] = xr[64 * j] + m * y; ss += (v[j].x * v[j].x + v[j].y * v[j].y) + (v[j].z * v[j].z + v[j].w * v[j].w); }
        const float r = rsqrtf(wave_sum(ss) * (1.f / D) + EPS);
#pragma unroll
        for (int j = 0; j < 4; ++j) xr[64 * j] = v[j] * r * ((const f32x4*)g)[lane + 64 * j];
    }
}

#define LAS __attribute__((address_space(3)))
#define XB_TMO      128
#define XB_XCNT(j)  (256  + 64 * (j))
#define XB_XSUB(j)  (1280 + 64 * (j))
#define XB_XGEN(j)  (2304 + 64 * (j))
#define XB_TOP      3328
#define XB_TOPGEN   3392
#define XCD_BAR_WORDS 3456
#define XB_SPIN_CAP (1u << 18)
__device__ __forceinline__ unsigned xb_ld(unsigned* p)              { return __hip_atomic_load(p, __ATOMIC_RELAXED, __HIP_MEMORY_SCOPE_AGENT); }
__device__ __forceinline__ unsigned xb_add(unsigned* p, unsigned v) { return __hip_atomic_fetch_add(p, v, __ATOMIC_RELAXED, __HIP_MEMORY_SCOPE_AGENT); }
__device__ __forceinline__ unsigned xb_xcc_id() { return (unsigned)__builtin_amdgcn_s_getreg((3 << 11) | 20) & 0xFu; }
#define XB_SPIN(cond, bar) do { unsigned _sp = 0; while (cond) { __builtin_amdgcn_s_sleep(1); \
    if ((++_sp & 255u) == 0u) { if (xb_ld(&(bar)[XB_TMO])) break; if (_sp > XB_SPIN_CAP) { atomicAdd(&(bar)[XB_TMO], 1u); break; } } } } while (0)
struct XcdBarrier { unsigned* bar; unsigned x; volatile LAS unsigned* st; };
__device__ __forceinline__ XcdBarrier xcd_barrier_post(unsigned* bar, volatile LAS unsigned* st) {
    XcdBarrier b; b.bar = bar; b.x = xb_xcc_id(); b.st = st;
    if (threadIdx.x == 0) (void)xb_add(&bar[XB_XCNT(b.x)], 1u);
    return b;
}
__device__ __forceinline__ void xcd_barrier_complete(unsigned* bar, unsigned x, unsigned& nloc, unsigned& nx) {
    const unsigned G = gridDim.x * gridDim.y * gridDim.z;
    unsigned sum, cnt, mine, sp = 0u;
    for (;;) {
        sum = 0u; cnt = 0u; mine = 0u;
#pragma unroll
        for (unsigned j = 0; j < 16; ++j) { const unsigned c = xb_ld(&bar[XB_XCNT(j)]); sum += c; cnt += (c > 0u) ? 1u : 0u; mine = (j == x) ? c : mine; }
        if (sum == G) break;
        __builtin_amdgcn_s_sleep(1);
        if ((++sp & 255u) == 0u) { if (xb_ld(&bar[XB_TMO])) break; if (sp > XB_SPIN_CAP) { atomicAdd(&bar[XB_TMO], 1u); break; } }
    }
    nloc = mine > 0u ? mine : 1u; nx = cnt > 0u ? cnt : 1u;
}
__device__ __forceinline__ void xcd_barrier(const XcdBarrier& b) {
    asm volatile("s_waitcnt vmcnt(0)" ::: "memory");
    __syncthreads();
    if (threadIdx.x == 0) {
        unsigned* bar = b.bar;
        __builtin_amdgcn_s_waitcnt(0);
        unsigned nloc = b.st[0], nx = b.st[1];
        if (nloc == 0u) { xcd_barrier_complete(bar, b.x, nloc, nx); b.st[0] = nloc; b.st[1] = nx; }
        const unsigned old = xb_add(&bar[XB_XSUB(b.x)], 1u);
        const unsigned gen = old / nloc;
        if (old + 1u == (gen + 1u) * nloc) {
            __builtin_amdgcn_fence(__ATOMIC_RELEASE, "agent");
            asm volatile("s_waitcnt vmcnt(0)" ::: "memory");
            const unsigned og = xb_add(&bar[XB_TOP], 1u);
            const unsigned tg = og / nx;
            if (og + 1u == (tg + 1u) * nx) xb_add(&bar[XB_TOPGEN], 1u);
            else XB_SPIN(xb_ld(&bar[XB_TOPGEN]) == tg, bar);
            __builtin_amdgcn_fence(__ATOMIC_ACQUIRE, "agent");
            xb_add(&bar[XB_XGEN(b.x)], 1u);
            asm volatile("s_waitcnt vmcnt(0)" ::: "memory");
        } else {
            XB_SPIN(xb_ld(&bar[XB_XGEN(b.x)]) == gen, bar);
            __builtin_amdgcn_fence(__ATOMIC_ACQUIRE, "agent");
            asm volatile("s_waitcnt vmcnt(0)" ::: "memory");
        }
    }
    __syncthreads();
}

constexpr int LDS_BYTES = 147456;
constexpr int LDS_MISC = 131072 + 8192;
constexpr int NPHASE = 21;

__global__ void __launch_bounds__(NT, 2) k_run(Params p) {
    extern __shared__ __attribute__((aligned(16))) unsigned char lds[];
    float* sm = (float*)lds;
    const int bid = blockIdx.x, nb = gridDim.x;
    volatile LAS unsigned* misc = (volatile LAS unsigned*)((LAS unsigned char*)lds + LDS_MISC);
    if (threadIdx.x < 16) misc[threadIdx.x] = 0u;
    __syncthreads();
    XcdBarrier bar; bar.bar = (unsigned*)(p.ws + WS_CTL) + CW_BAR; bar.x = 0; bar.st = nullptr;
    if (p.ph_hi - p.ph_lo > 1) bar = xcd_barrier_post((unsigned*)(p.ws + WS_CTL) + CW_BAR, misc + 8);
    const int lo = p.ph_lo, hi = p.ph_hi;
#ifndef ONLY_PH
#define ONLY_PH -1
#endif
#define IN(k) ((ONLY_PH < 0 || ONLY_PH == (k)) && lo <= (k) && (k) < hi)
#define SEAM(k) do { if (IN(k) && IN((k) + 1)) xcd_barrier(bar); } while (0)

    if (IN(0)) { ph_mod(p, sm, bid, nb); ph_tw(p, bid, nb); __syncthreads(); ph_filt(p, sm, bid, nb); __syncthreads(); ph_wconv(p, sm, bid, nb); } SEAM(0);
    if (IN(1)) { ph_hfft(p, sm, bid, nb); ph_norm(p, 0, 0, true, R, false, bid, nb); } SEAM(1);
    if (IN(2)) { EpiP E{(bf16*)(p.ws + WS_P)}; gemm_naive<EpiP, false>((const bf16*)(p.ws + WS_H), (const bf16*)(p.ws + WS_WIN), D, R / 128, INC / 64, E, sm, bid, nb); } SEAM(2);
    if (IN(3)) { prep_qk(p, 0, R, bid, nb); prep_hyz(p, 0, true, sm, bid, nb); prep_retu(p, 0, sm, bid, nb); } SEAM(3);
    if (IN(4)) { ph_retscan(p, 0, bid, nb);
        for (int u = bid; u < 512; u += nb) { if (u < 256) hconv_unit(p, 0, u, sm); else hconv_ctx_unit(p, u - 256, sm); }
        attn_naive(p, true, sm, bid, nb); } SEAM(4);
    if (IN(5)) { post_ret(p, 0, NCH, lds, bid, nb); post_hy(p, 0, true, sm, bid, nb); } SEAM(5);
    if (IN(6)) { EpiRes E{&p, 0, 2, true}; gemm_naive<EpiRes, false>((const bf16*)(p.ws + WS_YMIX), (const bf16*)(p.ws + WS_WOUT), D, R / 128, D / 64, E, sm, bid, nb); } SEAM(6);
    if (IN(7)) { ph_norm(p, 0, 1, false, R, false, bid, nb); } SEAM(7);
    if (IN(8)) { EpiSwi E{(bf16*)(p.ws + WS_HID), nullptr}; gemm_naive<EpiSwi, true>((const bf16*)(p.ws + WS_H), (const bf16*)(p.ws + WS_WGU), D, R / 128, FF / 64, E, sm, bid, nb); } SEAM(8);
    if (IN(9)) { EpiRes E{&p, 0, 5, false}; gemm_naive<EpiRes, false>((const bf16*)(p.ws + WS_HID), (const bf16*)(p.ws + WS_WDN), FF, R / 128, D / 64, E, sm, bid, nb); } SEAM(9);
    if (IN(10)) { ph_norm(p, 1, 0, false, R, false, bid, nb); } SEAM(10);
    if (IN(11)) { EpiP E{(bf16*)(p.ws + WS_P)}; gemm_naive<EpiP, false>((const bf16*)(p.ws + WS_H), (const bf16*)(p.ws + WS_WIN) + (size_t)INC * D, D, R / 128, INC / 64, E, sm, bid, nb); } SEAM(11);
    if (IN(12)) { prep_qk(p, 1, R, bid, nb); prep_hyz(p, 1, false, sm, bid, nb); prep_retu(p, 1, sm, bid, nb); } SEAM(12);
    if (IN(13)) { ph_retscan(p, 1, bid, nb);
        for (int u = bid; u < 256; u += nb) hconv_unit(p, 1, u, sm);
        attn_naive(p, false, sm, bid, nb); } SEAM(13);
    if (IN(14)) { post_ret(p, 1, 128, lds, bid, nb); post_hy(p, 1, false, sm, bid, nb); } SEAM(14);
    if (IN(15)) { EpiRes E{&p, 1, 2, false}; gemm_naive<EpiRes, false>((const bf16*)(p.ws + WS_YMIX), (const bf16*)(p.ws + WS_WOUT) + (size_t)D * D, D, SEQ / 128, D / 64, E, sm, bid, nb); } SEAM(15);
    if (IN(16)) { ph_norm(p, 1, 1, false, SEQ, true, bid, nb); } SEAM(16);
    if (IN(17)) { ph_gather(p, (int*)(lds + LDS_MISC + 256), bid, nb); } SEAM(17);
    if (IN(18)) { int* ism = (int*)(lds + LDS_MISC + 256); const int total = moe_segments(p, ism, ism + 16);
        EpiSwi E{(bf16*)(p.ws + WS_HIDM), ism + 16}; gemm_naive<EpiSwi, true>((const bf16*)(p.ws + WS_XS), (const bf16*)(p.ws + WS_MOEW), D, total / 128, FF / 64, E, sm, bid, nb); } SEAM(18);
    if (IN(19)) { int* ism = (int*)(lds + LDS_MISC + 256); const int total = moe_segments(p, ism, ism + 16);
        EpiMoeDown E{(bf16*)(p.ws + WS_Y2), (const int*)(p.ws + WS_ROWD), (const float*)(p.ws + WS_ROWG), ism + 16};
        gemm_naive<EpiMoeDown, false>((const bf16*)(p.ws + WS_HIDM), (const bf16*)(p.ws + WS_MOEW) + (size_t)5632 * 1024, FF, total / 128, D / 64, E, sm, bid, nb); } SEAM(19);
    if (IN(20)) { ph_final(p, bid, nb); }
#undef IN
#undef SEAM
}

extern "C" void kernel_launch(void* const* d_in, const int* in_sizes, int n_in, void* d_out, int out_size, void* d_ws, size_t ws_size, hipStream_t stream) {
    static int grid = 0;
    if (grid == 0) {
        if (n_in != 32 || out_size != SEQ * D || ws_size < WS_END) { fprintf(stderr, "kernel_launch: unexpected problem (n_in %d out %d ws %zu)\n", n_in, out_size, ws_size); grid = -1; return; }
        int dev = 0, cus = 0;
        if (hipGetDevice(&dev) != hipSuccess || hipDeviceGetAttribute(&cus, hipDeviceAttributeMultiprocessorCount, dev) != hipSuccess) { grid = -1; return; }
        if (hipFuncSetAttribute((const void*)k_run, hipFuncAttributeMaxDynamicSharedMemorySize, LDS_BYTES) != hipSuccess) { fprintf(stderr, "kernel_launch: LDS attribute failed\n"); grid = -1; return; }
        int per_cu = 0; (void)hipOccupancyMaxActiveBlocksPerMultiprocessor(&per_cu, (const void*)k_run, NT, LDS_BYTES); (void)hipGetLastError();
        grid = cus > 0 ? cus : 256;
    }
    if (grid < 0) return;
    (void)hipMemsetAsync((char*)d_ws + WS_CTL, 0, CTL_BYTES, stream);
    Params p; memset(&p, 0, sizeof(p));
    for (int i = 0; i < 32; ++i) p.in[i] = (const float*)d_in[i];
    p.out = (float*)d_out; p.ws = (unsigned char*)d_ws;
#if N_LAUNCH_MODE == 1
    p.ph_lo = 0; p.ph_hi = NPHASE;
    hipLaunchKernelGGL(k_run, dim3(grid), dim3(NT), LDS_BYTES, stream, p);
#else
    for (int ph = 0; ph < NPHASE; ++ph) { p.ph_lo = ph; p.ph_hi = ph + 1; hipLaunchKernelGGL(k_run, dim3(grid), dim3(NT), LDS_BYTES, stream, p); }
#endif
}
```

```cpp
#include <hip/hip_runtime.h>
#include <cstdio>
#include <cstdint>
#include <cstring>

typedef unsigned short bf16;
typedef unsigned u32x4 __attribute__((ext_vector_type(4)));
typedef unsigned u32x2 __attribute__((ext_vector_type(2)));
typedef float f32x4 __attribute__((ext_vector_type(4)));
typedef float f32x2 __attribute__((ext_vector_type(2)));

#ifndef N_LAUNCH_MODE
#define N_LAUNCH_MODE 1
#endif

constexpr int D = 1024, SEQ = 16384, CTXL = 256, R = SEQ + CTXL;
constexpr int INC = 2560, FF = 2816, NE = 8;
constexpr int C_HX0 = 0, C_HX1 = 256, C_HV = 512, C_RQ = 768, C_RK = 1024, C_RV = 1280, C_RG = 1536, C_AQ = 1792, C_AK = 2304, C_AV = 2432;
constexpr int FN = 32768, FM = 16384;
constexpr int NCH = 130;
constexpr float EPS = 1e-6f;
constexpr float C2 = 0.125f * 1.4426950408889634f;
constexpr int NT = 512;
constexpr int MOE_MAXROWS = 34560;

constexpr size_t MiB = 1u << 20;
constexpr size_t WS_CTL = 0, CTL_BYTES = MiB;
constexpr size_t WS_MOD = 1 * MiB;
constexpr size_t WS_TW = 1 * MiB + 128 * 1024;
constexpr size_t WS_TWN = 1 * MiB + 256 * 1024;
constexpr size_t WS_XC = 2 * MiB;
constexpr size_t WS_ASGT = 3 * MiB;
constexpr size_t WS_ASGG = 3 * MiB + 512 * 1024;
constexpr size_t WS_ROWD = 4 * MiB;
constexpr size_t WS_ROWG = 4 * MiB + 256 * 1024;
constexpr size_t WS_TAPSC = 5 * MiB;
constexpr size_t WS_ZC = 5 * MiB + 512 * 1024;
constexpr size_t WS_HSPEC = 8 * MiB;
constexpr size_t WS_ZT = 72 * MiB;
constexpr size_t WS_RU = 88 * MiB;
constexpr size_t WS_WIN = 105 * MiB;
constexpr size_t WS_WOUT = 115 * MiB;
constexpr size_t WS_WGU = 119 * MiB;
constexpr size_t WS_WDN = 130 * MiB;
constexpr size_t WS_H = 136 * MiB;
constexpr size_t WS_P = 169 * MiB;
constexpr size_t WS_YMIX = 251 * MiB;
constexpr size_t WS_HID = 169 * MiB;
constexpr size_t WS_MOEW = 306 * MiB;
constexpr size_t WS_XS = 8 * MiB;
constexpr size_t WS_Y2 = 8 * MiB;
constexpr size_t WS_HIDM = 105 * MiB;
constexpr size_t WS_END = 438 * MiB;
constexpr size_t MOEW_E = (size_t)(5632 * 1024 + 1024 * 2816);
static_assert(WS_HIDM + (size_t)MOE_MAXROWS * FF * 2 <= WS_MOEW, "map");
static_assert(WS_XS + (size_t)MOE_MAXROWS * D * 2 <= WS_HIDM, "map");
static_assert(WS_MOEW + 8 * MOEW_E * 2 <= WS_END, "map");

constexpr int CW_CNT = 64;
constexpr int CW_BAR = 4096;

struct Params { const float* in[32]; float* out; unsigned char* ws; int ph_lo, ph_hi; };

__device__ __forceinline__ float bf2f(bf16 v) { return __uint_as_float((unsigned)v << 16); }
__device__ __forceinline__ unsigned f2bf(float f) { unsigned u = __float_as_uint(f); return (u + 0x7fffu + ((u >> 16) & 1u)) >> 16; }
__device__ __forceinline__ unsigned pk2(float lo, float hi) { return f2bf(lo) | (f2bf(hi) << 16); }
__device__ __forceinline__ float lo16(unsigned w) { return __uint_as_float(w << 16); }
__device__ __forceinline__ float hi16(unsigned w) { return __uint_as_float(w & 0xffff0000u); }
__device__ __forceinline__ float wave_sum(float v) {
#pragma unroll
    for (int o = 1; o < 64; o <<= 1) v += __shfl_xor(v, o);
    return v;
}
__device__ __forceinline__ float silu_f(float x) { return x / (1.f + __expf(-x)); }
__device__ __forceinline__ const float* xsrc_row(const Params& p, bool first, int row) {
    if (first) return row < SEQ ? p.in[0] + (size_t)row * D : p.in[2] + (size_t)(row - SEQ) * D;
    return row < SEQ ? p.out + (size_t)row * D : (const float*)(p.ws + WS_XC) + (size_t)(row - SEQ) * D;
}
__device__ __forceinline__ float* xdst_row(const Params& p, int row) {
    return row < SEQ ? p.out + (size_t)row * D : (float*)(p.ws + WS_XC) + (size_t)(row - SEQ) * D;
}
__device__ __forceinline__ const float* mod_vec(const Params& p, int l, int row, int j) {
    return (const float*)(p.ws + WS_MOD) + (size_t)((l * 2 + (row >= SEQ ? 1 : 0)) * 6 + j) * D;
}

__device__ __forceinline__ void ph_mod(const Params& p, float* sm, int bid, int nb) {
    const float* c = p.in[1]; const float* cc = p.in[3]; const float* W = p.in[4]; const float* B = p.in[5];
    float* MOD = (float*)(p.ws + WS_MOD);
    float* sc = sm; float* scc = sm + 1024; float* red = sm + 2048;
    const int tid = threadIdx.x;
    for (int i = tid; i < 1024; i += NT) { sc[i] = silu_f(c[i]); scc[i] = silu_f(cc[i]); }
    __syncthreads();
    for (int it = bid; it < 192; it += nb) {
        const int l = it / 96, cl = tid & 63, col = (it % 96) * 64 + cl, kg = tid >> 6;
        const float* w = W + (size_t)l * 1024 * 6144 + col;
        float a0 = 0.f, a1 = 0.f;
#pragma unroll 8
        for (int k = kg * 128; k < kg * 128 + 128; ++k) { const float wv = w[(size_t)k * 6144]; a0 += sc[k] * wv; a1 += scc[k] * wv; }
        red[(kg * 64 + cl) * 2] = a0; red[(kg * 64 + cl) * 2 + 1] = a1;
        __syncthreads();
        if (tid < 128) { const int c2 = tid & 63, s = tid >> 6; float sum = 0.f;
            for (int g = 0; g < 8; ++g) sum += red[(g * 64 + c2) * 2 + s];
            const int colg = (it % 96) * 64 + c2; MOD[(size_t)(l * 2 + s) * 6144 + colg] = sum + B[l * 6144 + colg]; }
        __syncthreads();
    }
}
__device__ __forceinline__ void ph_tw(const Params& p, int bid, int nb) {
    f32x2* TW = (f32x2*)(p.ws + WS_TW); f32x2* TWN = (f32x2*)(p.ws + WS_TWN);
    for (int k = bid * NT + threadIdx.x; k <= FM / 2; k += nb * NT) {
        float s, c;
        if (k < FM / 2) { const float x = (float)k * (2.0f / FM); s = sinpif(x); c = cospif(x); TW[k] = (f32x2){c, -s}; }
        { const float x = (float)k * (2.0f / FN); s = sinpif(x); c = cospif(x); TWN[k] = (f32x2){c, -s}; }
    }
}
__device__ __forceinline__ void transpose_item(const float* W, int K, int N, bf16* WT, int drow0, int k0, int n0, float* scr, int lane) {
#pragma unroll 8
    for (int i = 0; i < 32; ++i) { const int kk = 2 * i + (lane >> 5); scr[kk * 33 + (lane & 31)] = W[(size_t)(k0 + kk) * N + n0 + (lane & 31)]; }
    asm volatile("s_waitcnt vmcnt(0) lgkmcnt(0)" ::: "memory");
    const int c = lane & 7;
#pragma unroll
    for (int j = 0; j < 4; ++j) { const int n = (lane >> 3) + 8 * j; const float* s = scr + (8 * c) * 33 + n;
        u32x4 o; o.x = pk2(s[0 * 33], s[1 * 33]); o.y = pk2(s[2 * 33], s[3 * 33]); o.z = pk2(s[4 * 33], s[5 * 33]); o.w = pk2(s[6 * 33], s[7 * 33]);
        *(u32x4*)(WT + (size_t)(drow0 + n) * K + k0 + 8 * c) = o; }
    asm volatile("s_waitcnt lgkmcnt(0)" ::: "memory");
}
__device__ __forceinline__ int gu_row(int n, int up) { return (n >> 7) * 256 + (n & 127) + (up ? 128 : 0); }
__device__ __forceinline__ void ph_wconv(const Params& p, float* sm, int bid, int nb) {
    const int lane = threadIdx.x & 63, wave = threadIdx.x >> 6;
    float* scr = sm + wave * (64 * 33);
    const int gw = bid * 8 + wave, NGW = nb * 8;
    constexpr int I_IN = 16 * 80, I_OUT = 16 * 32, I_GU = 16 * 88, I_DN = 44 * 32;
    constexpr int PER_FFN = 3 * I_GU;
    static_assert(I_DN == I_GU, "");
    constexpr int NITEMS = 2 * I_IN + 2 * I_OUT + 9 * PER_FFN;
    for (int it = gw; it < NITEMS; it += NGW) {
        int r = it;
        if (r < 2 * I_IN) { const int l = r / I_IN; r %= I_IN; const int kb = r / 80, nb2 = r % 80;
            transpose_item(p.in[8] + (size_t)l * D * INC, D, INC, (bf16*)(p.ws + WS_WIN) + (size_t)l * INC * D, nb2 * 32, kb * 64, nb2 * 32, scr, lane); continue; }
        r -= 2 * I_IN;
        if (r < 2 * I_OUT) { const int l = r / I_OUT; r %= I_OUT; const int kb = r / 32, nb2 = r % 32;
            transpose_item(p.in[9] + (size_t)l * D * D, D, D, (bf16*)(p.ws + WS_WOUT) + (size_t)l * D * D, nb2 * 32, kb * 64, nb2 * 32, scr, lane); continue; }
        r -= 2 * I_OUT;
        const int f = r / PER_FFN; r %= PER_FFN;
        const int which = r / I_GU; r %= I_GU;
        const float* src; bf16* dgu; bf16* ddn;
        if (f == 0) { src = p.in[23 + which]; dgu = (bf16*)(p.ws + WS_WGU); ddn = (bf16*)(p.ws + WS_WDN); }
        else { src = p.in[28 + which] + (size_t)(f - 1) * D * FF; dgu = (bf16*)(p.ws + WS_MOEW) + (size_t)(f - 1) * MOEW_E; ddn = dgu + (size_t)5632 * 1024; }
        if (which < 2) { const int kb = r / 88, nb2 = r % 88; transpose_item(src, D, FF, dgu, gu_row(nb2 * 32, which), kb * 64, nb2 * 32, scr, lane); }
        else { const int kb = r / 32, nb2 = r % 32; transpose_item(src, FF, D, ddn, nb2 * 32, kb * 64, nb2 * 32, scr, lane); }
    }
}
__device__ __forceinline__ void ph_filt(const Params& p, float* sm, int bid, int nb) {
    const float dlo = -4.605170185988091f / 1.5f, dhi = -4.605170185988091f / 0.3f;
    float* col = sm + threadIdx.x;
    for (int it = bid; it < 260; it += nb) {
        int which, chunk, q;
        if (it < 256) { which = it >> 7; chunk = (it & 127) >> 2; q = it & 3; } else { which = 2; chunk = 0; q = it - 256; }
        const int l = (which == 2) ? 0 : which; const int Lf = (which == 2) ? CTXL : SEQ; const int NN = 2 * Lf;
        const int n = chunk * NT + threadIdx.x;
        if (n >= Lf) continue;
        float* taps = (which == 2) ? (float*)(p.ws + WS_TAPSC) : (float*)(p.ws + WS_HSPEC) + (size_t)which * 256 * FN;
        const float* w1 = p.in[12] + l * 33 * 64; const float* b1 = p.in[13] + l * 64; const float* w2 = p.in[14] + l * 4096; const float* b2 = p.in[15] + l * 64;
        const float* w3 = p.in[16] + l * 64 * 512; const float* b3 = p.in[17] + l * 512; const float* fr = p.in[18] + l * 64;
        const float t = (float)n / (float)(Lf - 1);
        float feat[33]; feat[0] = t;
#pragma unroll
        for (int b = 0; b < 16; ++b) { const float band = 1e-4f + (float)b * ((15.f - 1e-4f) / 15.f);
            const float rev2 = (2.0f / (float)Lf) * (float)n * band; feat[1 + b] = cospif(rev2); feat[17 + b] = -sinpif(rev2); }
#pragma unroll 1
        for (int j = 0; j < 64; ++j) { float a = b1[j];
#pragma unroll
            for (int i = 0; i < 33; ++i) a += feat[i] * w1[i * 64 + j];
            col[j * NT] = sinpif(fr[j] * a * 0.3183098861837907f); }
        float acc[64];
#pragma unroll
        for (int j = 0; j < 64; ++j) acc[j] = b2[j];
#pragma unroll 1
        for (int i = 0; i < 64; ++i) { const float x = col[i * NT];
#pragma unroll
            for (int j = 0; j < 64; ++j) acc[j] += x * w2[i * 64 + j]; }
#pragma unroll
        for (int j = 0; j < 64; ++j) col[j * NT] = acc[j];
#pragma unroll 1
        for (int j = 0; j < 64; ++j) col[j * NT] = sinpif(fr[j] * col[j * NT] * 0.3183098861837907f);
#pragma unroll
        for (int j = 0; j < 64; ++j) acc[j] = col[j * NT];
#pragma unroll 1
        for (int j = q * 128; j < q * 128 + 128; ++j) { float a = b3[j];
#pragma unroll
            for (int i = 0; i < 64; ++i) a += acc[i] * w3[i * 512 + j];
            const int dir = j >> 8, ch = j & 255;
            const float delta = fabsf(dlo + (float)ch * ((dhi - dlo) / 255.f));
            a *= __expf(-t * delta);
            if (dir == 0) taps[(size_t)ch * NN + n] = a;
            else { if (n >= 1) taps[(size_t)ch * NN + NN - n] = a; else taps[(size_t)ch * NN + Lf] = 0.f; } }
    }
}

__device__ __forceinline__ int brev14(int k) { return (int)(__brev((unsigned)k) >> 18); }
__device__ __forceinline__ void fft_dif(f32x2* buf, const f32x2* TW) {
    for (int half = FM / 2; half >= 1; half >>= 1) {
        const int tws = (FM / 2) / half;
        for (int j = threadIdx.x; j < FM / 2; j += NT) { const int pos = j & (half - 1), i0 = ((j - pos) << 1) + pos, i1 = i0 + half;
            const f32x2 u = buf[i0], v = buf[i1], w = TW[pos * tws]; const f32x2 d = u - v;
            buf[i0] = u + v; buf[i1] = (f32x2){d.x * w.x - d.y * w.y, d.x * w.y + d.y * w.x}; }
        __syncthreads();
    }
}
__device__ __forceinline__ void fft_dit_inv(f32x2* buf, const f32x2* TW) {
    for (int half = 1; half <= FM / 2; half <<= 1) {
        const int tws = (FM / 2) / half;
        for (int j = threadIdx.x; j < FM / 2; j += NT) { const int pos = j & (half - 1), i0 = ((j - pos) << 1) + pos, i1 = i0 + half;
            const f32x2 u = buf[i0], b = buf[i1], w = TW[pos * tws];
            const f32x2 v = (f32x2){b.x * w.x + b.y * w.y, b.y * w.x - b.x * w.y};
            buf[i0] = u + v; buf[i1] = u - v; }
        __syncthreads();
    }
}
__device__ __forceinline__ void ph_hfft(const Params& p, float* sm, int bid, int nb) {
    f32x2* buf = (f32x2*)sm; float* red = sm + 2 * FM;
    const f32x2* TW = (const f32x2*)(p.ws + WS_TW); const f32x2* TWN = (const f32x2*)(p.ws + WS_TWN);
    const int tid = threadIdx.x;
    for (int u = bid; u < 512; u += nb) {
        f32x2* g = (f32x2*)((float*)(p.ws + WS_HSPEC) + (size_t)u * FN);
        float asum = 0.f;
        for (int n = tid; n < FM; n += NT) { const f32x2 v = g[n]; buf[n] = v; asum += fabsf(v.x) + fabsf(v.y); }
        asum = wave_sum(asum);
        if ((tid & 63) == 0) red[tid >> 6] = asum;
        __syncthreads();
        float tot = 0.f;
#pragma unroll
        for (int w = 0; w < 8; ++w) tot += red[w];
        const float sc = 0.5f / (tot + EPS);
        fft_dif(buf, TW);
        for (int k = tid; k <= FM / 2; k += NT) {
            if (k == 0) { const f32x2 a = buf[0]; g[0] = (f32x2){(a.x + a.y) * 2.f * sc, (a.x - a.y) * 2.f * sc}; continue; }
            const int kk = FM - k; const f32x2 a = buf[brev14(k)], b = buf[brev14(kk)], w = TWN[k];
            const f32x2 E = (f32x2){a.x + b.x, a.y - b.y}, O = (f32x2){a.y + b.y, b.x - a.x};
            const f32x2 T = (f32x2){w.x * O.x - w.y * O.y, w.x * O.y + w.y * O.x};
            g[k] = (f32x2){(E.x + T.x) * sc, (E.y + T.y) * sc};
            g[kk] = (f32x2){(E.x - T.x) * sc, -(E.y - T.y) * sc};
        }
        __syncthreads();
    }
}
__device__ __forceinline__ void hconv_unit(const Params& p, int l, int ch, float* sm) {
    f32x2* buf = (f32x2*)sm;
    const f32x2* TW = (const f32x2*)(p.ws + WS_TW); const f32x2* TWN = (const f32x2*)(p.ws + WS_TWN);
    const f32x2* H = (const f32x2*)((const float*)(p.ws + WS_HSPEC) + (size_t)(l * 256 + ch) * FN);
    f32x2* z = (f32x2*)((float*)(p.ws + WS_ZT) + (size_t)ch * SEQ);
    const int tid = threadIdx.x;
    for (int n = tid; n < FM; n += NT) buf[n] = (n < SEQ / 2) ? z[n] : (f32x2){0.f, 0.f};
    __syncthreads();
    fft_dif(buf, TW);
    for (int k = tid; k <= FM / 2; k += NT) {
        if (k == 0) { const f32x2 a = buf[0], h = H[0]; const float y0 = (a.x + a.y) * h.x, ym = (a.x - a.y) * h.y; buf[0] = (f32x2){0.5f * (y0 + ym), 0.5f * (y0 - ym)}; continue; }
        const int kk = FM - k, rk = brev14(k), rkk = brev14(kk);
        const f32x2 a = buf[rk], b = buf[rkk], w = TWN[k], hk = H[k], hkk = H[kk];
        const f32x2 E = (f32x2){0.5f * (a.x + b.x), 0.5f * (a.y - b.y)}, O = (f32x2){0.5f * (a.y + b.y), 0.5f * (b.x - a.x)};
        const f32x2 T = (f32x2){w.x * O.x - w.y * O.y, w.x * O.y + w.y * O.x};
        const f32x2 Xk = E + T, Xkk = (f32x2){E.x - T.x, -(E.y - T.y)};
        const f32x2 Yk = (f32x2){Xk.x * hk.x - Xk.y * hk.y, Xk.x * hk.y + Xk.y * hk.x};
        const f32x2 Ykk = (f32x2){Xkk.x * hkk.x - Xkk.y * hkk.y, Xkk.x * hkk.y + Xkk.y * hkk.x};
        const f32x2 Ey = (f32x2){0.5f * (Yk.x + Ykk.x), 0.5f * (Yk.y - Ykk.y)};
        const f32x2 Dy = (f32x2){0.5f * (Yk.x - Ykk.x), 0.5f * (Yk.y + Ykk.y)};
        const f32x2 Oy = (f32x2){w.x * Dy.x + w.y * Dy.y, w.x * Dy.y - w.y * Dy.x};
        buf[rk] = (f32x2){Ey.x - Oy.y, Ey.y + Oy.x};
        if (kk != k) buf[rkk] = (f32x2){Ey.x + Oy.y, -(Ey.y - Oy.x)};
    }
    __syncthreads();
    fft_dit_inv(buf, TW);
    const float inv = 1.f / (float)FM;
    for (int n = tid; n < SEQ / 2; n += NT) { const f32x2 v = buf[n]; z[n] = (f32x2){v.x * inv, v.y * inv}; }
    __syncthreads();
}
__device__ __forceinline__ void hconv_ctx_unit(const Params& p, int ch, float* sm) {
    float* zc = (float*)(p.ws + WS_ZC) + ch * CTXL; const float* tc = (const float*)(p.ws + WS_TAPSC) + ch * 512;
    float* zs = sm; float* ts = sm + 256; float* red = sm + 768;
    const int tid = threadIdx.x;
    if (tid < 256) zs[tid] = zc[tid];
    const float tv = tc[tid]; ts[tid] = tv;
    const float a = wave_sum(fabsf(tv)); if ((tid & 63) == 0) red[tid >> 6] = a;
    __syncthreads();
    if (tid < 256) { float tot = 0.f;
#pragma unroll
        for (int w = 0; w < 8; ++w) tot += red[w];
        float acc = 0.f;
        for (int m = 0; m < 256; ++m) { const int lag = tid - m; acc += zs[m] * ts[lag >= 0 ? lag : 512 + lag]; }
        zc[tid] = acc / (tot + EPS); }
    __syncthreads();
}

__device__ __forceinline__ void ph_norm(const Params& p, int l, int which, bool first, int nrows, bool route, int bid, int nb) {
    const int lane = threadIdx.x & 63, wave = threadIdx.x >> 6;
    const float* g = p.in[which ? 7 : 6] + l * D;
    bf16* H = (bf16*)(p.ws + WS_H);
    for (int row = bid * 8 + wave; row < nrows; row += nb * 8) {
        const f32x4* xr = (const f32x4*)xsrc_row(p, first, row) + lane;
        const f32x4* sh = (const f32x4*)mod_vec(p, l, row, which ? 3 : 0) + lane; const f32x4* scv = (const f32x4*)mod_vec(p, l, row, which ? 4 : 1) + lane;
        f32x4 v[4]; float ss = 0.f;
#pragma unroll
        for (int j = 0; j < 4; ++j) { v[j] = xr[64 * j]; ss += (v[j].x * v[j].x + v[j].y * v[j].y) + (v[j].z * v[j].z + v[j].w * v[j].w); }
        const float r = rsqrtf(wave_sum(ss) * (1.f / D) + EPS);
        u32x2* o8 = (u32x2*)(H + (size_t)row * D) + lane;
#pragma unroll
        for (int j = 0; j < 4; ++j) { const f32x4 gg = ((const f32x4*)g)[lane + 64 * j], s1 = scv[64 * j], s0 = sh[64 * j];
            v[j] = v[j] * r * gg * (s1 + 1.f) + s0;
            o8[64 * j] = (u32x2){pk2(v[j].x, v[j].y), pk2(v[j].z, v[j].w)}; }
        if (route) {
            const float* rw = p.in[26]; const float* rb = p.in[27];
            float lg[8];
#pragma unroll
            for (int e = 0; e < 8; ++e) lg[e] = 0.f;
#pragma unroll
            for (int j = 0; j < 4; ++j)
#pragma unroll
                for (int i = 0; i < 4; ++i) { const int d = 4 * lane + 256 * j + i; const float hv = v[j][i];
                    const f32x4 w0 = *(const f32x4*)(rw + d * 8), w1 = *(const f32x4*)(rw + d * 8 + 4);
                    lg[0] += hv * w0.x; lg[1] += hv * w0.y; lg[2] += hv * w0.z; lg[3] += hv * w0.w; lg[4] += hv * w1.x; lg[5] += hv * w1.y; lg[6] += hv * w1.z; lg[7] += hv * w1.w; }
#pragma unroll
            for (int e = 0; e < 8; ++e) lg[e] = wave_sum(lg[e]) + rb[e];
            int i1 = 0; float v1 = lg[0];
#pragma unroll
            for (int e = 1; e < 8; ++e) if (lg[e] > v1) { v1 = lg[e]; i1 = e; }
            int i2 = -1; float v2 = -3.0e38f;
#pragma unroll
            for (int e = 0; e < 8; ++e) if (e != i1 && lg[e] > v2) { v2 = lg[e]; i2 = e; }
            const float ex = __expf(v2 - v1), g1 = 1.f / (1.f + ex), g2 = ex * g1;
            if (lane == 0) {
                unsigned* cnt = (unsigned*)(p.ws + WS_CTL) + CW_CNT;
                int* at = (int*)(p.ws + WS_ASGT); float* ag = (float*)(p.ws + WS_ASGG);
                const unsigned p1 = atomicAdd(&cnt[i1], 1u); at[i1 * SEQ + p1] = row * 2; ag[i1 * SEQ + p1] = g1;
                const unsigned p2 = atomicAdd(&cnt[i2], 1u); at[i2 * SEQ + p2] = row * 2 + 1; ag[i2 * SEQ + p2] = g2;
            }
        }
    }
}

template <class Epi, bool DUAL>
__device__ __forceinline__ void gemm_naive(const bf16* A, const bf16* Bt, int K, int mtiles, int ntiles, const Epi& E, float* sm, int bid, int nb) {
    float* As = sm; float* Bs = sm + 32 * 132; float* Bs2 = Bs + 32 * 68;
    const int tid = threadIdx.x, ty = tid >> 4, tx = tid & 15;
    for (int tile = bid; tile < mtiles * ntiles; tile += nb) {
        const int mt = tile / ntiles, nt = tile % ntiles;
        const bf16* Ab = A + (size_t)mt * 128 * K;
        const int brow = DUAL ? gu_row(nt * 64, 0) : nt * 64;
        const bf16* Bb = E.bt(Bt, mt) + (size_t)brow * K;
        float acc[4][4], acu[4][4];
#pragma unroll
        for (int i = 0; i < 4; ++i)
#pragma unroll
            for (int j = 0; j < 4; ++j) { acc[i][j] = 0.f; acu[i][j] = 0.f; }
        for (int k0 = 0; k0 < K; k0 += 32) {
            { const int row = tid >> 2, kc = (tid & 3) * 8; const u32x4 w = *(const u32x4*)(Ab + (size_t)row * K + k0 + kc);
              As[(kc + 0) * 132 + row] = lo16(w.x); As[(kc + 1) * 132 + row] = hi16(w.x); As[(kc + 2) * 132 + row] = lo16(w.y); As[(kc + 3) * 132 + row] = hi16(w.y);
              As[(kc + 4) * 132 + row] = lo16(w.z); As[(kc + 5) * 132 + row] = hi16(w.z); As[(kc + 6) * 132 + row] = lo16(w.w); As[(kc + 7) * 132 + row] = hi16(w.w); }
            if (tid < 256 || DUAL) { const int t2 = tid & 255; const int row = t2 >> 2, kc = (t2 & 3) * 8; float* dst = (tid < 256) ? Bs : Bs2;
              const u32x4 w = *(const u32x4*)(Bb + (size_t)(row + (tid < 256 ? 0 : 128)) * K + k0 + kc);
              dst[(kc + 0) * 68 + row] = lo16(w.x); dst[(kc + 1) * 68 + row] = hi16(w.x); dst[(kc + 2) * 68 + row] = lo16(w.y); dst[(kc + 3) * 68 + row] = hi16(w.y);
              dst[(kc + 4) * 68 + row] = lo16(w.z); dst[(kc + 5) * 68 + row] = hi16(w.z); dst[(kc + 6) * 68 + row] = lo16(w.w); dst[(kc + 7) * 68 + row] = hi16(w.w); }
            __syncthreads();
#pragma unroll 8
            for (int kk = 0; kk < 32; ++kk) { const f32x4 a = *(const f32x4*)&As[kk * 132 + ty * 4]; const f32x4 b = *(const f32x4*)&Bs[kk * 68 + tx * 4];
#pragma unroll
                for (int i = 0; i < 4; ++i)
#pragma unroll
                    for (int j = 0; j < 4; ++j) acc[i][j] += a[i] * b[j];
                if (DUAL) { const f32x4 b2 = *(const f32x4*)&Bs2[kk * 68 + tx * 4];
#pragma unroll
                    for (int i = 0; i < 4; ++i)
#pragma unroll
                        for (int j = 0; j < 4; ++j) acu[i][j] += a[i] * b2[j]; } }
            __syncthreads();
        }
#pragma unroll
        for (int i = 0; i < 4; ++i) E.store(mt * 128 + ty * 4 + i, nt * 64 + tx * 4, acc[i], acu[i]);
    }
}
struct EpiP {
    bf16* P;
    __device__ __forceinline__ const bf16* bt(const bf16* b, int) const { return b; }
    __device__ __forceinline__ void store(int row, int col, const float* a, const float*) const { *(u32x2*)(P + (size_t)row * INC + col) = (u32x2){pk2(a[0], a[1]), pk2(a[2], a[3])}; }
};
struct EpiRes {
    const Params* p; int l, gj; bool first;
    __device__ __forceinline__ const bf16* bt(const bf16* b, int) const { return b; }
    __device__ __forceinline__ void store(int row, int col, const float* a, const float*) const {
        const f32x4 s = *(const f32x4*)(xsrc_row(*p, first, row) + col), m = *(const f32x4*)(mod_vec(*p, l, row, gj) + col);
        *(f32x4*)(xdst_row(*p, row) + col) = (f32x4){s.x + m.x * a[0], s.y + m.y * a[1], s.z + m.z * a[2], s.w + m.w * a[3]}; }
};
struct EpiSwi {
    bf16* Hd; const int* tile_e;
    __device__ __forceinline__ const bf16* bt(const bf16* b, int mt) const { return tile_e ? b + (size_t)tile_e[mt] * MOEW_E : b; }
    __device__ __forceinline__ void store(int row, int col, const float* a, const float* u) const {
        *(u32x2*)(Hd + (size_t)row * FF + col) = (u32x2){pk2(silu_f(a[0]) * u[0], silu_f(a[1]) * u[1]), pk2(silu_f(a[2]) * u[2], silu_f(a[3]) * u[3])}; }
};
struct EpiMoeDown {
    bf16* Y2; const int* rowd; const float* rowg; const int* tile_e;
    __device__ __forceinline__ const bf16* bt(const bf16* b, int mt) const { return b + (size_t)tile_e[mt] * MOEW_E; }
    __device__ __forceinline__ void store(int row, int col, const float* a, const float*) const {
        const int d = rowd[row]; if (d < 0) return; const float g = rowg[row];
        *(u32x2*)(Y2 + (size_t)d * D + col) = (u32x2){pk2(a[0] * g, a[1] * g), pk2(a[2] * g, a[3] * g)}; }
};

__device__ __forceinline__ void prep_qk(const Params& p, int l, int nrows, int bid, int nb) {
    const int lane = threadIdx.x & 63, wave = threadIdx.x >> 6;
    bf16* P = (bf16*)(p.ws + WS_P);
    const float gq = p.in[21][l * 64 + lane], gk = p.in[22][l * 64 + lane];
    const int sec = lane >> 5, j = lane & 31, i = j & 15;
    const float invf = exp2f(-(float)i * (13.287712379549449f / 16.f));
    for (int row = bid * 8 + wave; row < nrows; row += nb * 8) {
        float cs = 1.f, sn = 0.f;
        if (row < SEQ) { const float pos = (float)(sec ? (row & 63) : (row >> 6)); const float x = pos * invf * 0.3183098861837907f; sn = sinpif(x); cs = cospif(x); }
        bf16* pr = P + (size_t)row * INC;
#pragma unroll
        for (int hv = 0; hv < 10; ++hv) {
            const int off = (hv < 8) ? C_AQ + hv * 64 : C_AK + (hv - 8) * 64;
            const float v = bf2f(pr[off + lane]);
            const float ss = wave_sum(v * v);
            float y = v * rsqrtf(ss * (1.f / 64.f) + EPS) * (hv < 8 ? gq : gk);
            const float o = __shfl_xor(y, 16);
            y = (j < 16) ? y * cs - o * sn : y * cs + o * sn;
            if (hv < 8) y *= C2;
            pr[off + lane] = (bf16)f2bf(y);
        }
    }
}
__device__ __forceinline__ float conv3(const bf16* P, const float* cw, const float* cb, int t, int lo, int hi, int col) {
    float a = cb[col] + cw[768 + col] * bf2f(P[(size_t)t * INC + col]);
    if (t - 1 >= lo) a += cw[col] * bf2f(P[(size_t)(t - 1) * INC + col]);
    if (t + 1 < hi) a += cw[1536 + col] * bf2f(P[(size_t)(t + 1) * INC + col]);
    return a;
}
__device__ __forceinline__ void prep_hyz(const Params& p, int l, bool with_ctx, float* sm, int bid, int nb) {
    const bf16* P = (const bf16*)(p.ws + WS_P);
    const float* cw = p.in[10] + l * 3 * 768; const float* cb = p.in[11] + l * 768;
    const int ntile = with_ctx ? 260 : 256, tid = threadIdx.x;
    for (int tile = bid; tile < ntile; tile += nb) {
        const int t0 = tile * 64; const int lo = tile < 256 ? 0 : SEQ, hi = tile < 256 ? SEQ : R;
        for (int e = tid; e < 64 * 256; e += NT) { const int tl = e >> 8, ch = e & 255;
            sm[ch * 65 + tl] = conv3(P, cw, cb, t0 + tl, lo, hi, C_HX1 + ch) * conv3(P, cw, cb, t0 + tl, lo, hi, C_HV + ch); }
        __syncthreads();
        for (int e = tid; e < 64 * 256; e += NT) { const int ch = e >> 6, tl = e & 63;
            if (tile < 256) ((float*)(p.ws + WS_ZT))[(size_t)ch * SEQ + t0 + tl] = sm[ch * 65 + tl];
            else ((float*)(p.ws + WS_ZC))[ch * CTXL + (t0 - SEQ) + tl] = sm[ch * 65 + tl]; }
        __syncthreads();
    }
}
__device__ __forceinline__ void prep_retu(const Params& p, int l, float* sm, int bid, int nb) {
    const bf16* P = (const bf16*)(p.ws + WS_P);
    float* Ks = sm; float* Vs = sm + 8192; float* wf = sm + 16384; float* wb = wf + 128;
    const int tid = threadIdx.x;
    for (int it = bid; it < NCH * 4; it += nb) {
        const int c = it >> 2, h = it & 3; const int r0 = c * 128;
        const float lgf = -__expf(p.in[20][l * 8 + h]), lgb = -__expf(p.in[20][l * 8 + 4 + h]);
        if (tid < 128) { wf[tid] = __expf(lgf * (float)(127 - tid)); wb[tid] = __expf(lgb * (float)tid); }
        for (int e = tid; e < 128 * 64; e += NT) { const int m = e >> 6, d = e & 63; const bf16* pr = P + (size_t)(r0 + m) * INC + h * 64 + d;
            Ks[e] = bf2f(pr[C_RK]) * 0.125f; Vs[e] = bf2f(pr[C_RV]); }
        __syncthreads();
        const int d = tid >> 3, e0 = (tid & 7) * 8;
        float af[8], ab[8];
#pragma unroll
        for (int j = 0; j < 8; ++j) { af[j] = 0.f; ab[j] = 0.f; }
        for (int m = 0; m < 128; ++m) { const float kd = Ks[m * 64 + d], kf = kd * wf[m], kb = kd * wb[m];
            const f32x4 v0 = *(const f32x4*)&Vs[m * 64 + e0], v1 = *(const f32x4*)&Vs[m * 64 + e0 + 4];
#pragma unroll
            for (int j = 0; j < 4; ++j) { af[j] += kf * v0[j]; ab[j] += kb * v0[j]; af[4 + j] += kf * v1[j]; ab[4 + j] += kb * v1[j]; } }
        float* U = (float*)(p.ws + WS_RU);
        float* uf = U + ((size_t)(0 * 4 + h) * NCH + c) * 4096 + d * 64 + e0; float* ub = U + ((size_t)(1 * 4 + h) * NCH + c) * 4096 + d * 64 + e0;
        *(f32x4*)uf = (f32x4){af[0], af[1], af[2], af[3]}; *(f32x4*)(uf + 4) = (f32x4){af[4], af[5], af[6], af[7]};
        *(f32x4*)ub = (f32x4){ab[0], ab[1], ab[2], ab[3]}; *(f32x4*)(ub + 4) = (f32x4){ab[4], ab[5], ab[6], ab[7]};
        __syncthreads();
    }
}
__device__ __forceinline__ void ph_retscan(const Params& p, int l, int bid, int nb) {
    float* U = (float*)(p.ws + WS_RU);
    for (int g = bid * NT + threadIdx.x; g < 8 * 4096; g += nb * NT) {
        const int dir = g >> 14, h = (g >> 12) & 3, e = g & 4095;
        const float lg = -__expf(p.in[20][l * 8 + dir * 4 + h]); const float Dc = __expf(lg * 128.f);
        float* u = U + (size_t)(dir * 4 + h) * NCH * 4096 + e;
        const float uc0 = u[(size_t)128 * 4096], uc1 = u[(size_t)129 * 4096];
        if (dir == 0) {
            float s = Dc * uc0 + uc1; u[(size_t)128 * 4096] = 0.f; u[(size_t)129 * 4096] = uc0;
            for (int c = 0; c < 128; ++c) { const float t = u[(size_t)c * 4096]; u[(size_t)c * 4096] = s; s = Dc * s + t; }
        } else {
            float s = uc0 + Dc * uc1; u[(size_t)129 * 4096] = 0.f; u[(size_t)128 * 4096] = uc1;
            for (int c = 127; c >= 0; --c) { const float t = u[(size_t)c * 4096]; u[(size_t)c * 4096] = s; s = Dc * s + t; }
        }
    }
}

__device__ __forceinline__ void post_ret(const Params& p, int l, int nchunks, unsigned char* smb, int bid, int nb) {
    const bf16* P = (const bf16*)(p.ws + WS_P); bf16* Y = (bf16*)(p.ws + WS_YMIX);
    bf16* Qs = (bf16*)smb; bf16* Ks = Qs + 128 * 72; bf16* Vs = Ks + 128 * 72; float* S = (float*)(smb + 3 * 128 * 72 * 2); float* pf = S + 128 * 132; float* pb = pf + 128;
    const int tid = threadIdx.x;
    for (int it = bid; it < nchunks * 4; it += nb) {
        const int c = it >> 2, h = it & 3, r0 = c * 128;
        const float lgf = -__expf(p.in[20][l * 8 + h]), lgb = -__expf(p.in[20][l * 8 + 4 + h]);
        if (tid < 128) { pf[tid] = __expf(lgf * (float)tid); pb[tid] = __expf(lgb * (float)tid); }
        for (int e = tid; e < 128 * 8; e += NT) { const int m = e >> 3, dc = e & 7; const bf16* pr = P + (size_t)(r0 + m) * INC + h * 64 + dc * 8;
            *(u32x4*)(Qs + m * 72 + dc * 8) = *(const u32x4*)(pr + C_RQ); *(u32x4*)(Ks + m * 72 + dc * 8) = *(const u32x4*)(pr + C_RK); *(u32x4*)(Vs + m * 72 + dc * 8) = *(const u32x4*)(pr + C_RV); }
        __syncthreads();
        {
            const int tn = tid >> 4, tm = tid & 15;
            float acc[4][8];
#pragma unroll
            for (int i = 0; i < 4; ++i)
#pragma unroll
                for (int j = 0; j < 8; ++j) acc[i][j] = 0.f;
            for (int dc = 0; dc < 8; ++dc) {
                u32x4 q[4], k[8];
#pragma unroll
                for (int i = 0; i < 4; ++i) q[i] = *(const u32x4*)(Qs + (tn + 32 * i) * 72 + dc * 8);
#pragma unroll
                for (int j = 0; j < 8; ++j) k[j] = *(const u32x4*)(Ks + (tm + 16 * j) * 72 + dc * 8);
#pragma unroll
                for (int i = 0; i < 4; ++i)
#pragma unroll
                    for (int j = 0; j < 8; ++j)
#pragma unroll
                        for (int w = 0; w < 4; ++w) acc[i][j] += lo16(q[i][w]) * lo16(k[j][w]) + hi16(q[i][w]) * hi16(k[j][w]);
            }
#pragma unroll
            for (int i = 0; i < 4; ++i)
#pragma unroll
                for (int j = 0; j < 8; ++j) { const int n = tn + 32 * i, m = tm + 16 * j;
                    const float f = (n > m) ? pf[n - m] : ((n < m) ? pb[m - n] : 2.f);
                    S[n * 132 + m] = acc[i][j] * 0.125f * f; }
        }
        __syncthreads();
        {
            const int n = tid >> 2, eq = tid & 3;
            float acc[16];
#pragma unroll
            for (int e = 0; e < 16; ++e) acc[e] = 0.f;
            for (int m = 0; m < 128; ++m) { const float sv = S[n * 132 + m];
                const u32x4 v0 = *(const u32x4*)(Vs + m * 72 + eq * 16), v1 = *(const u32x4*)(Vs + m * 72 + eq * 16 + 8);
#pragma unroll
                for (int w = 0; w < 4; ++w) { acc[2 * w] += sv * lo16(v0[w]); acc[2 * w + 1] += sv * hi16(v0[w]); acc[8 + 2 * w] += sv * lo16(v1[w]); acc[9 + 2 * w] += sv * hi16(v1[w]); } }
            const float* SPf = (const float*)(p.ws + WS_RU) + ((size_t)(0 * 4 + h) * NCH + c) * 4096 + eq * 16;
            const float* SPb = (const float*)(p.ws + WS_RU) + ((size_t)(1 * 4 + h) * NCH + c) * 4096 + eq * 16;
            const float xif = pf[n] * pf[1], xib = pb[127 - n] * pb[1];
            for (int d = 0; d < 64; ++d) { const float qd = bf2f(Qs[n * 72 + d]), qf = qd * xif, qb = qd * xib;
#pragma unroll
                for (int w = 0; w < 4; ++w) { const f32x4 a = *(const f32x4*)(SPf + d * 64 + 4 * w), b = *(const f32x4*)(SPb + d * 64 + 4 * w);
                    acc[4 * w] += qf * a.x + qb * b.x; acc[4 * w + 1] += qf * a.y + qb * b.y; acc[4 * w + 2] += qf * a.z + qb * b.z; acc[4 * w + 3] += qf * a.w + qb * b.w; } }
            float s = 0.f;
#pragma unroll
            for (int e = 0; e < 16; ++e) s += acc[e];
            s += __shfl_xor(s, 1); s += __shfl_xor(s, 2);
            const float mu = s * (1.f / 64.f); float vs = 0.f;
#pragma unroll
            for (int e = 0; e < 16; ++e) { acc[e] -= mu; vs += acc[e] * acc[e]; }
            vs += __shfl_xor(vs, 1); vs += __shfl_xor(vs, 2);
            const float rs = rsqrtf(vs * (1.f / 64.f) + EPS);
            const bf16* gr = P + (size_t)(r0 + n) * INC + C_RG + h * 64 + eq * 16;
            const u32x4 g0 = *(const u32x4*)gr, g1 = *(const u32x4*)(gr + 8);
            u32x4 o0, o1;
#pragma unroll
            for (int w = 0; w < 4; ++w) { o0[w] = pk2(silu_f(lo16(g0[w])) * acc[2 * w] * rs, silu_f(hi16(g0[w])) * acc[2 * w + 1] * rs);
                o1[w] = pk2(silu_f(lo16(g1[w])) * acc[8 + 2 * w] * rs, silu_f(hi16(g1[w])) * acc[9 + 2 * w] * rs); }
            bf16* yo = Y + (size_t)(r0 + n) * D + 256 + h * 64 + eq * 16;
            *(u32x4*)yo = o0; *(u32x4*)(yo + 8) = o1;
        }
        __syncthreads();
    }
}
__device__ __forceinline__ void post_hy(const Params& p, int l, bool with_ctx, float* sm, int bid, int nb) {
    const bf16* P = (const bf16*)(p.ws + WS_P); bf16* Y = (bf16*)(p.ws + WS_YMIX);
    const float* cw = p.in[10] + l * 3 * 768; const float* cb = p.in[11] + l * 768; const float* hb = p.in[19] + l * 256;
    const int ntile = with_ctx ? 260 : 256, tid = threadIdx.x;
    for (int tile = bid; tile < ntile; tile += nb) {
        const int t0 = tile * 64; const int lo = tile < 256 ? 0 : SEQ, hi = tile < 256 ? SEQ : R;
        for (int e = tid; e < 64 * 256; e += NT) { const int ch = e >> 6, tl = e & 63;
            sm[ch * 65 + tl] = (tile < 256) ? ((const float*)(p.ws + WS_ZT))[(size_t)ch * SEQ + t0 + tl] : ((const float*)(p.ws + WS_ZC))[ch * CTXL + (t0 - SEQ) + tl]; }
        __syncthreads();
        for (int e = tid; e < 64 * 256; e += NT) { const int tl = e >> 8, ch = e & 255, t = t0 + tl;
            const float x0 = conv3(P, cw, cb, t, lo, hi, C_HX0 + ch), z = conv3(P, cw, cb, t, lo, hi, C_HX1 + ch) * conv3(P, cw, cb, t, lo, hi, C_HV + ch);
            Y[(size_t)t * D + ch] = (bf16)f2bf(x0 * (sm[ch * 65 + tl] + hb[ch] * z)); }
        __syncthreads();
    }
}

__device__ __forceinline__ void attn_naive(const Params& p, bool with_ctx, float* sm, int bid, int nb) {
    const bf16* P = (const bf16*)(p.ws + WS_P); bf16* Y = (bf16*)(p.ws + WS_YMIX);
    float* Ks = sm; float* Vs = sm + 32 * 64;
    const int tid = threadIdx.x, nunits = with_ctx ? 264 : 256;
    for (int u = bid; u < nunits; u += nb) {
        int h, q0, nq, k0, nk;
        if (u < 256) { h = u >> 5; q0 = (u & 31) * 512; nq = 512; k0 = 0; nk = R; } else { h = u - 256; q0 = SEQ; nq = 256; k0 = SEQ; nk = CTXL; }
        const int kvh = h >> 2; const bool act = tid < nq; const int qrow = q0 + (act ? tid : 0);
        float qv[64], o[64];
        { const u32x4* qp = (const u32x4*)(P + (size_t)qrow * INC + C_AQ + h * 64);
#pragma unroll
          for (int c = 0; c < 8; ++c) { const u32x4 w = qp[c];
#pragma unroll
              for (int x = 0; x < 4; ++x) { qv[c * 8 + 2 * x] = lo16(w[x]); qv[c * 8 + 2 * x + 1] = hi16(w[x]); } } }
#pragma unroll
        for (int d = 0; d < 64; ++d) o[d] = 0.f;
        float m = -1.0e30f, ls = 0.f;
        for (int kt = 0; kt < nk; kt += 32) {
            __syncthreads();
            { const int e = tid * 4, kr = e >> 6, d = e & 63; const bf16* kp = P + (size_t)(k0 + kt + kr) * INC + kvh * 64 + d;
              const u32x2 kw = *(const u32x2*)(kp + C_AK), vw = *(const u32x2*)(kp + C_AV);
              Ks[e] = lo16(kw.x); Ks[e + 1] = hi16(kw.x); Ks[e + 2] = lo16(kw.y); Ks[e + 3] = hi16(kw.y);
              Vs[e] = lo16(vw.x); Vs[e + 1] = hi16(vw.x); Vs[e + 2] = lo16(vw.y); Vs[e + 3] = hi16(vw.y); }
            __syncthreads();
#pragma unroll 1
            for (int j = 0; j < 32; ++j) { float a = 0.f;
#pragma unroll
                for (int d4 = 0; d4 < 16; ++d4) { const f32x4 kk = *(const f32x4*)&Ks[j * 64 + d4 * 4]; a += qv[d4 * 4] * kk.x + qv[d4 * 4 + 1] * kk.y + qv[d4 * 4 + 2] * kk.z + qv[d4 * 4 + 3] * kk.w; }
                const float mn = fmaxf(m, a), sc = exp2f(m - mn), pj = exp2f(a - mn); m = mn; ls = ls * sc + pj;
#pragma unroll
                for (int d4 = 0; d4 < 16; ++d4) { const f32x4 vv = *(const f32x4*)&Vs[j * 64 + d4 * 4];
                    o[d4 * 4] = o[d4 * 4] * sc + pj * vv.x; o[d4 * 4 + 1] = o[d4 * 4 + 1] * sc + pj * vv.y; o[d4 * 4 + 2] = o[d4 * 4 + 2] * sc + pj * vv.z; o[d4 * 4 + 3] = o[d4 * 4 + 3] * sc + pj * vv.w; } }
        }
        if (act) { const float il = 1.f / ls; u32x4* yo = (u32x4*)(Y + (size_t)qrow * D + 512 + h * 64);
#pragma unroll
            for (int c = 0; c < 8; ++c) yo[c] = (u32x4){pk2(o[c * 8] * il, o[c * 8 + 1] * il), pk2(o[c * 8 + 2] * il, o[c * 8 + 3] * il), pk2(o[c * 8 + 4] * il, o[c * 8 + 5] * il), pk2(o[c * 8 + 6] * il, o[c * 8 + 7] * il)}; }
    }
}

__device__ __forceinline__ int moe_segments(const Params& p, int* seg  , int* tile_e  ) {
    const unsigned* cnt = (const unsigned*)(p.ws + WS_CTL) + CW_CNT;
    if (threadIdx.x == 0) { int s = 0; for (int e = 0; e < 8; ++e) { seg[e] = s; s += (int)((cnt[e] + 255u) >> 8) << 8; } seg[8] = s; }
    __syncthreads();
    const int total = seg[8];
    for (int t = threadIdx.x; t < total / 128; t += NT) { int e = 0; while (t * 128 >= seg[e + 1]) ++e; tile_e[t] = e; }
    __syncthreads();
    return total;
}
__device__ __forceinline__ void ph_gather(const Params& p, int* ism, int bid, int nb) {
    int* seg = ism; int* tile_e = ism + 16;
    const int total = moe_segments(p, seg, tile_e);
    const unsigned* cnt = (const unsigned*)(p.ws + WS_CTL) + CW_CNT;
    const int lane = threadIdx.x & 63, wave = threadIdx.x >> 6;
    const bf16* H = (const bf16*)(p.ws + WS_H); bf16* XS = (bf16*)(p.ws + WS_XS);
    int* rowd = (int*)(p.ws + WS_ROWD); float* rowg = (float*)(p.ws + WS_ROWG);
    const int* at = (const int*)(p.ws + WS_ASGT); const float* ag = (const float*)(p.ws + WS_ASGG);
    for (int s = bid * 8 + wave; s < total; s += nb * 8) {
        const int e = tile_e[s >> 7], pos = s - seg[e];
        u32x4 v0 = (u32x4){0u, 0u, 0u, 0u}, v1 = v0; int dd = -1; float gg = 0.f;
        if (pos < (int)cnt[e]) { dd = at[e * SEQ + pos]; gg = ag[e * SEQ + pos]; const u32x4* src = (const u32x4*)(H + (size_t)(dd >> 1) * D); v0 = src[lane]; v1 = src[64 + lane]; }
        u32x4* dst = (u32x4*)(XS + (size_t)s * D); dst[lane] = v0; dst[64 + lane] = v1;
        if (lane == 0) { rowd[s] = dd; rowg[s] = gg; }
    }
}
__device__ __forceinline__ void ph_final(const Params& p, int bid, int nb) {
    const int lane = threadIdx.x & 63, wave = threadIdx.x >> 6;
    const bf16* Y2 = (const bf16*)(p.ws + WS_Y2); const float* g = p.in[31];
    for (int row = bid * 8 + wave; row < SEQ; row += nb * 8) {
        f32x4* xr = (f32x4*)(p.out + (size_t)row * D) + lane; const f32x4* m5 = (const f32x4*)mod_vec(p, 1, row, 5) + lane;
        const u32x2* ya = (const u32x2*)(Y2 + (size_t)(2 * row) * D) + lane; const u32x2* yb = (const u32x2*)(Y2 + (size_t)(2 * row + 1) * D) + lane;
        f32x4 v[4]; float ss = 0.f;
#pragma unroll
        for (int j = 0; j < 4; ++j) { const u32x2 a = ya[64 * j], b = yb[64 * j]; const f32x4 m = m5[64 * j];
            const f32x4 y = (f32x4){lo16(a.x) + lo16(b.x), hi16(a.x) + hi16(b.x), lo16(a.y) + lo16(b.y), hi16(a.y) + hi16(b.y)};
            v[j] = xr[64 * j] + m * y; ss += (v[j].x * v[j].x + v[j].y * v[j].y) + (v[j].z * v[j].z + v[j].w * v[j].w); }
        const float r = rsqrtf(wave_sum(ss) * (1.f / D) + EPS);
#pragma unroll
        for (int j = 0; j < 4; ++j) xr[64 * j] = v[j] * r * ((const f32x4*)g)[lane + 64 * j];
    }
}

#define LAS __attribute__((address_space(3)))
#define XB_TMO      128
#define XB_XCNT(j)  (256  + 64 * (j))
#define XB_XSUB(j)  (1280 + 64 * (j))
#define XB_XGEN(j)  (2304 + 64 * (j))
#define XB_TOP      3328
#define XB_TOPGEN   3392
#define XCD_BAR_WORDS 3456
#define XB_SPIN_CAP (1u << 18)
__device__ __forceinline__ unsigned xb_ld(unsigned* p)              { return __hip_atomic_load(p, __ATOMIC_RELAXED, __HIP_MEMORY_SCOPE_AGENT); }
__device__ __forceinline__ unsigned xb_add(unsigned* p, unsigned v) { return __hip_atomic_fetch_add(p, v, __ATOMIC_RELAXED, __HIP_MEMORY_SCOPE_AGENT); }
__device__ __forceinline__ unsigned xb_xcc_id() { return (unsigned)__builtin_amdgcn_s_getreg((3 << 11) | 20) & 0xFu; }
#define XB_SPIN(cond, bar) do { unsigned _sp = 0; while (cond) { __builtin_amdgcn_s_sleep(1); \
    if ((++_sp & 255u) == 0u) { if (xb_ld(&(bar)[XB_TMO])) break; if (_sp > XB_SPIN_CAP) { atomicAdd(&(bar)[XB_TMO], 1u); break; } } } } while (0)
struct XcdBarrier { unsigned* bar; unsigned x; volatile LAS unsigned* st; };
__device__ __forceinline__ XcdBarrier xcd_barrier_post(unsigned* bar, volatile LAS unsigned* st) {
    XcdBarrier b; b.bar = bar; b.x = xb_xcc_id(); b.st = st;
    if (threadIdx.x == 0) (void)xb_add(&bar[XB_XCNT(b.x)], 1u);
    return b;
}
__device__ __forceinline__ void xcd_barrier_complete(unsigned* bar, unsigned x, unsigned& nloc, unsigned& nx) {
    const unsigned G = gridDim.x * gridDim.y * gridDim.z;
    unsigned sum, cnt, mine, sp = 0u;
    for (;;) {
        sum = 0u; cnt = 0u; mine = 0u;
#pragma unroll
        for (unsigned j = 0; j < 16; ++j) { const unsigned c = xb_ld(&bar[XB_XCNT(j)]); sum += c; cnt += (c > 0u) ? 1u : 0u; mine = (j == x) ? c : mine; }
        if (sum == G) break;
        __builtin_amdgcn_s_sleep(1);
        if ((++sp & 255u) == 0u) { if (xb_ld(&bar[XB_TMO])) break; if (sp > XB_SPIN_CAP) { atomicAdd(&bar[XB_TMO], 1u); break; } }
    }
    nloc = mine > 0u ? mine : 1u; nx = cnt > 0u ? cnt : 1u;
}
__device__ __forceinline__ void xcd_barrier(const XcdBarrier& b) {
    asm volatile("s_waitcnt vmcnt(0)" ::: "memory");
    __syncthreads();
    if (threadIdx.x == 0) {
        unsigned* bar = b.bar;
        __builtin_amdgcn_s_waitcnt(0);
        unsigned nloc = b.st[0], nx = b.st[1];
        if (nloc == 0u) { xcd_barrier_complete(bar, b.x, nloc, nx); b.st[0] = nloc; b.st[1] = nx; }
        const unsigned old = xb_add(&bar[XB_XSUB(b.x)], 1u);
        const unsigned gen = old / nloc;
        if (old + 1u == (gen + 1u) * nloc) {
            __builtin_amdgcn_fence(__ATOMIC_RELEASE, "agent");
            asm volatile("s_waitcnt vmcnt(0)" ::: "memory");
            const unsigned og = xb_add(&bar[XB_TOP], 1u);
            const unsigned tg = og / nx;
            if (og + 1u == (tg + 1u) * nx) xb_add(&bar[XB_TOPGEN], 1u);
            else XB_SPIN(xb_ld(&bar[XB_TOPGEN]) == tg, bar);
            __builtin_amdgcn_fence(__ATOMIC_ACQUIRE, "agent");
            xb_add(&bar[XB_XGEN(b.x)], 1u);
            asm volatile("s_waitcnt vmcnt(0)" ::: "memory");
        } else {
            XB_SPIN(xb_ld(&bar[XB_XGEN(b.x)]) == gen, bar);
            __builtin_amdgcn_fence(__ATOMIC_ACQUIRE, "agent");
            asm volatile("s_waitcnt vmcnt(0)" ::: "memory");
        }
    }
    __syncthreads();
}

constexpr int LDS_BYTES = 147456;
constexpr int LDS_MISC = 131072 + 8192;
constexpr int NPHASE = 21;

__global__ void __launch_bounds__(NT, 2) k_run(Params p) {
    extern __shared__ __attribute__((aligned(16))) unsigned char lds[];
    float* sm = (float*)lds;
    const int bid = blockIdx.x, nb = gridDim.x;
    volatile LAS unsigned* misc = (volatile LAS unsigned*)((LAS unsigned char*)lds + LDS_MISC);
    if (threadIdx.x < 16) misc[threadIdx.x] = 0u;
    __syncthreads();
    XcdBarrier bar; bar.bar = (unsigned*)(p.ws + WS_CTL) + CW_BAR; bar.x = 0; bar.st = nullptr;
    if (p.ph_hi - p.ph_lo > 1) bar = xcd_barrier_post((unsigned*)(p.ws + WS_CTL) + CW_BAR, misc + 8);
    const int lo = p.ph_lo, hi = p.ph_hi;
#ifndef ONLY_PH
#define ONLY_PH -1
#endif
#define IN(k) ((ONLY_PH < 0 || ONLY_PH == (k)) && lo <= (k) && (k) < hi)
#define SEAM(k) do { if (IN(k) && IN((k) + 1)) xcd_barrier(bar); } while (0)

    if (IN(0)) { ph_mod(p, sm, bid, nb); ph_tw(p, bid, nb); __syncthreads(); ph_filt(p, sm, bid, nb); __syncthreads(); ph_wconv(p, sm, bid, nb); } SEAM(0);
    if (IN(1)) { ph_hfft(p, sm, bid, nb); ph_norm(p, 0, 0, true, R, false, bid, nb); } SEAM(1);
    if (IN(2)) { EpiP E{(bf16*)(p.ws + WS_P)}; gemm_naive<EpiP, false>((const bf16*)(p.ws + WS_H), (const bf16*)(p.ws + WS_WIN), D, R / 128, INC / 64, E, sm, bid, nb); } SEAM(2);
    if (IN(3)) { prep_qk(p, 0, R, bid, nb); prep_hyz(p, 0, true, sm, bid, nb); prep_retu(p, 0, sm, bid, nb); } SEAM(3);
    if (IN(4)) { ph_retscan(p, 0, bid, nb);
        for (int u = bid; u < 512; u += nb) { if (u < 256) hconv_unit(p, 0, u, sm); else hconv_ctx_unit(p, u - 256, sm); }
        attn_naive(p, true, sm, bid, nb); } SEAM(4);
    if (IN(5)) { post_ret(p, 0, NCH, lds, bid, nb); post_hy(p, 0, true, sm, bid, nb); } SEAM(5);
    if (IN(6)) { EpiRes E{&p, 0, 2, true}; gemm_naive<EpiRes, false>((const bf16*)(p.ws + WS_YMIX), (const bf16*)(p.ws + WS_WOUT), D, R / 128, D / 64, E, sm, bid, nb); } SEAM(6);
    if (IN(7)) { ph_norm(p, 0, 1, false, R, false, bid, nb); } SEAM(7);
    if (IN(8)) { EpiSwi E{(bf16*)(p.ws + WS_HID), nullptr}; gemm_naive<EpiSwi, true>((const bf16*)(p.ws + WS_H), (const bf16*)(p.ws + WS_WGU), D, R / 128, FF / 64, E, sm, bid, nb); } SEAM(8);
    if (IN(9)) { EpiRes E{&p, 0, 5, false}; gemm_naive<EpiRes, false>((const bf16*)(p.ws + WS_HID), (const bf16*)(p.ws + WS_WDN), FF, R / 128, D / 64, E, sm, bid, nb); } SEAM(9);
    if (IN(10)) { ph_norm(p, 1, 0, false, R, false, bid, nb); } SEAM(10);
    if (IN(11)) { EpiP E{(bf16*)(p.ws + WS_P)}; gemm_naive<EpiP, false>((const bf16*)(p.ws + WS_H), (const bf16*)(p.ws + WS_WIN) + (size_t)INC * D, D, R / 128, INC / 64, E, sm, bid, nb); } SEAM(11);
    if (IN(12)) { prep_qk(p, 1, R, bid, nb); prep_hyz(p, 1, false, sm, bid, nb); prep_retu(p, 1, sm, bid, nb); } SEAM(12);
    if (IN(13)) { ph_retscan(p, 1, bid, nb);
        for (int u = bid; u < 256; u += nb) hconv_unit(p, 1, u, sm);
        attn_naive(p, false, sm, bid, nb); } SEAM(13);
    if (IN(14)) { post_ret(p, 1, 128, lds, bid, nb); post_hy(p, 1, false, sm, bid, nb); } SEAM(14);
    if (IN(15)) { EpiRes E{&p, 1, 2, false}; gemm_naive<EpiRes, false>((const bf16*)(p.ws + WS_YMIX), (const bf16*)(p.ws + WS_WOUT) + (size_t)D * D, D, SEQ / 128, D / 64, E, sm, bid, nb); } SEAM(15);
    if (IN(16)) { ph_norm(p, 1, 1, false, SEQ, true, bid, nb); } SEAM(16);
    if (IN(17)) { ph_gather(p, (int*)(lds + LDS_MISC + 256), bid, nb); } SEAM(17);
    if (IN(18)) { int* ism = (int*)(lds + LDS_MISC + 256); const int total = moe_segments(p, ism, ism + 16);
        EpiSwi E{(bf16*)(p.ws + WS_HIDM), ism + 16}; gemm_naive<EpiSwi, true>((const bf16*)(p.ws + WS_XS), (const bf16*)(p.ws + WS_MOEW), D, total / 128, FF / 64, E, sm, bid, nb); } SEAM(18);
    if (IN(19)) { int* ism = (int*)(lds + LDS_MISC + 256); const int total = moe_segments(p, ism, ism + 16);
        EpiMoeDown E{(bf16*)(p.ws + WS_Y2), (const int*)(p.ws + WS_ROWD), (const float*)(p.ws + WS_ROWG), ism + 16};
        gemm_naive<EpiMoeDown, false>((const bf16*)(p.ws + WS_HIDM), (const bf16*)(p.ws + WS_MOEW) + (size_t)5632 * 1024, FF, total / 128, D / 64, E, sm, bid, nb); } SEAM(19);
    if (IN(20)) { ph_final(p, bid, nb); }
#undef IN
#undef SEAM
}

extern "C" void kernel_launch(void* const* d_in, const int* in_sizes, int n_in, void* d_out, int out_size, void* d_ws, size_t ws_size, hipStream_t stream) {
    static int grid = 0;
    if (grid == 0) {
        if (n_in != 32 || out_size != SEQ * D || ws_size < WS_END) { fprintf(stderr, "kernel_launch: unexpected problem (n_in %d out %d ws %zu)\n", n_in, out_size, ws_size); grid = -1; return; }
        int dev = 0, cus = 0;
        if (hipGetDevice(&dev) != hipSuccess || hipDeviceGetAttribute(&cus, hipDeviceAttributeMultiprocessorCount, dev) != hipSuccess) { grid = -1; return; }
        if (hipFuncSetAttribute((const void*)k_run, hipFuncAttributeMaxDynamicSharedMemorySize, LDS_BYTES) != hipSuccess) { fprintf(stderr, "kernel_launch: LDS attribute failed\n"); grid = -1; return; }
        int per_cu = 0; (void)hipOccupancyMaxActiveBlocksPerMultiprocessor(&per_cu, (const void*)k_run, NT, LDS_BYTES); (void)hipGetLastError();
        grid = cus > 0 ? cus : 256;
    }
    if (grid < 0) return;
    (void)hipMemsetAsync((char*)d_ws + WS_CTL, 0, CTL_BYTES, stream);
    Params p; memset(&p, 0, sizeof(p));
    for (int i = 0; i < 32; ++i) p.in[i] = (const float*)d_in[i];
    p.out = (float*)d_out; p.ws = (unsigned char*)d_ws;
#if N_LAUNCH_MODE == 1
    p.ph_lo = 0; p.ph_hi = NPHASE;
    hipLaunchKernelGGL(k_run, dim3(grid), dim3(NT), LDS_BYTES, stream, p);
#else
    for (int ph = 0; ph < NPHASE; ++ph) { p.ph_lo = ph; p.ph_hi = ph + 1; hipLaunchKernelGGL(k_run, dim3(grid), dim3(NT), LDS_BYTES, stream, p); }
#endif
}
```

```cpp
#include <hip/hip_runtime.h>
#include <cstdio>
#include <cstdint>
#include <cstring>

typedef unsigned short bf16;
typedef unsigned u32x4 __attribute__((ext_vector_type(4)));
typedef unsigned u32x2 __attribute__((ext_vector_type(2)));
typedef float f32x4 __attribute__((ext_vector_type(4)));
typedef float f32x2 __attribute__((ext_vector_type(2)));

#ifndef N_LAUNCH_MODE
#define N_LAUNCH_MODE 1
#endif

constexpr int D = 1024, SEQ = 16384, CTXL = 256, R = SEQ + CTXL;
constexpr int INC = 2560, FF = 2816, NE = 8;
constexpr int C_HX0 = 0, C_HX1 = 256, C_HV = 512, C_RQ = 768, C_RK = 1024, C_RV = 1280, C_RG = 1536, C_AQ = 1792, C_AK = 2304, C_AV = 2432;
constexpr int FN = 32768, FM = 16384;
constexpr int NCH = 130;
constexpr float EPS = 1e-6f;
constexpr float C2 = 0.125f * 1.4426950408889634f;
constexpr int NT = 512;
constexpr int MOE_MAXROWS = 34560;

constexpr size_t MiB = 1u << 20;
constexpr size_t WS_CTL = 0, CTL_BYTES = MiB;
constexpr size_t WS_MOD = 1 * MiB;
constexpr size_t WS_TW = 1 * MiB + 128 * 1024;
constexpr size_t WS_TWN = 1 * MiB + 256 * 1024;
constexpr size_t WS_XC = 2 * MiB;
constexpr size_t WS_ASGT = 3 * MiB;
constexpr size_t WS_ASGG = 3 * MiB + 512 * 1024;
constexpr size_t WS_ROWD = 4 * MiB;
constexpr size_t WS_ROWG = 4 * MiB + 256 * 1024;
constexpr size_t WS_TAPSC = 5 * MiB;
constexpr size_t WS_ZC = 5 * MiB + 512 * 1024;
constexpr size_t WS_HSPEC = 8 * MiB;
constexpr size_t WS_ZT = 72 * MiB;
constexpr size_t WS_RU = 88 * MiB;
constexpr size_t WS_WIN = 105 * MiB;
constexpr size_t WS_WOUT = 115 * MiB;
constexpr size_t WS_WGU = 119 * MiB;
constexpr size_t WS_WDN = 130 * MiB;
constexpr size_t WS_H = 136 * MiB;
constexpr size_t WS_P = 169 * MiB;
constexpr size_t WS_YMIX = 251 * MiB;
constexpr size_t WS_HID = 169 * MiB;
constexpr size_t WS_MOEW = 306 * MiB;
constexpr size_t WS_XS = 8 * MiB;
constexpr size_t WS_Y2 = 8 * MiB;
constexpr size_t WS_HIDM = 105 * MiB;
constexpr size_t WS_END = 438 * MiB;
constexpr size_t MOEW_E = (size_t)(5632 * 1024 + 1024 * 2816);
static_assert(WS_HIDM + (size_t)MOE_MAXROWS * FF * 2 <= WS_MOEW, "map");
static_assert(WS_XS + (size_t)MOE_MAXROWS * D * 2 <= WS_HIDM, "map");
static_assert(WS_MOEW + 8 * MOEW_E * 2 <= WS_END, "map");

constexpr int CW_CNT = 64;
constexpr int CW_BAR = 4096;

struct Params { const float* in[32]; float* out; unsigned char* ws; int ph_lo, ph_hi; };

__device__ __forceinline__ float bf2f(bf16 v) { return __uint_as_float((unsigned)v << 16); }
__device__ __forceinline__ unsigned f2bf(float f) { unsigned u = __float_as_uint(f); return (u + 0x7fffu + ((u >> 16) & 1u)) >> 16; }
__device__ __forceinline__ unsigned pk2(float lo, float hi) { return f2bf(lo) | (f2bf(hi) << 16); }
__device__ __forceinline__ float lo16(unsigned w) { return __uint_as_float(w << 16); }
__device__ __forceinline__ float hi16(unsigned w) { return __uint_as_float(w & 0xffff0000u); }
__device__ __forceinline__ float wave_sum(float v) {
#pragma unroll
    for (int o = 1; o < 64; o <<= 1) v += __shfl_xor(v, o);
    return v;
}
__device__ __forceinline__ float silu_f(float x) { return x / (1.f + __expf(-x)); }
__device__ __forceinline__ const float* xsrc_row(const Params& p, bool first, int row) {
    if (first) return row < SEQ ? p.in[0] + (size_t)row * D : p.in[2] + (size_t)(row - SEQ) * D;
    return row < SEQ ? p.out + (size_t)row * D : (const float*)(p.ws + WS_XC) + (size_t)(row - SEQ) * D;
}
__device__ __forceinline__ float* xdst_row(const Params& p, int row) {
    return row < SEQ ? p.out + (size_t)row * D : (float*)(p.ws + WS_XC) + (size_t)(row - SEQ) * D;
}
__device__ __forceinline__ const float* mod_vec(const Params& p, int l, int row, int j) {
    return (const float*)(p.ws + WS_MOD) + (size_t)((l * 2 + (row >= SEQ ? 1 : 0)) * 6 + j) * D;
}

__device__ __forceinline__ void ph_mod(const Params& p, float* sm, int bid, int nb) {
    const float* c = p.in[1]; const float* cc = p.in[3]; const float* W = p.in[4]; const float* B = p.in[5];
    float* MOD = (float*)(p.ws + WS_MOD);
    float* sc = sm; float* scc = sm + 1024; float* red = sm + 2048;
    const int tid = threadIdx.x;
    for (int i = tid; i < 1024; i += NT) { sc[i] = silu_f(c[i]); scc[i] = silu_f(cc[i]); }
    __syncthreads();
    for (int it = bid; it < 192; it += nb) {
        const int l = it / 96, cl = tid & 63, col = (it % 96) * 64 + cl, kg = tid >> 6;
        const float* w = W + (size_t)l * 1024 * 6144 + col;
        float a0 = 0.f, a1 = 0.f;
#pragma unroll 8
        for (int k = kg * 128; k < kg * 128 + 128; ++k) { const float wv = w[(size_t)k * 6144]; a0 += sc[k] * wv; a1 += scc[k] * wv; }
        red[(kg * 64 + cl) * 2] = a0; red[(kg * 64 + cl) * 2 + 1] = a1;
        __syncthreads();
        if (tid < 128) { const int c2 = tid & 63, s = tid >> 6; float sum = 0.f;
            for (int g = 0; g < 8; ++g) sum += red[(g * 64 + c2) * 2 + s];
            const int colg = (it % 96) * 64 + c2; MOD[(size_t)(l * 2 + s) * 6144 + colg] = sum + B[l * 6144 + colg]; }
        __syncthreads();
    }
}
__device__ __forceinline__ void ph_tw(const Params& p, int bid, int nb) {
    f32x2* TW = (f32x2*)(p.ws + WS_TW); f32x2* TWN = (f32x2*)(p.ws + WS_TWN);
    for (int k = bid * NT + threadIdx.x; k <= FM / 2; k += nb * NT) {
        float s, c;
        if (k < FM / 2) { const float x = (float)k * (2.0f / FM); s = sinpif(x); c = cospif(x); TW[k] = (f32x2){c, -s}; }
        { const float x = (float)k * (2.0f / FN); s = sinpif(x); c = cospif(x); TWN[k] = (f32x2){c, -s}; }
    }
}
__device__ __forceinline__ void transpose_item(const float* W, int K, int N, bf16* WT, int drow0, int k0, int n0, float* scr, int lane) {
#pragma unroll 8
    for (int i = 0; i < 32; ++i) { const int kk = 2 * i + (lane >> 5); scr[kk * 33 + (lane & 31)] = W[(size_t)(k0 + kk) * N + n0 + (lane & 31)]; }
    asm volatile("s_waitcnt vmcnt(0) lgkmcnt(0)" ::: "memory");
    const int c = lane & 7;
#pragma unroll
    for (int j = 0; j < 4; ++j) { const int n = (lane >> 3) + 8 * j; const float* s = scr + (8 * c) * 33 + n;
        u32x4 o; o.x = pk2(s[0 * 33], s[1 * 33]); o.y = pk2(s[2 * 33], s[3 * 33]); o.z = pk2(s[4 * 33], s[5 * 33]); o.w = pk2(s[6 * 33], s[7 * 33]);
        *(u32x4*)(WT + (size_t)(drow0 + n) * K + k0 + 8 * c) = o; }
    asm volatile("s_waitcnt lgkmcnt(0)" ::: "memory");
}
__device__ __forceinline__ int gu_row(int n, int up) { return (n >> 7) * 256 + (n & 127) + (up ? 128 : 0); }
__device__ __forceinline__ void ph_wconv(const Params& p, float* sm, int bid, int nb) {
    const int lane = threadIdx.x & 63, wave = threadIdx.x >> 6;
    float* scr = sm + wave * (64 * 33);
    const int gw = bid * 8 + wave, NGW = nb * 8;
    constexpr int I_IN = 16 * 80, I_OUT = 16 * 32, I_GU = 16 * 88, I_DN = 44 * 32;
    constexpr int PER_FFN = 3 * I_GU;
    static_assert(I_DN == I_GU, "");
    constexpr int NITEMS = 2 * I_IN + 2 * I_OUT + 9 * PER_FFN;
    for (int it = gw; it < NITEMS; it += NGW) {
        int r = it;
        if (r < 2 * I_IN) { const int l = r / I_IN; r %= I_IN; const int kb = r / 80, nb2 = r % 80;
            transpose_item(p.in[8] + (size_t)l * D * INC, D, INC, (bf16*)(p.ws + WS_WIN) + (size_t)l * INC * D, nb2 * 32, kb * 64, nb2 * 32, scr, lane); continue; }
        r -= 2 * I_IN;
        if (r < 2 * I_OUT) { const int l = r / I_OUT; r %= I_OUT; const int kb = r / 32, nb2 = r % 32;
            transpose_item(p.in[9] + (size_t)l * D * D, D, D, (bf16*)(p.ws + WS_WOUT) + (size_t)l * D * D, nb2 * 32, kb * 64, nb2 * 32, scr, lane); continue; }
        r -= 2 * I_OUT;
        const int f = r / PER_FFN; r %= PER_FFN;
        const int which = r / I_GU; r %= I_GU;
        const float* src; bf16* dgu; bf16* ddn;
        if (f == 0) { src = p.in[23 + which]; dgu = (bf16*)(p.ws + WS_WGU); ddn = (bf16*)(p.ws + WS_WDN); }
        else { src = p.in[28 + which] + (size_t)(f - 1) * D * FF; dgu = (bf16*)(p.ws + WS_MOEW) + (size_t)(f - 1) * MOEW_E; ddn = dgu + (size_t)5632 * 1024; }
        if (which < 2) { const int kb = r / 88, nb2 = r % 88; transpose_item(src, D, FF, dgu, gu_row(nb2 * 32, which), kb * 64, nb2 * 32, scr, lane); }
        else { const int kb = r / 32, nb2 = r % 32; transpose_item(src, FF, D, ddn, nb2 * 32, kb * 64, nb2 * 32, scr, lane); }
    }
}
__device__ __forceinline__ void ph_filt(const Params& p, float* sm, int bid, int nb) {
    const float dlo = -4.605170185988091f / 1.5f, dhi = -4.605170185988091f / 0.3f;
    float* col = sm + threadIdx.x;
    for (int it = bid; it < 260; it += nb) {
        int which, chunk, q;
        if (it < 256) { which = it >> 7; chunk = (it & 127) >> 2; q = it & 3; } else { which = 2; chunk = 0; q = it - 256; }
        const int l = (which == 2) ? 0 : which; const int Lf = (which == 2) ? CTXL : SEQ; const int NN = 2 * Lf;
        const int n = chunk * NT + threadIdx.x;
        if (n >= Lf) continue;
        float* taps = (which == 2) ? (float*)(p.ws + WS_TAPSC) : (float*)(p.ws + WS_HSPEC) + (size_t)which * 256 * FN;
        const float* w1 = p.in[12] + l * 33 * 64; const float* b1 = p.in[13] + l * 64; const float* w2 = p.in[14] + l * 4096; const float* b2 = p.in[15] + l * 64;
        const float* w3 = p.in[16] + l * 64 * 512; const float* b3 = p.in[17] + l * 512; const float* fr = p.in[18] + l * 64;
        const float t = (float)n / (float)(Lf - 1);
        float feat[33]; feat[0] = t;
#pragma unroll
        for (int b = 0; b < 16; ++b) { const float band = 1e-4f + (float)b * ((15.f - 1e-4f) / 15.f);
            const float rev2 = (2.0f / (float)Lf) * (float)n * band; feat[1 + b] = cospif(rev2); feat[17 + b] = -sinpif(rev2); }
#pragma unroll 1
        for (int j = 0; j < 64; ++j) { float a = b1[j];
#pragma unroll
            for (int i = 0; i < 33; ++i) a += feat[i] * w1[i * 64 + j];
            col[j * NT] = sinpif(fr[j] * a * 0.3183098861837907f); }
        float acc[64];
#pragma unroll
        for (int j = 0; j < 64; ++j) acc[j] = b2[j];
#pragma unroll 1
        for (int i = 0; i < 64; ++i) { const float x = col[i * NT];
#pragma unroll
            for (int j = 0; j < 64; ++j) acc[j] += x * w2[i * 64 + j]; }
#pragma unroll
        for (int j = 0; j < 64; ++j) col[j * NT] = acc[j];
#pragma unroll 1
        for (int j = 0; j < 64; ++j) col[j * NT] = sinpif(fr[j] * col[j * NT] * 0.3183098861837907f);
#pragma unroll
        for (int j = 0; j < 64; ++j) acc[j] = col[j * NT];
#pragma unroll 1
        for (int j = q * 128; j < q * 128 + 128; ++j) { float a = b3[j];
#pragma unroll
            for (int i = 0; i < 64; ++i) a += acc[i] * w3[i * 512 + j];
            const int dir = j >> 8, ch = j & 255;
            const float delta = fabsf(dlo + (float)ch * ((dhi - dlo) / 255.f));
            a *= __expf(-t * delta);
            if (dir == 0) taps[(size_t)ch * NN + n] = a;
            else { if (n >= 1) taps[(size_t)ch * NN + NN - n] = a; else taps[(size_t)ch * NN + Lf] = 0.f; } }
    }
}

__device__ __forceinline__ int brev14(int k) { return (int)(__brev((unsigned)k) >> 18); }
__device__ __forceinline__ void fft_dif(f32x2* buf, const f32x2* TW) {
    for (int half = FM / 2; half >= 1; half >>= 1) {
        const int tws = (FM / 2) / half;
        for (int j = threadIdx.x; j < FM / 2; j += NT) { const int pos = j & (half - 1), i0 = ((j - pos) << 1) + pos, i1 = i0 + half;
            const f32x2 u = buf[i0], v = buf[i1], w = TW[pos * tws]; const f32x2 d = u - v;
            buf[i0] = u + v; buf[i1] = (f32x2){d.x * w.x - d.y * w.y, d.x * w.y + d.y * w.x}; }
        __syncthreads();
    }
}
__device__ __forceinline__ void fft_dit_inv(f32x2* buf, const f32x2* TW) {
    for (int half = 1; half <= FM / 2; half <<= 1) {
        const int tws = (FM / 2) / half;
        for (int j = threadIdx.x; j < FM / 2; j += NT) { const int pos = j & (half - 1), i0 = ((j - pos) << 1) + pos, i1 = i0 + half;
            const f32x2 u = buf[i0], b = buf[i1], w = TW[pos * tws];
            const f32x2 v = (f32x2){b.x * w.x + b.y * w.y, b.y * w.x - b.x * w.y};
            buf[i0] = u + v; buf[i1] = u - v; }
        __syncthreads();
    }
}
__device__ __forceinline__ void ph_hfft(const Params& p, float* sm, int bid, int nb) {
    f32x2* buf = (f32x2*)sm; float* red = sm + 2 * FM;
    const f32x2* TW = (const f32x2*)(p.ws + WS_TW); const f32x2* TWN = (const f32x2*)(p.ws + WS_TWN);
    const int tid = threadIdx.x;
    for (int u = bid; u < 512; u += nb) {
        f32x2* g = (f32x2*)((float*)(p.ws + WS_HSPEC) + (size_t)u * FN);
        float asum = 0.f;
        for (int n = tid; n < FM; n += NT) { const f32x2 v = g[n]; buf[n] = v; asum += fabsf(v.x) + fabsf(v.y); }
        asum = wave_sum(asum);
        if ((tid & 63) == 0) red[tid >> 6] = asum;
        __syncthreads();
        float tot = 0.f;
#pragma unroll
        for (int w = 0; w < 8; ++w) tot += red[w];
        const float sc = 0.5f / (tot + EPS);
        fft_dif(buf, TW);
        for (int k = tid; k <= FM / 2; k += NT) {
            if (k == 0) { const f32x2 a = buf[0]; g[0] = (f32x2){(a.x + a.y) * 2.f * sc, (a.x - a.y) * 2.f * sc}; continue; }
            const int kk = FM - k; const f32x2 a = buf[brev14(k)], b = buf[brev14(kk)], w = TWN[k];
            const f32x2 E = (f32x2){a.x + b.x, a.y - b.y}, O = (f32x2){a.y + b.y, b.x - a.x};
            const f32x2 T = (f32x2){w.x * O.x - w.y * O.y, w.x * O.y + w.y * O.x};
            g[k] = (f32x2){(E.x + T.x) * sc, (E.y + T.y) * sc};
            g[kk] = (f32x2){(E.x - T.x) * sc, -(E.y - T.y) * sc};
        }
        __syncthreads();
    }
}
__device__ __forceinline__ void hconv_unit(const Params& p, int l, int ch, float* sm) {
    f32x2* buf = (f32x2*)sm;
    const f32x2* TW = (const f32x2*)(p.ws + WS_TW); const f32x2* TWN = (const f32x2*)(p.ws + WS_TWN);
    const f32x2* H = (const f32x2*)((const float*)(p.ws + WS_HSPEC) + (size_t)(l * 256 + ch) * FN);
    f32x2* z = (f32x2*)((float*)(p.ws + WS_ZT) + (size_t)ch * SEQ);
    const int tid = threadIdx.x;
    for (int n = tid; n < FM; n += NT) buf[n] = (n < SEQ / 2) ? z[n] : (f32x2){0.f, 0.f};
    __syncthreads();
    fft_dif(buf, TW);
    for (int k = tid; k <= FM / 2; k += NT) {
        if (k == 0) { const f32x2 a = buf[0], h = H[0]; const float y0 = (a.x + a.y) * h.x, ym = (a.x - a.y) * h.y; buf[0] = (f32x2){0.5f * (y0 + ym), 0.5f * (y0 - ym)}; continue; }
        const int kk = FM - k, rk = brev14(k), rkk = brev14(kk);
        const f32x2 a = buf[rk], b = buf[rkk], w = TWN[k], hk = H[k], hkk = H[kk];
        const f32x2 E = (f32x2){0.5f * (a.x + b.x), 0.5f * (a.y - b.y)}, O = (f32x2){0.5f * (a.y + b.y), 0.5f * (b.x - a.x)};
        const f32x2 T = (f32x2){w.x * O.x - w.y * O.y, w.x * O.y + w.y * O.x};
        const f32x2 Xk = E + T, Xkk = (f32x2){E.x - T.x, -(E.y - T.y)};
        const f32x2 Yk = (f32x2){Xk.x * hk.x - Xk.y * hk.y, Xk.x * hk.y + Xk.y * hk.x};
        const f32x2 Ykk = (f32x2){Xkk.x * hkk.x - Xkk.y * hkk.y, Xkk.x * hkk.y + Xkk.y * hkk.x};
        const f32x2 Ey = (f32x2){0.5f * (Yk.x + Ykk.x), 0.5f * (Yk.y - Ykk.y)};
        const f32x2 Dy = (f32x2){0.5f * (Yk.x - Ykk.x), 0.5f * (Yk.y + Ykk.y)};
        const f32x2 Oy = (f32x2){w.x * Dy.x + w.y * Dy.y, w.x * Dy.y - w.y * Dy.x};
        buf[rk] = (f32x2){Ey.x - Oy.y, Ey.y + Oy.x};
        if (kk != k) buf[rkk] = (f32x2){Ey.x + Oy.y, -(Ey.y - Oy.x)};
    }
    __syncthreads();
    fft_dit_inv(buf, TW);
    const float inv = 1.f / (float)FM;
    for (int n = tid; n < SEQ / 2; n += NT) { const f32x2 v = buf[n]; z[n] = (f32x2){v.x * inv, v.y * inv}; }
    __syncthreads();
}
__device__ __forceinline__ void hconv_ctx_unit(const Params& p, int ch, float* sm) {
    float* zc = (float*)(p.ws + WS_ZC) + ch * CTXL; const float* tc = (const float*)(p.ws + WS_TAPSC) + ch * 512;
    float* zs = sm; float* ts = sm + 256; float* red = sm + 768;
    const int tid = threadIdx.x;
    if (tid < 256) zs[tid] = zc[tid];
    const float tv = tc[tid]; ts[tid] = tv;
    const float a = wave_sum(fabsf(tv)); if ((tid & 63) == 0) red[tid >> 6] = a;
    __syncthreads();
    if (tid < 256) { float tot = 0.f;
#pragma unroll
        for (int w = 0; w < 8; ++w) tot += red[w];
        float acc = 0.f;
        for (int m = 0; m < 256; ++m) { const int lag = tid - m; acc += zs[m] * ts[lag >= 0 ? lag : 512 + lag]; }
        zc[tid] = acc / (tot + EPS); }
    __syncthreads();
}

__device__ __forceinline__ void ph_norm(const Params& p, int l, int which, bool first, int nrows, bool route, int bid, int nb) {
    const int lane = threadIdx.x & 63, wave = threadIdx.x >> 6;
    const float* g = p.in[which ? 7 : 6] + l * D;
    bf16* H = (bf16*)(p.ws + WS_H);
    for (int row = bid * 8 + wave; row < nrows; row += nb * 8) {
        const f32x4* xr = (const f32x4*)xsrc_row(p, first, row) + lane;
        const f32x4* sh = (const f32x4*)mod_vec(p, l, row, which ? 3 : 0) + lane; const f32x4* scv = (const f32x4*)mod_vec(p, l, row, which ? 4 : 1) + lane;
        f32x4 v[4]; float ss = 0.f;
#pragma unroll
        for (int j = 0; j < 4; ++j) { v[j] = xr[64 * j]; ss += (v[j].x * v[j].x + v[j].y * v[j].y) + (v[j].z * v[j].z + v[j].w * v[j].w); }
        const float r = rsqrtf(wave_sum(ss) * (1.f / D) + EPS);
        u32x2* o8 = (u32x2*)(H + (size_t)row * D) + lane;
#pragma unroll
        for (int j = 0; j < 4; ++j) { const f32x4 gg = ((const f32x4*)g)[lane + 64 * j], s1 = scv[64 * j], s0 = sh[64 * j];
            v[j] = v[j] * r * gg * (s1 + 1.f) + s0;
            o8[64 * j] = (u32x2){pk2(v[j].x, v[j].y), pk2(v[j].z, v[j].w)}; }
        if (route) {
            const float* rw = p.in[26]; const float* rb = p.in[27];
            float lg[8];
#pragma unroll
            for (int e = 0; e < 8; ++e) lg[e] = 0.f;
#pragma unroll
            for (int j = 0; j < 4; ++j)
#pragma unroll
                for (int i = 0; i < 4; ++i) { const int d = 4 * lane + 256 * j + i; const float hv = v[j][i];
                    const f32x4 w0 = *(const f32x4*)(rw + d * 8), w1 = *(const f32x4*)(rw + d * 8 + 4);
                    lg[0] += hv * w0.x; lg[1] += hv * w0.y; lg[2] += hv * w0.z; lg[3] += hv * w0.w; lg[4] += hv * w1.x; lg[5] += hv * w1.y; lg[6] += hv * w1.z; lg[7] += hv * w1.w; }
#pragma unroll
            for (int e = 0; e < 8; ++e) lg[e] = wave_sum(lg[e]) + rb[e];
            int i1 = 0; float v1 = lg[0];
#pragma unroll
            for (int e = 1; e < 8; ++e) if (lg[e] > v1) { v1 = lg[e]; i1 = e; }
            int i2 = -1; float v2 = -3.0e38f;
#pragma unroll
            for (int e = 0; e < 8; ++e) if (e != i1 && lg[e] > v2) { v2 = lg[e]; i2 = e; }
            const float ex = __expf(v2 - v1), g1 = 1.f / (1.f + ex), g2 = ex * g1;
            if (lane == 0) {
                unsigned* cnt = (unsigned*)(p.ws + WS_CTL) + CW_CNT;
                int* at = (int*)(p.ws + WS_ASGT); float* ag = (float*)(p.ws + WS_ASGG);
                const unsigned p1 = atomicAdd(&cnt[i1], 1u); at[i1 * SEQ + p1] = row * 2; ag[i1 * SEQ + p1] = g1;
                const unsigned p2 = atomicAdd(&cnt[i2], 1u); at[i2 * SEQ + p2] = row * 2 + 1; ag[i2 * SEQ + p2] = g2;
            }
        }
    }
}

namespace pg8 {
#define PG8_LAS __attribute__((address_space(3)))
typedef unsigned short bf16_t;
typedef short bf16x8 __attribute__((ext_vector_type(8)));
typedef float f32x4 __attribute__((ext_vector_type(4)));
typedef unsigned u32x4 __attribute__((ext_vector_type(4)));
constexpr int BM = 256, BK = 64, HALF = 128, HTB = HALF * BK * 2  , STAGE_BYTES = 8 * HTB, NXCD = 8, WGM = 8;

__host__ __device__ __forceinline__ int lds_byte(int r, int c) { const int st = (r >> 4) * 2 + (c >> 5), rr = r & 15, cc = c & 31, ob = rr * 64 + cc * 2; return st * 1024 + (ob ^ (((ob >> 9) & 1) << 5)); }
__host__ __device__ __forceinline__ void stage_rc(int b, int& R, int& C) { const int st = b / 1024, sb = b % 1024, swz = sb ^ (((sb >> 9) & 1) << 5); R = (st >> 1) * 16 + swz / 64; C = (st & 1) * 32 + (swz % 64) / 2; }
__host__ __device__ __forceinline__ int perm32(int rho) { const int n = rho >> 4, i = rho & 15; return 8 * (i >> 2) + 4 * n + (i & 3); }

struct Unit { int pm, pn; };
struct Gemm { const bf16_t* A; const bf16_t* Bt; int M, N, K; };

struct StaticOrder {
    int nM, nN, nwg, G, c; const int* tile_e = nullptr; size_t estride = 0;
    __host__ __device__ void init(int M, int N, int G_, int c_) { nM = M / BM; nN = N / BM; nwg = nM * nN; G = G_; c = c_; }
    __host__ __device__ bool next(int i, Unit& u) const {
        const long L = (long)i * G + c; if (L >= nwg) return false;
        int wgid = (int)L; { const int q = nwg / NXCD, r = nwg % NXCD, xcd = wgid % NXCD, off = wgid / NXCD; wgid = (xcd < r ? xcd * (q + 1) : r * (q + 1) + (xcd - r) * q) + off; }
        const int nig = WGM * nN, gid = wgid / nig, fm = gid * WGM, gsz = (nM - fm) < WGM ? (nM - fm) : WGM;
        u.pm = fm + ((wgid % nig) % gsz); u.pn = (wgid % nig) / gsz; return true;
    }
    __device__ __forceinline__ size_t b_extra(const Unit& u) const { return tile_e ? (size_t)tile_e[2 * u.pm] * estride : (size_t)0; }
    __device__ __forceinline__ void a_ready(const Unit&) const {}
    __device__ __forceinline__ void done(const Unit&) const {}
};

__device__ __forceinline__ unsigned cvt_pk_bf16(float lo, float hi) { unsigned r; asm volatile("v_cvt_pk_bf16_f32 %0, %1, %2" : "=v"(r) : "v"(lo), "v"(hi)); return r; }
template <class Epi, class Sched, bool ALIGN_EPI = false, bool SP2 = false>
__device__ __forceinline__ void gemm_phase(PG8_LAS unsigned char* lds, const Gemm g, const Sched& S, const Epi& E) {
    const int tid = threadIdx.x, wid = __builtin_amdgcn_readfirstlane(tid >> 6), lane = tid & 63, wr = wid >> 2, wc = wid & 3, fr = lane & 15, fq = lane >> 4;
    const int K = g.K, nt = K / BK;
    unsigned voffA[2], voffB[2];
#pragma unroll
    for (int i = 0; i < 2; ++i) { int R, C; stage_rc(tid * 16 + i * 8192, R, C); const int Rb = Epi::PERM ? ((R & ~31) + perm32(R & 31)) : R;
        voffA[i] = (unsigned)(R * K + C) * 2u; voffB[i] = (unsigned)(Rb * K + C) * 2u; }
    const size_t kstep = (size_t)(BK * 2);
    const size_t hstep = (size_t)HALF * K * 2;
    const size_t tstep = 2 * hstep;
    const unsigned ldsw = (unsigned)wid * 1024u;
    const int aoff = lds_byte(wr * 64 + fr, fq * 8), boff = lds_byte(wc * 32 + fr, fq * 8);
#define PG8_SA(b, h) (((b) * 2 + (h)) * HTB)
#define PG8_SB(b, h) ((4 + (b) * 2 + (h)) * HTB)
#define PG8_STAGE(bufoff, gbase, voff) do { _Pragma("unroll") for (int _i = 0; _i < 2; ++_i) \
        __builtin_amdgcn_global_load_lds((const unsigned*)((const char*)(gbase) + (voff)[_i]), (PG8_LAS unsigned*)(lds + (bufoff) + ldsw + _i * 8192), 16, 0, 0); } while (0)
#define PG8_LDA(dst, b, h) do { _Pragma("unroll") for (int m = 0; m < 4; ++m) _Pragma("unroll") for (int k = 0; k < 2; ++k) dst[m][k] = *(const PG8_LAS bf16x8*)(lds + PG8_SA(b, h) + aoff + m * 2048 + k * 1024); } while (0)
#define PG8_LDB(dst, b, h) do { _Pragma("unroll") for (int n = 0; n < 2; ++n) _Pragma("unroll") for (int k = 0; k < 2; ++k) dst[n][k] = *(const PG8_LAS bf16x8*)(lds + PG8_SB(b, h) + boff + n * 2048 + k * 1024); } while (0)
#define PG8_MMA(ai, bj, At, Bt) do { __builtin_amdgcn_s_setprio(1); _Pragma("unroll") for (int m = 0; m < 4; ++m) _Pragma("unroll") for (int n = 0; n < 2; ++n) _Pragma("unroll") for (int k = 0; k < 2; ++k) \
        acc[ai][bj][m][n] = __builtin_amdgcn_mfma_f32_16x16x32_bf16(Bt[n][k], At[m][k], acc[ai][bj][m][n], 0, 0, 0); __builtin_amdgcn_s_setprio(0); } while (0)
#define PG8_WAIT_V(n) asm volatile("s_waitcnt vmcnt(" #n ")" ::: "memory")
#define PG8_WAIT_L(n) asm volatile("s_waitcnt lgkmcnt(" #n ")" ::: "memory")
#define PG8_BAR __builtin_amdgcn_s_barrier()
#define PG8_SCHED __builtin_amdgcn_sched_barrier(0)
    Unit cur, nxt; int ui = 0;
    if (!S.next(0, cur)) return;
    f32x4 acc[2][2][4][2];
#pragma unroll
    for (int a = 0; a < 2; ++a)
#pragma unroll
        for (int b = 0; b < 2; ++b)
#pragma unroll
            for (int m = 0; m < 4; ++m)
#pragma unroll
                for (int n = 0; n < 2; ++n) acc[a][b][m][n] = (f32x4){0.f, 0.f, 0.f, 0.f};
    bf16x8 At[4][2], B0[2][2], B1[2][2];
    const char* cA = (const char*)g.A + (size_t)cur.pm * tstep; const char* cB = (const char*)g.Bt + (size_t)cur.pn * tstep + S.b_extra(cur);
    S.a_ready(cur);
    if constexpr (SP2) {
        PG8_STAGE(PG8_SB(0, 0), cB, voffB); PG8_STAGE(PG8_SB(0, 1), cB + hstep, voffB); PG8_STAGE(PG8_SA(0, 0), cA, voffA); PG8_STAGE(PG8_SA(0, 1), cA + hstep, voffA);
        if (wr == 1) PG8_BAR;
        PG8_WAIT_V(2); PG8_BAR;
        PG8_STAGE(PG8_SB(1, 0), cB + kstep, voffB); PG8_STAGE(PG8_SA(1, 0), cA + kstep, voffA); PG8_STAGE(PG8_SB(1, 1), cB + hstep + kstep, voffB);
        PG8_WAIT_V(6); PG8_BAR;
    } else {
        PG8_STAGE(PG8_SB(0, 0), cB, voffB); PG8_STAGE(PG8_SA(0, 0), cA, voffA); PG8_STAGE(PG8_SB(0, 1), cB + hstep, voffB); PG8_STAGE(PG8_SA(0, 1), cA + hstep, voffA);
        if (wr == 1) PG8_BAR;
        PG8_WAIT_V(4); PG8_BAR;
        PG8_STAGE(PG8_SB(1, 0), cB + kstep, voffB); PG8_STAGE(PG8_SA(1, 0), cA + kstep, voffA); PG8_STAGE(PG8_SB(1, 1), cB + hstep + kstep, voffB);
        PG8_WAIT_V(6); PG8_BAR;
    }
    for (;;) {
        const bool has_next = S.next(ui + 1, nxt);
        const char* nA = has_next ? (const char*)g.A + (size_t)nxt.pm * tstep : cA; const char* nB = has_next ? (const char*)g.Bt + (size_t)nxt.pn * tstep + S.b_extra(nxt) : cB;
        for (int t = 0; t < nt; t += 2) {
            const bool last = (t == nt - 2);
            const char* a1 = cA + (size_t)(t + 1) * kstep;
            const char* a2 = last ? nA : cA + (size_t)(t + 2) * kstep; const char* b2 = last ? nB : cB + (size_t)(t + 2) * kstep;
            const char* a3 = a2 + kstep; const char* b3 = b2 + kstep;
            if (last && has_next) S.a_ready(nxt);
            if constexpr (SP2) {
            PG8_LDB(B0, 0, 0); PG8_LDB(B1, 0, 1); PG8_SCHED; PG8_LDA(At, 0, 0); PG8_STAGE(PG8_SA(1, 1), a1 + hstep, voffA);
            PG8_WAIT_V(8); PG8_WAIT_L(0); PG8_BAR; PG8_MMA(0, 0, At, B0); PG8_MMA(0, 1, At, B1); PG8_BAR; PG8_SCHED;
            PG8_LDA(At, 0, 1); PG8_STAGE(PG8_SB(0, 0), b2, voffB); PG8_STAGE(PG8_SB(0, 1), b2 + hstep, voffB); PG8_STAGE(PG8_SA(0, 0), a2, voffA);
            PG8_WAIT_V(8); PG8_WAIT_L(0); PG8_BAR; PG8_MMA(1, 0, At, B0); PG8_MMA(1, 1, At, B1); PG8_BAR; PG8_SCHED;
            PG8_LDB(B0, 1, 0); PG8_LDB(B1, 1, 1); PG8_SCHED; PG8_LDA(At, 1, 0); PG8_STAGE(PG8_SA(0, 1), a2 + hstep, voffA);
            PG8_WAIT_V(8); PG8_WAIT_L(0); PG8_BAR; PG8_MMA(0, 0, At, B0); PG8_MMA(0, 1, At, B1); PG8_BAR; PG8_SCHED;
            PG8_LDA(At, 1, 1); PG8_STAGE(PG8_SB(1, 0), b3, voffB); PG8_STAGE(PG8_SB(1, 1), b3 + hstep, voffB); PG8_STAGE(PG8_SA(1, 0), a3, voffA);
            PG8_WAIT_V(8); PG8_WAIT_L(0); PG8_BAR; PG8_MMA(1, 0, At, B0); PG8_MMA(1, 1, At, B1); PG8_BAR; PG8_SCHED;
            } else {
            PG8_LDB(B0, 0, 0); PG8_SCHED; PG8_LDA(At, 0, 0); PG8_STAGE(PG8_SA(1, 1), a1 + hstep, voffA);
            PG8_WAIT_L(8); PG8_BAR; PG8_WAIT_L(0); PG8_MMA(0, 0, At, B0); PG8_BAR; PG8_SCHED;
            PG8_LDB(B1, 0, 1); PG8_STAGE(PG8_SB(0, 0), b2, voffB);
            PG8_BAR; PG8_WAIT_L(0); PG8_MMA(0, 1, At, B1); PG8_BAR;
            PG8_LDA(At, 0, 1); PG8_STAGE(PG8_SA(0, 0), a2, voffA);
            PG8_BAR; PG8_WAIT_L(0); PG8_MMA(1, 0, At, B0); PG8_BAR; PG8_SCHED;
            PG8_STAGE(PG8_SB(0, 1), b2 + hstep, voffB);
            PG8_WAIT_V(6); PG8_BAR; PG8_MMA(1, 1, At, B1); PG8_BAR;
            PG8_LDB(B0, 1, 0); PG8_SCHED; PG8_LDA(At, 1, 0); PG8_STAGE(PG8_SA(0, 1), a2 + hstep, voffA);
            PG8_WAIT_L(8); PG8_BAR; PG8_WAIT_L(0); PG8_MMA(0, 0, At, B0); PG8_BAR; PG8_SCHED;
            PG8_LDB(B1, 1, 1); PG8_STAGE(PG8_SB(1, 0), b3, voffB);
            PG8_BAR; PG8_WAIT_L(0); PG8_MMA(0, 1, At, B1); PG8_BAR;
            PG8_LDA(At, 1, 1); PG8_STAGE(PG8_SA(1, 0), a3, voffA);
            PG8_BAR; PG8_WAIT_L(0); PG8_MMA(1, 0, At, B0); PG8_BAR; PG8_SCHED;
            PG8_STAGE(PG8_SB(1, 1), b3 + hstep, voffB);
            PG8_WAIT_V(6); PG8_BAR; PG8_MMA(1, 1, At, B1); PG8_BAR;
            }
        }
        if constexpr (ALIGN_EPI) { if (wr == 0) PG8_BAR; }
        if constexpr (!Epi::AFTER_DRAIN) { E(acc, cur, wr, wc, fr, fq); S.done(cur); }
        if (!has_next) break;
#pragma unroll
        for (int a = 0; a < 2; ++a)
#pragma unroll
            for (int b = 0; b < 2; ++b)
#pragma unroll
                for (int m = 0; m < 4; ++m)
#pragma unroll
                    for (int n = 0; n < 2; ++n) acc[a][b][m][n] = (f32x4){0.f, 0.f, 0.f, 0.f};
        cur = nxt; cA = nA; cB = nB; ++ui;
        if constexpr (ALIGN_EPI) { if (wr == 1) PG8_BAR; }
    }
    PG8_WAIT_V(0);
    if constexpr (!ALIGN_EPI) { if (wr == 0) PG8_BAR; }
    PG8_BAR;
    if constexpr (Epi::AFTER_DRAIN) { E.fused(acc, cur, wr, wc, fr, fq, lds, wid, lane); S.done(cur); }
#undef PG8_SA
#undef PG8_SB
#undef PG8_STAGE
#undef PG8_LDA
#undef PG8_LDB
#undef PG8_MMA
#undef PG8_WAIT_V
#undef PG8_WAIT_L
#undef PG8_BAR
#undef PG8_SCHED
}
}
struct PgEpiP {
    static constexpr bool PERM = true, AFTER_DRAIN = false; bf16* O; int ldc;
    __device__ __forceinline__ void operator()(const pg8::f32x4 (&acc)[2][2][4][2], const pg8::Unit& u, int wr, int wc, int fr, int fq) const {
        const int row0 = u.pm * 256 + wr * 64 + fr, col0 = u.pn * 256 + wc * 32 + 8 * fq;
#pragma unroll
        for (int ai = 0; ai < 2; ++ai)
#pragma unroll
            for (int m = 0; m < 4; ++m) { bf16* rowp = O + (size_t)(row0 + ai * 128 + m * 16) * ldc + col0;
#pragma unroll
                for (int bj = 0; bj < 2; ++bj) { const f32x4 v0 = acc[ai][bj][m][0], v1 = acc[ai][bj][m][1];
                    *(u32x4*)(rowp + bj * 128) = (u32x4){pg8::cvt_pk_bf16(v0[0], v0[1]), pg8::cvt_pk_bf16(v0[2], v0[3]), pg8::cvt_pk_bf16(v1[0], v1[1]), pg8::cvt_pk_bf16(v1[2], v1[3])}; } }
    }
};
struct PgEpiRes {
    static constexpr bool PERM = true, AFTER_DRAIN = false; const Params* p; int l, gj; bool first;
    __device__ __forceinline__ void operator()(const pg8::f32x4 (&acc)[2][2][4][2], const pg8::Unit& u, int wr, int wc, int fr, int fq) const {
        const int row0 = u.pm * 256 + wr * 64 + fr, col0 = u.pn * 256 + wc * 32 + 8 * fq;
#pragma unroll
        for (int ai = 0; ai < 2; ++ai)
#pragma unroll
            for (int m = 0; m < 4; ++m) { const int row = row0 + ai * 128 + m * 16;
                const float* src = xsrc_row(*p, first, row) + col0; float* dst = xdst_row(*p, row) + col0; const float* md = mod_vec(*p, l, row, gj) + col0;
#pragma unroll
                for (int bj = 0; bj < 2; ++bj)
#pragma unroll
                    for (int n = 0; n < 2; ++n) { const f32x4 sv = *(const f32x4*)(src + bj * 128 + 4 * n), mm = *(const f32x4*)(md + bj * 128 + 4 * n);
                        *(f32x4*)(dst + bj * 128 + 4 * n) = sv + mm * acc[ai][bj][m][n]; } }
    }
};
struct PgEpiSwi {
    static constexpr bool PERM = true, AFTER_DRAIN = false; bf16* Hd;
    __device__ __forceinline__ void operator()(const pg8::f32x4 (&acc)[2][2][4][2], const pg8::Unit& u, int wr, int wc, int fr, int fq) const {
        const int row0 = u.pm * 256 + wr * 64 + fr, col0 = u.pn * 128 + wc * 32 + 8 * fq;
#pragma unroll
        for (int ai = 0; ai < 2; ++ai)
#pragma unroll
            for (int m = 0; m < 4; ++m) { const f32x4 g0 = acc[ai][0][m][0], g1 = acc[ai][0][m][1], u0 = acc[ai][1][m][0], u1 = acc[ai][1][m][1];
                *(u32x4*)(Hd + (size_t)(row0 + ai * 128 + m * 16) * FF + col0) = (u32x4){pg8::cvt_pk_bf16(silu_f(g0[0]) * u0[0], silu_f(g0[1]) * u0[1]), pg8::cvt_pk_bf16(silu_f(g0[2]) * u0[2], silu_f(g0[3]) * u0[3]),
                    pg8::cvt_pk_bf16(silu_f(g1[0]) * u1[0], silu_f(g1[1]) * u1[1]), pg8::cvt_pk_bf16(silu_f(g1[2]) * u1[2], silu_f(g1[3]) * u1[3])}; }
    }
};
struct PgEpiMoeDown {
    static constexpr bool PERM = true, AFTER_DRAIN = false; bf16* Y2; const int* rowd; const float* rowg;
    __device__ __forceinline__ void operator()(const pg8::f32x4 (&acc)[2][2][4][2], const pg8::Unit& u, int wr, int wc, int fr, int fq) const {
        const int row0 = u.pm * 256 + wr * 64 + fr, col0 = u.pn * 256 + wc * 32 + 8 * fq;
#pragma unroll
        for (int ai = 0; ai < 2; ++ai)
#pragma unroll
            for (int m = 0; m < 4; ++m) { const int row = row0 + ai * 128 + m * 16; const int d = rowd[row]; if (d < 0) continue; const float g = rowg[row];
                bf16* rowp = Y2 + (size_t)d * D + col0;
#pragma unroll
                for (int bj = 0; bj < 2; ++bj) { const f32x4 v0 = acc[ai][bj][m][0] * g, v1 = acc[ai][bj][m][1] * g;
                    *(u32x4*)(rowp + bj * 128) = (u32x4){pg8::cvt_pk_bf16(v0[0], v0[1]), pg8::cvt_pk_bf16(v0[2], v0[3]), pg8::cvt_pk_bf16(v1[0], v1[1]), pg8::cvt_pk_bf16(v1[2], v1[3])}; } }
    }
};
template <class Epi>
__device__ __forceinline__ void run_gemm(unsigned char* lds, const bf16* A, const bf16* Bt, int M, int N, int K, const Epi& E, const int* tile_e, size_t estride, int bid, int nb) {
    pg8::Gemm g{A, Bt, M, N, K}; pg8::StaticOrder S; S.init(M, N, nb, bid); S.tile_e = tile_e; S.estride = estride;
    pg8::gemm_phase<Epi, pg8::StaticOrder, true, true>((__attribute__((address_space(3))) unsigned char*)lds, g, S, E);
}

__device__ __forceinline__ void prep_qk(const Params& p, int l, int nrows, int bid, int nb) {
    const int lane = threadIdx.x & 63, wave = threadIdx.x >> 6;
    bf16* P = (bf16*)(p.ws + WS_P);
    const float gq = p.in[21][l * 64 + lane], gk = p.in[22][l * 64 + lane];
    const int sec = lane >> 5, j = lane & 31, i = j & 15;
    const float invf = exp2f(-(float)i * (13.287712379549449f / 16.f));
    for (int row = bid * 8 + wave; row < nrows; row += nb * 8) {
        float cs = 1.f, sn = 0.f;
        if (row < SEQ) { const float pos = (float)(sec ? (row & 63) : (row >> 6)); const float x = pos * invf * 0.3183098861837907f; sn = sinpif(x); cs = cospif(x); }
        bf16* pr = P + (size_t)row * INC;
#pragma unroll
        for (int hv = 0; hv < 10; ++hv) {
            const int off = (hv < 8) ? C_AQ + hv * 64 : C_AK + (hv - 8) * 64;
            const float v = bf2f(pr[off + lane]);
            const float ss = wave_sum(v * v);
            float y = v * rsqrtf(ss * (1.f / 64.f) + EPS) * (hv < 8 ? gq : gk);
            const float o = __shfl_xor(y, 16);
            y = (j < 16) ? y * cs - o * sn : y * cs + o * sn;
            if (hv < 8) y *= C2;
            pr[off + lane] = (bf16)f2bf(y);
        }
    }
}
__device__ __forceinline__ float conv3(const bf16* P, const float* cw, const float* cb, int t, int lo, int hi, int col) {
    float a = cb[col] + cw[768 + col] * bf2f(P[(size_t)t * INC + col]);
    if (t - 1 >= lo) a += cw[col] * bf2f(P[(size_t)(t - 1) * INC + col]);
    if (t + 1 < hi) a += cw[1536 + col] * bf2f(P[(size_t)(t + 1) * INC + col]);
    return a;
}
__device__ __forceinline__ void prep_hyz(const Params& p, int l, bool with_ctx, float* sm, int bid, int nb) {
    const bf16* P = (const bf16*)(p.ws + WS_P);
    const float* cw = p.in[10] + l * 3 * 768; const float* cb = p.in[11] + l * 768;
    const int ntile = with_ctx ? 260 : 256, tid = threadIdx.x;
    for (int tile = bid; tile < ntile; tile += nb) {
        const int t0 = tile * 64; const int lo = tile < 256 ? 0 : SEQ, hi = tile < 256 ? SEQ : R;
        for (int e = tid; e < 64 * 256; e += NT) { const int tl = e >> 8, ch = e & 255;
            sm[ch * 65 + tl] = conv3(P, cw, cb, t0 + tl, lo, hi, C_HX1 + ch) * conv3(P, cw, cb, t0 + tl, lo, hi, C_HV + ch); }
        __syncthreads();
        for (int e = tid; e < 64 * 256; e += NT) { const int ch = e >> 6, tl = e & 63;
            if (tile < 256) ((float*)(p.ws + WS_ZT))[(size_t)ch * SEQ + t0 + tl] = sm[ch * 65 + tl];
            else ((float*)(p.ws + WS_ZC))[ch * CTXL + (t0 - SEQ) + tl] = sm[ch * 65 + tl]; }
        __syncthreads();
    }
}
__device__ __forceinline__ void prep_retu(const Params& p, int l, float* sm, int bid, int nb) {
    const bf16* P = (const bf16*)(p.ws + WS_P);
    float* Ks = sm; float* Vs = sm + 8192; float* wf = sm + 16384; float* wb = wf + 128;
    const int tid = threadIdx.x;
    for (int it = bid; it < NCH * 4; it += nb) {
        const int c = it >> 2, h = it & 3; const int r0 = c * 128;
        const float lgf = -__expf(p.in[20][l * 8 + h]), lgb = -__expf(p.in[20][l * 8 + 4 + h]);
        if (tid < 128) { wf[tid] = __expf(lgf * (float)(127 - tid)); wb[tid] = __expf(lgb * (float)tid); }
        for (int e = tid; e < 128 * 64; e += NT) { const int m = e >> 6, d = e & 63; const bf16* pr = P + (size_t)(r0 + m) * INC + h * 64 + d;
            Ks[e] = bf2f(pr[C_RK]) * 0.125f; Vs[e] = bf2f(pr[C_RV]); }
        __syncthreads();
        const int d = tid >> 3, e0 = (tid & 7) * 8;
        float af[8], ab[8];
#pragma unroll
        for (int j = 0; j < 8; ++j) { af[j] = 0.f; ab[j] = 0.f; }
        for (int m = 0; m < 128; ++m) { const float kd = Ks[m * 64 + d], kf = kd * wf[m], kb = kd * wb[m];
            const f32x4 v0 = *(const f32x4*)&Vs[m * 64 + e0], v1 = *(const f32x4*)&Vs[m * 64 + e0 + 4];
#pragma unroll
            for (int j = 0; j < 4; ++j) { af[j] += kf * v0[j]; ab[j] += kb * v0[j]; af[4 + j] += kf * v1[j]; ab[4 + j] += kb * v1[j]; } }
        float* U = (float*)(p.ws + WS_RU);
        float* uf = U + ((size_t)(0 * 4 + h) * NCH + c) * 4096 + d * 64 + e0; float* ub = U + ((size_t)(1 * 4 + h) * NCH + c) * 4096 + d * 64 + e0;
        *(f32x4*)uf = (f32x4){af[0], af[1], af[2], af[3]}; *(f32x4*)(uf + 4) = (f32x4){af[4], af[5], af[6], af[7]};
        *(f32x4*)ub = (f32x4){ab[0], ab[1], ab[2], ab[3]}; *(f32x4*)(ub + 4) = (f32x4){ab[4], ab[5], ab[6], ab[7]};
        __syncthreads();
    }
}
__device__ __forceinline__ void ph_retscan(const Params& p, int l, int bid, int nb) {
    float* U = (float*)(p.ws + WS_RU);
    for (int g = bid * NT + threadIdx.x; g < 8 * 4096; g += nb * NT) {
        const int dir = g >> 14, h = (g >> 12) & 3, e = g & 4095;
        const float lg = -__expf(p.in[20][l * 8 + dir * 4 + h]); const float Dc = __expf(lg * 128.f);
        float* u = U + (size_t)(dir * 4 + h) * NCH * 4096 + e;
        const float uc0 = u[(size_t)128 * 4096], uc1 = u[(size_t)129 * 4096];
        if (dir == 0) {
            float s = Dc * uc0 + uc1; u[(size_t)128 * 4096] = 0.f; u[(size_t)129 * 4096] = uc0;
            for (int c = 0; c < 128; ++c) { const float t = u[(size_t)c * 4096]; u[(size_t)c * 4096] = s; s = Dc * s + t; }
        } else {
            float s = uc0 + Dc * uc1; u[(size_t)129 * 4096] = 0.f; u[(size_t)128 * 4096] = uc1;
            for (int c = 127; c >= 0; --c) { const float t = u[(size_t)c * 4096]; u[(size_t)c * 4096] = s; s = Dc * s + t; }
        }
    }
}

__device__ __forceinline__ void post_ret(const Params& p, int l, int nchunks, unsigned char* smb, int bid, int nb) {
    const bf16* P = (const bf16*)(p.ws + WS_P); bf16* Y = (bf16*)(p.ws + WS_YMIX);
    bf16* Qs = (bf16*)smb; bf16* Ks = Qs + 128 * 72; bf16* Vs = Ks + 128 * 72; float* S = (float*)(smb + 3 * 128 * 72 * 2); float* pf = S + 128 * 132; float* pb = pf + 128;
    const int tid = threadIdx.x;
    for (int it = bid; it < nchunks * 4; it += nb) {
        const int c = it >> 2, h = it & 3, r0 = c * 128;
        const float lgf = -__expf(p.in[20][l * 8 + h]), lgb = -__expf(p.in[20][l * 8 + 4 + h]);
        if (tid < 128) { pf[tid] = __expf(lgf * (float)tid); pb[tid] = __expf(lgb * (float)tid); }
        for (int e = tid; e < 128 * 8; e += NT) { const int m = e >> 3, dc = e & 7; const bf16* pr = P + (size_t)(r0 + m) * INC + h * 64 + dc * 8;
            *(u32x4*)(Qs + m * 72 + dc * 8) = *(const u32x4*)(pr + C_RQ); *(u32x4*)(Ks + m * 72 + dc * 8) = *(const u32x4*)(pr + C_RK); *(u32x4*)(Vs + m * 72 + dc * 8) = *(const u32x4*)(pr + C_RV); }
        __syncthreads();
        {
            const int tn = tid >> 4, tm = tid & 15;
            float acc[4][8];
#pragma unroll
            for (int i = 0; i < 4; ++i)
#pragma unroll
                for (int j = 0; j < 8; ++j) acc[i][j] = 0.f;
            for (int dc = 0; dc < 8; ++dc) {
                u32x4 q[4], k[8];
#pragma unroll
                for (int i = 0; i < 4; ++i) q[i] = *(const u32x4*)(Qs + (tn + 32 * i) * 72 + dc * 8);
#pragma unroll
                for (int j = 0; j < 8; ++j) k[j] = *(const u32x4*)(Ks + (tm + 16 * j) * 72 + dc * 8);
#pragma unroll
                for (int i = 0; i < 4; ++i)
#pragma unroll
                    for (int j = 0; j < 8; ++j)
#pragma unroll
                        for (int w = 0; w < 4; ++w) acc[i][j] += lo16(q[i][w]) * lo16(k[j][w]) + hi16(q[i][w]) * hi16(k[j][w]);
            }
#pragma unroll
            for (int i = 0; i < 4; ++i)
#pragma unroll
                for (int j = 0; j < 8; ++j) { const int n = tn + 32 * i, m = tm + 16 * j;
                    const float f = (n > m) ? pf[n - m] : ((n < m) ? pb[m - n] : 2.f);
                    S[n * 132 + m] = acc[i][j] * 0.125f * f; }
        }
        __syncthreads();
        {
            const int n = tid >> 2, eq = tid & 3;
            float acc[16];
#pragma unroll
            for (int e = 0; e < 16; ++e) acc[e] = 0.f;
            for (int m = 0; m < 128; ++m) { const float sv = S[n * 132 + m];
                const u32x4 v0 = *(const u32x4*)(Vs + m * 72 + eq * 16), v1 = *(const u32x4*)(Vs + m * 72 + eq * 16 + 8);
#pragma unroll
                for (int w = 0; w < 4; ++w) { acc[2 * w] += sv * lo16(v0[w]); acc[2 * w + 1] += sv * hi16(v0[w]); acc[8 + 2 * w] += sv * lo16(v1[w]); acc[9 + 2 * w] += sv * hi16(v1[w]); } }
            const float* SPf = (const float*)(p.ws + WS_RU) + ((size_t)(0 * 4 + h) * NCH + c) * 4096 + eq * 16;
            const float* SPb = (const float*)(p.ws + WS_RU) + ((size_t)(1 * 4 + h) * NCH + c) * 4096 + eq * 16;
            const float xif = pf[n] * pf[1], xib = pb[127 - n] * pb[1];
            for (int d = 0; d < 64; ++d) { const float qd = bf2f(Qs[n * 72 + d]), qf = qd * xif, qb = qd * xib;
#pragma unroll
                for (int w = 0; w < 4; ++w) { const f32x4 a = *(const f32x4*)(SPf + d * 64 + 4 * w), b = *(const f32x4*)(SPb + d * 64 + 4 * w);
                    acc[4 * w] += qf * a.x + qb * b.x; acc[4 * w + 1] += qf * a.y + qb * b.y; acc[4 * w + 2] += qf * a.z + qb * b.z; acc[4 * w + 3] += qf * a.w + qb * b.w; } }
            float s = 0.f;
#pragma unroll
            for (int e = 0; e < 16; ++e) s += acc[e];
            s += __shfl_xor(s, 1); s += __shfl_xor(s, 2);
            const float mu = s * (1.f / 64.f); float vs = 0.f;
#pragma unroll
            for (int e = 0; e < 16; ++e) { acc[e] -= mu; vs += acc[e] * acc[e]; }
            vs += __shfl_xor(vs, 1); vs += __shfl_xor(vs, 2);
            const float rs = rsqrtf(vs * (1.f / 64.f) + EPS);
            const bf16* gr = P + (size_t)(r0 + n) * INC + C_RG + h * 64 + eq * 16;
            const u32x4 g0 = *(const u32x4*)gr, g1 = *(const u32x4*)(gr + 8);
            u32x4 o0, o1;
#pragma unroll
            for (int w = 0; w < 4; ++w) { o0[w] = pk2(silu_f(lo16(g0[w])) * acc[2 * w] * rs, silu_f(hi16(g0[w])) * acc[2 * w + 1] * rs);
                o1[w] = pk2(silu_f(lo16(g1[w])) * acc[8 + 2 * w] * rs, silu_f(hi16(g1[w])) * acc[9 + 2 * w] * rs); }
            bf16* yo = Y + (size_t)(r0 + n) * D + 256 + h * 64 + eq * 16;
            *(u32x4*)yo = o0; *(u32x4*)(yo + 8) = o1;
        }
        __syncthreads();
    }
}
__device__ __forceinline__ void post_hy(const Params& p, int l, bool with_ctx, float* sm, int bid, int nb) {
    const bf16* P = (const bf16*)(p.ws + WS_P); bf16* Y = (bf16*)(p.ws + WS_YMIX);
    const float* cw = p.in[10] + l * 3 * 768; const float* cb = p.in[11] + l * 768; const float* hb = p.in[19] + l * 256;
    const int ntile = with_ctx ? 260 : 256, tid = threadIdx.x;
    for (int tile = bid; tile < ntile; tile += nb) {
        const int t0 = tile * 64; const int lo = tile < 256 ? 0 : SEQ, hi = tile < 256 ? SEQ : R;
        for (int e = tid; e < 64 * 256; e += NT) { const int ch = e >> 6, tl = e & 63;
            sm[ch * 65 + tl] = (tile < 256) ? ((const float*)(p.ws + WS_ZT))[(size_t)ch * SEQ + t0 + tl] : ((const float*)(p.ws + WS_ZC))[ch * CTXL + (t0 - SEQ) + tl]; }
        __syncthreads();
        for (int e = tid; e < 64 * 256; e += NT) { const int tl = e >> 8, ch = e & 255, t = t0 + tl;
            const float x0 = conv3(P, cw, cb, t, lo, hi, C_HX0 + ch), z = conv3(P, cw, cb, t, lo, hi, C_HX1 + ch) * conv3(P, cw, cb, t, lo, hi, C_HV + ch);
            Y[(size_t)t * D + ch] = (bf16)f2bf(x0 * (sm[ch * 65 + tl] + hb[ch] * z)); }
        __syncthreads();
    }
}

__device__ __forceinline__ void attn_naive(const Params& p, bool with_ctx, float* sm, int bid, int nb) {
    const bf16* P = (const bf16*)(p.ws + WS_P); bf16* Y = (bf16*)(p.ws + WS_YMIX);
    float* Ks = sm; float* Vs = sm + 32 * 64;
    const int tid = threadIdx.x, nunits = with_ctx ? 264 : 256;
    for (int u = bid; u < nunits; u += nb) {
        int h, q0, nq, k0, nk;
        if (u < 256) { h = u >> 5; q0 = (u & 31) * 512; nq = 512; k0 = 0; nk = R; } else { h = u - 256; q0 = SEQ; nq = 256; k0 = SEQ; nk = CTXL; }
        const int kvh = h >> 2; const bool act = tid < nq; const int qrow = q0 + (act ? tid : 0);
        float qv[64], o[64];
        { const u32x4* qp = (const u32x4*)(P + (size_t)qrow * INC + C_AQ + h * 64);
#pragma unroll
          for (int c = 0; c < 8; ++c) { const u32x4 w = qp[c];
#pragma unroll
              for (int x = 0; x < 4; ++x) { qv[c * 8 + 2 * x] = lo16(w[x]); qv[c * 8 + 2 * x + 1] = hi16(w[x]); } } }
#pragma unroll
        for (int d = 0; d < 64; ++d) o[d] = 0.f;
        float m = -1.0e30f, ls = 0.f;
        for (int kt = 0; kt < nk; kt += 32) {
            __syncthreads();
            { const int e = tid * 4, kr = e >> 6, d = e & 63; const bf16* kp = P + (size_t)(k0 + kt + kr) * INC + kvh * 64 + d;
              const u32x2 kw = *(const u32x2*)(kp + C_AK), vw = *(const u32x2*)(kp + C_AV);
              Ks[e] = lo16(kw.x); Ks[e + 1] = hi16(kw.x); Ks[e + 2] = lo16(kw.y); Ks[e + 3] = hi16(kw.y);
              Vs[e] = lo16(vw.x); Vs[e + 1] = hi16(vw.x); Vs[e + 2] = lo16(vw.y); Vs[e + 3] = hi16(vw.y); }
            __syncthreads();
#pragma unroll 1
            for (int j = 0; j < 32; ++j) { float a = 0.f;
#pragma unroll
                for (int d4 = 0; d4 < 16; ++d4) { const f32x4 kk = *(const f32x4*)&Ks[j * 64 + d4 * 4]; a += qv[d4 * 4] * kk.x + qv[d4 * 4 + 1] * kk.y + qv[d4 * 4 + 2] * kk.z + qv[d4 * 4 + 3] * kk.w; }
                const float mn = fmaxf(m, a), sc = exp2f(m - mn), pj = exp2f(a - mn); m = mn; ls = ls * sc + pj;
#pragma unroll
                for (int d4 = 0; d4 < 16; ++d4) { const f32x4 vv = *(const f32x4*)&Vs[j * 64 + d4 * 4];
                    o[d4 * 4] = o[d4 * 4] * sc + pj * vv.x; o[d4 * 4 + 1] = o[d4 * 4 + 1] * sc + pj * vv.y; o[d4 * 4 + 2] = o[d4 * 4 + 2] * sc + pj * vv.z; o[d4 * 4 + 3] = o[d4 * 4 + 3] * sc + pj * vv.w; } }
        }
        if (act) { const float il = 1.f / ls; u32x4* yo = (u32x4*)(Y + (size_t)qrow * D + 512 + h * 64);
#pragma unroll
            for (int c = 0; c < 8; ++c) yo[c] = (u32x4){pk2(o[c * 8] * il, o[c * 8 + 1] * il), pk2(o[c * 8 + 2] * il, o[c * 8 + 3] * il), pk2(o[c * 8 + 4] * il, o[c * 8 + 5] * il), pk2(o[c * 8 + 6] * il, o[c * 8 + 7] * il)}; }
    }
}

__device__ __forceinline__ int moe_segments(const Params& p, int* seg  , int* tile_e  ) {
    const unsigned* cnt = (const unsigned*)(p.ws + WS_CTL) + CW_CNT;
    if (threadIdx.x == 0) { int s = 0; for (int e = 0; e < 8; ++e) { seg[e] = s; s += (int)((cnt[e] + 255u) >> 8) << 8; } seg[8] = s; }
    __syncthreads();
    const int total = seg[8];
    for (int t = threadIdx.x; t < total / 128; t += NT) { int e = 0; while (t * 128 >= seg[e + 1]) ++e; tile_e[t] = e; }
    __syncthreads();
    return total;
}
__device__ __forceinline__ void ph_gather(const Params& p, int* ism, int bid, int nb) {
    int* seg = ism; int* tile_e = ism + 16;
    const int total = moe_segments(p, seg, tile_e);
    const unsigned* cnt = (const unsigned*)(p.ws + WS_CTL) + CW_CNT;
    const int lane = threadIdx.x & 63, wave = threadIdx.x >> 6;
    const bf16* H = (const bf16*)(p.ws + WS_H); bf16* XS = (bf16*)(p.ws + WS_XS);
    int* rowd = (int*)(p.ws + WS_ROWD); float* rowg = (float*)(p.ws + WS_ROWG);
    const int* at = (const int*)(p.ws + WS_ASGT); const float* ag = (const float*)(p.ws + WS_ASGG);
    for (int s = bid * 8 + wave; s < total; s += nb * 8) {
        const int e = tile_e[s >> 7], pos = s - seg[e];
        u32x4 v0 = (u32x4){0u, 0u, 0u, 0u}, v1 = v0; int dd = -1; float gg = 0.f;
        if (pos < (int)cnt[e]) { dd = at[e * SEQ + pos]; gg = ag[e * SEQ + pos]; const u32x4* src = (const u32x4*)(H + (size_t)(dd >> 1) * D); v0 = src[lane]; v1 = src[64 + lane]; }
        u32x4* dst = (u32x4*)(XS + (size_t)s * D); dst[lane] = v0; dst[64 + lane] = v1;
        if (lane == 0) { rowd[s] = dd; rowg[s] = gg; }
    }
}
__device__ __forceinline__ void ph_final(const Params& p, int bid, int nb) {
    const int lane = threadIdx.x & 63, wave = threadIdx.x >> 6;
    const bf16* Y2 = (const bf16*)(p.ws + WS_Y2); const float* g = p.in[31];
    for (int row = bid * 8 + wave; row < SEQ; row += nb * 8) {
        f32x4* xr = (f32x4*)(p.out + (size_t)row * D) + lane; const f32x4* m5 = (const f32x4*)mod_vec(p, 1, row, 5) + lane;
        const u32x2* ya = (const u32x2*)(Y2 + (size_t)(2 * row) * D) + lane; const u32x2* yb = (const u32x2*)(Y2 + (size_t)(2 * row + 1) * D) + lane;
        f32x4 v[4]; float ss = 0.f;
#pragma unroll
        for (int j = 0; j < 4; ++j) { const u32x2 a = ya[64 * j], b = yb[64 * j]; const f32x4 m = m5[64 * j];
            const f32x4 y = (f32x4){lo16(a.x) + lo16(b.x), hi16(a.x) + hi16(b.x), lo16(a.y) + lo16(b.y), hi16(a.y) + hi16(b.y)};
            v[j] = xr[64 * j] + m * y; ss += (v[j].x * v[j].x + v[j].y * v[j].y) + (v[j].z * v[j].z + v[j].w * v[j].w); }
        const float r = rsqrtf(wave_sum(ss) * (1.f / D) + EPS);
#pragma unroll
        for (int j = 0; j < 4; ++j) xr[64 * j] = v[j] * r * ((const f32x4*)g)[lane + 64 * j];
    }
}

#define LAS __attribute__((address_space(3)))
#define XB_TMO      128
#define XB_XCNT(j)  (256  + 64 * (j))
#define XB_XSUB(j)  (1280 + 64 * (j))
#define XB_XGEN(j)  (2304 + 64 * (j))
#define XB_TOP      3328
#define XB_TOPGEN   3392
#define XCD_BAR_WORDS 3456
#define XB_SPIN_CAP (1u << 18)
__device__ __forceinline__ unsigned xb_ld(unsigned* p)              { return __hip_atomic_load(p, __ATOMIC_RELAXED, __HIP_MEMORY_SCOPE_AGENT); }
__device__ __forceinline__ unsigned xb_add(unsigned* p, unsigned v) { return __hip_atomic_fetch_add(p, v, __ATOMIC_RELAXED, __HIP_MEMORY_SCOPE_AGENT); }
__device__ __forceinline__ unsigned xb_xcc_id() { return (unsigned)__builtin_amdgcn_s_getreg((3 << 11) | 20) & 0xFu; }
#define XB_SPIN(cond, bar) do { unsigned _sp = 0; while (cond) { __builtin_amdgcn_s_sleep(1); \
    if ((++_sp & 255u) == 0u) { if (xb_ld(&(bar)[XB_TMO])) break; if (_sp > XB_SPIN_CAP) { atomicAdd(&(bar)[XB_TMO], 1u); break; } } } } while (0)
struct XcdBarrier { unsigned* bar; unsigned x; volatile LAS unsigned* st; };
__device__ __forceinline__ XcdBarrier xcd_barrier_post(unsigned* bar, volatile LAS unsigned* st) {
    XcdBarrier b; b.bar = bar; b.x = xb_xcc_id(); b.st = st;
    if (threadIdx.x == 0) (void)xb_add(&bar[XB_XCNT(b.x)], 1u);
    return b;
}
__device__ __forceinline__ void xcd_barrier_complete(unsigned* bar, unsigned x, unsigned& nloc, unsigned& nx) {
    const unsigned G = gridDim.x * gridDim.y * gridDim.z;
    unsigned sum, cnt, mine, sp = 0u;
    for (;;) {
        sum = 0u; cnt = 0u; mine = 0u;
#pragma unroll
        for (unsigned j = 0; j < 16; ++j) { const unsigned c = xb_ld(&bar[XB_XCNT(j)]); sum += c; cnt += (c > 0u) ? 1u : 0u; mine = (j == x) ? c : mine; }
        if (sum == G) break;
        __builtin_amdgcn_s_sleep(1);
        if ((++sp & 255u) == 0u) { if (xb_ld(&bar[XB_TMO])) break; if (sp > XB_SPIN_CAP) { atomicAdd(&bar[XB_TMO], 1u); break; } }
    }
    nloc = mine > 0u ? mine : 1u; nx = cnt > 0u ? cnt : 1u;
}
__device__ __forceinline__ void xcd_barrier(const XcdBarrier& b) {
    asm volatile("s_waitcnt vmcnt(0)" ::: "memory");
    __syncthreads();
    if (threadIdx.x == 0) {
        unsigned* bar = b.bar;
        __builtin_amdgcn_s_waitcnt(0);
        unsigned nloc = b.st[0], nx = b.st[1];
        if (nloc == 0u) { xcd_barrier_complete(bar, b.x, nloc, nx); b.st[0] = nloc; b.st[1] = nx; }
        const unsigned old = xb_add(&bar[XB_XSUB(b.x)], 1u);
        const unsigned gen = old / nloc;
        if (old + 1u == (gen + 1u) * nloc) {
            __builtin_amdgcn_fence(__ATOMIC_RELEASE, "agent");
            asm volatile("s_waitcnt vmcnt(0)" ::: "memory");
            const unsigned og = xb_add(&bar[XB_TOP], 1u);
            const unsigned tg = og / nx;
            if (og + 1u == (tg + 1u) * nx) xb_add(&bar[XB_TOPGEN], 1u);
            else XB_SPIN(xb_ld(&bar[XB_TOPGEN]) == tg, bar);
            __builtin_amdgcn_fence(__ATOMIC_ACQUIRE, "agent");
            xb_add(&bar[XB_XGEN(b.x)], 1u);
            asm volatile("s_waitcnt vmcnt(0)" ::: "memory");
        } else {
            XB_SPIN(xb_ld(&bar[XB_XGEN(b.x)]) == gen, bar);
            __builtin_amdgcn_fence(__ATOMIC_ACQUIRE, "agent");
            asm volatile("s_waitcnt vmcnt(0)" ::: "memory");
        }
    }
    __syncthreads();
}

constexpr int LDS_BYTES = 147456;
constexpr int LDS_MISC = 131072 + 8192;
constexpr int NPHASE = 21;

__global__ void __launch_bounds__(NT, 2) k_run(Params p) {
    extern __shared__ __attribute__((aligned(16))) unsigned char lds[];
    float* sm = (float*)lds;
    const int bid = blockIdx.x, nb = gridDim.x;
    volatile LAS unsigned* misc = (volatile LAS unsigned*)((LAS unsigned char*)lds + LDS_MISC);
    if (threadIdx.x < 16) misc[threadIdx.x] = 0u;
    __syncthreads();
    XcdBarrier bar; bar.bar = (unsigned*)(p.ws + WS_CTL) + CW_BAR; bar.x = 0; bar.st = nullptr;
    if (p.ph_hi - p.ph_lo > 1) bar = xcd_barrier_post((unsigned*)(p.ws + WS_CTL) + CW_BAR, misc + 8);
    const int lo = p.ph_lo, hi = p.ph_hi;
#ifndef ONLY_PH
#define ONLY_PH -1
#endif
#define IN(k) ((ONLY_PH < 0 || ONLY_PH == (k)) && lo <= (k) && (k) < hi)
#define SEAM(k) do { if (IN(k) && IN((k) + 1)) xcd_barrier(bar); } while (0)

    if (IN(0)) { ph_mod(p, sm, bid, nb); ph_tw(p, bid, nb); __syncthreads(); ph_filt(p, sm, bid, nb); __syncthreads(); ph_wconv(p, sm, bid, nb); } SEAM(0);
    if (IN(1)) { ph_hfft(p, sm, bid, nb); ph_norm(p, 0, 0, true, R, false, bid, nb); } SEAM(1);
    if (IN(2)) { PgEpiP E{(bf16*)(p.ws + WS_P), INC}; run_gemm(lds, (const bf16*)(p.ws + WS_H), (const bf16*)(p.ws + WS_WIN), R, INC, D, E, nullptr, 0, bid, nb); } SEAM(2);
    if (IN(3)) { prep_qk(p, 0, R, bid, nb); prep_hyz(p, 0, true, sm, bid, nb); prep_retu(p, 0, sm, bid, nb); } SEAM(3);
    if (IN(4)) { ph_retscan(p, 0, bid, nb);
        for (int u = bid; u < 512; u += nb) { if (u < 256) hconv_unit(p, 0, u, sm); else hconv_ctx_unit(p, u - 256, sm); }
        attn_naive(p, true, sm, bid, nb); } SEAM(4);
    if (IN(5)) { post_ret(p, 0, NCH, lds, bid, nb); post_hy(p, 0, true, sm, bid, nb); } SEAM(5);
    if (IN(6)) { PgEpiRes E{&p, 0, 2, true}; run_gemm(lds, (const bf16*)(p.ws + WS_YMIX), (const bf16*)(p.ws + WS_WOUT), R, D, D, E, nullptr, 0, bid, nb); } SEAM(6);
    if (IN(7)) { ph_norm(p, 0, 1, false, R, false, bid, nb); } SEAM(7);
    if (IN(8)) { PgEpiSwi E{(bf16*)(p.ws + WS_HID)}; run_gemm(lds, (const bf16*)(p.ws + WS_H), (const bf16*)(p.ws + WS_WGU), R, 2 * FF, D, E, nullptr, 0, bid, nb); } SEAM(8);
    if (IN(9)) { PgEpiRes E{&p, 0, 5, false}; run_gemm(lds, (const bf16*)(p.ws + WS_HID), (const bf16*)(p.ws + WS_WDN), R, D, FF, E, nullptr, 0, bid, nb); } SEAM(9);
    if (IN(10)) { ph_norm(p, 1, 0, false, R, false, bid, nb); } SEAM(10);
    if (IN(11)) { PgEpiP E{(bf16*)(p.ws + WS_P), INC}; run_gemm(lds, (const bf16*)(p.ws + WS_H), (const bf16*)(p.ws + WS_WIN) + (size_t)INC * D, R, INC, D, E, nullptr, 0, bid, nb); } SEAM(11);
    if (IN(12)) { prep_qk(p, 1, R, bid, nb); prep_hyz(p, 1, false, sm, bid, nb); prep_retu(p, 1, sm, bid, nb); } SEAM(12);
    if (IN(13)) { ph_retscan(p, 1, bid, nb);
        for (int u = bid; u < 256; u += nb) hconv_unit(p, 1, u, sm);
        attn_naive(p, false, sm, bid, nb); } SEAM(13);
    if (IN(14)) { post_ret(p, 1, 128, lds, bid, nb); post_hy(p, 1, false, sm, bid, nb); } SEAM(14);
    if (IN(15)) { PgEpiRes E{&p, 1, 2, false}; run_gemm(lds, (const bf16*)(p.ws + WS_YMIX), (const bf16*)(p.ws + WS_WOUT) + (size_t)D * D, SEQ, D, D, E, nullptr, 0, bid, nb); } SEAM(15);
    if (IN(16)) { ph_norm(p, 1, 1, false, SEQ, true, bid, nb); } SEAM(16);
    if (IN(17)) { ph_gather(p, (int*)(lds + LDS_MISC + 256), bid, nb); } SEAM(17);
    if (IN(18)) { int* ism = (int*)(lds + LDS_MISC + 256); const int total = moe_segments(p, ism, ism + 16);
        PgEpiSwi E{(bf16*)(p.ws + WS_HIDM)}; run_gemm(lds, (const bf16*)(p.ws + WS_XS), (const bf16*)(p.ws + WS_MOEW), total, 2 * FF, D, E, ism + 16, MOEW_E * 2, bid, nb); } SEAM(18);
    if (IN(19)) { int* ism = (int*)(lds + LDS_MISC + 256); const int total = moe_segments(p, ism, ism + 16);
        PgEpiMoeDown E{(bf16*)(p.ws + WS_Y2), (const int*)(p.ws + WS_ROWD), (const float*)(p.ws + WS_ROWG)};
        run_gemm(lds, (const bf16*)(p.ws + WS_HIDM), (const bf16*)(p.ws + WS_MOEW) + (size_t)5632 * 1024, total, D, FF, E, ism + 16, MOEW_E * 2, bid, nb); } SEAM(19);
    if (IN(20)) { ph_final(p, bid, nb); }
#undef IN
#undef SEAM
}

extern "C" void kernel_launch(void* const* d_in, const int* in_sizes, int n_in, void* d_out, int out_size, void* d_ws, size_t ws_size, hipStream_t stream) {
    static int grid = 0;
    if (grid == 0) {
        if (n_in != 32 || out_size != SEQ * D || ws_size < WS_END) { fprintf(stderr, "kernel_launch: unexpected problem (n_in %d out %d ws %zu)\n", n_in, out_size, ws_size); grid = -1; return; }
        int dev = 0, cus = 0;
        if (hipGetDevice(&dev) != hipSuccess || hipDeviceGetAttribute(&cus, hipDeviceAttributeMultiprocessorCount, dev) != hipSuccess) { grid = -1; return; }
        if (hipFuncSetAttribute((const void*)k_run, hipFuncAttributeMaxDynamicSharedMemorySize, LDS_BYTES) != hipSuccess) { fprintf(stderr, "kernel_launch: LDS attribute failed\n"); grid = -1; return; }
        int per_cu = 0; (void)hipOccupancyMaxActiveBlocksPerMultiprocessor(&per_cu, (const void*)k_run, NT, LDS_BYTES); (void)hipGetLastError();
        grid = cus > 0 ? cus : 256;
    }
    if (grid < 0) return;
    (void)hipMemsetAsync((char*)d_ws + WS_CTL, 0, CTL_BYTES, stream);
    Params p; memset(&p, 0, sizeof(p));
    for (int i = 0; i < 32; ++i) p.in[i] = (const float*)d_in[i];
    p.out = (float*)d_out; p.ws = (unsigned char*)d_ws;
#if N_LAUNCH_MODE == 1
    p.ph_lo = 0; p.ph_hi = NPHASE;
    hipLaunchKernelGGL(k_run, dim3(grid), dim3(NT), LDS_BYTES, stream, p);
#else
    for (int ph = 0; ph < NPHASE; ++ph) { p.ph_lo = ph; p.ph_hi = ph + 1; hipLaunchKernelGGL(k_run, dim3(grid), dim3(NT), LDS_BYTES, stream, p); }
#endif
}
```

```cpp
#include <hip/hip_runtime.h>
#include <cstdio>
#include <cstdint>
#include <cstring>

typedef unsigned short bf16;
typedef unsigned u32x4 __attribute__((ext_vector_type(4)));
typedef unsigned u32x2 __attribute__((ext_vector_type(2)));
typedef float f32x4 __attribute__((ext_vector_type(4)));
typedef float f32x2 __attribute__((ext_vector_type(2)));

#ifndef N_LAUNCH_MODE
#define N_LAUNCH_MODE 1
#endif

constexpr int D = 1024, SEQ = 16384, CTXL = 256, R = SEQ + CTXL;
constexpr int INC = 2560, FF = 2816, NE = 8;
constexpr int C_HX0 = 0, C_HX1 = 256, C_HV = 512, C_RQ = 768, C_RK = 1024, C_RV = 1280, C_RG = 1536, C_AQ = 1792, C_AK = 2304, C_AV = 2432;
constexpr int FN = 32768, FM = 16384;
constexpr int NCH = 130;
constexpr float EPS = 1e-6f;
constexpr float C2 = 0.125f * 1.4426950408889634f;
constexpr int NT = 512;
constexpr int MOE_MAXROWS = 34560;

constexpr size_t MiB = 1u << 20;
constexpr size_t WS_CTL = 0, CTL_BYTES = MiB;
constexpr size_t WS_MOD = 1 * MiB;
constexpr size_t WS_TW = 1 * MiB + 128 * 1024;
constexpr size_t WS_TWN = 1 * MiB + 256 * 1024;
constexpr size_t WS_XC = 2 * MiB;
constexpr size_t WS_ASGT = 3 * MiB;
constexpr size_t WS_ASGG = 3 * MiB + 512 * 1024;
constexpr size_t WS_ROWD = 4 * MiB;
constexpr size_t WS_ROWG = 4 * MiB + 256 * 1024;
constexpr size_t WS_TAPSC = 5 * MiB;
constexpr size_t WS_ZC = 5 * MiB + 512 * 1024;
constexpr size_t WS_HSPEC = 8 * MiB;
constexpr size_t WS_ZT = 72 * MiB;
constexpr size_t WS_RU = 88 * MiB;
constexpr size_t WS_WIN = 105 * MiB;
constexpr size_t WS_WOUT = 115 * MiB;
constexpr size_t WS_WGU = 119 * MiB;
constexpr size_t WS_WDN = 130 * MiB;
constexpr size_t WS_H = 136 * MiB;
constexpr size_t WS_P = 169 * MiB;
constexpr size_t WS_YMIX = 251 * MiB;
constexpr size_t WS_HID = 169 * MiB;
constexpr size_t WS_MOEW = 306 * MiB;
constexpr size_t WS_XS = 8 * MiB;
constexpr size_t WS_Y2 = 8 * MiB;
constexpr size_t WS_HIDM = 105 * MiB;
constexpr size_t WS_END = 438 * MiB;
constexpr size_t MOEW_E = (size_t)(5632 * 1024 + 1024 * 2816);
static_assert(WS_HIDM + (size_t)MOE_MAXROWS * FF * 2 <= WS_MOEW, "map");
static_assert(WS_XS + (size_t)MOE_MAXROWS * D * 2 <= WS_HIDM, "map");
static_assert(WS_MOEW + 8 * MOEW_E * 2 <= WS_END, "map");

constexpr int CW_CNT = 64;
constexpr int CW_BAR = 4096;

struct Params { const float* in[32]; float* out; unsigned char* ws; int ph_lo, ph_hi; };

__device__ __forceinline__ float bf2f(bf16 v) { return __uint_as_float((unsigned)v << 16); }
__device__ __forceinline__ unsigned f2bf(float f) { unsigned u = __float_as_uint(f); return (u + 0x7fffu + ((u >> 16) & 1u)) >> 16; }
__device__ __forceinline__ unsigned pk2(float lo, float hi) { return f2bf(lo) | (f2bf(hi) << 16); }
__device__ __forceinline__ float lo16(unsigned w) { return __uint_as_float(w << 16); }
__device__ __forceinline__ float hi16(unsigned w) { return __uint_as_float(w & 0xffff0000u); }
__device__ __forceinline__ float wave_sum(float v) {
#pragma unroll
    for (int o = 1; o < 64; o <<= 1) v += __shfl_xor(v, o);
    return v;
}
__device__ __forceinline__ float silu_f(float x) { return x / (1.f + __expf(-x)); }
__device__ __forceinline__ const float* xsrc_row(const Params& p, bool first, int row) {
    if (first) return row < SEQ ? p.in[0] + (size_t)row * D : p.in[2] + (size_t)(row - SEQ) * D;
    return row < SEQ ? p.out + (size_t)row * D : (const float*)(p.ws + WS_XC) + (size_t)(row - SEQ) * D;
}
__device__ __forceinline__ float* xdst_row(const Params& p, int row) {
    return row < SEQ ? p.out + (size_t)row * D : (float*)(p.ws + WS_XC) + (size_t)(row - SEQ) * D;
}
__device__ __forceinline__ const float* mod_vec(const Params& p, int l, int row, int j) {
    return (const float*)(p.ws + WS_MOD) + (size_t)((l * 2 + (row >= SEQ ? 1 : 0)) * 6 + j) * D;
}

__device__ __forceinline__ void ph_mod(const Params& p, float* sm, int bid, int nb) {
    const float* c = p.in[1]; const float* cc = p.in[3]; const float* W = p.in[4]; const float* B = p.in[5];
    float* MOD = (float*)(p.ws + WS_MOD);
    float* sc = sm; float* scc = sm + 1024; float* red = sm + 2048;
    const int tid = threadIdx.x;
    for (int i = tid; i < 1024; i += NT) { sc[i] = silu_f(c[i]); scc[i] = silu_f(cc[i]); }
    __syncthreads();
    for (int it = bid; it < 192; it += nb) {
        const int l = it / 96, cl = tid & 63, col = (it % 96) * 64 + cl, kg = tid >> 6;
        const float* w = W + (size_t)l * 1024 * 6144 + col;
        float a0 = 0.f, a1 = 0.f;
#pragma unroll 8
        for (int k = kg * 128; k < kg * 128 + 128; ++k) { const float wv = w[(size_t)k * 6144]; a0 += sc[k] * wv; a1 += scc[k] * wv; }
        red[(kg * 64 + cl) * 2] = a0; red[(kg * 64 + cl) * 2 + 1] = a1;
        __syncthreads();
        if (tid < 128) { const int c2 = tid & 63, s = tid >> 6; float sum = 0.f;
            for (int g = 0; g < 8; ++g) sum += red[(g * 64 + c2) * 2 + s];
            const int colg = (it % 96) * 64 + c2; MOD[(size_t)(l * 2 + s) * 6144 + colg] = sum + B[l * 6144 + colg]; }
        __syncthreads();
    }
}
__device__ __forceinline__ void ph_tw(const Params& p, int bid, int nb) {
    f32x2* TW = (f32x2*)(p.ws + WS_TW); f32x2* TWN = (f32x2*)(p.ws + WS_TWN);
    for (int k = bid * NT + threadIdx.x; k <= FM / 2; k += nb * NT) {
        float s, c;
        if (k < FM / 2) { const float x = (float)k * (2.0f / FM); s = sinpif(x); c = cospif(x); TW[k] = (f32x2){c, -s}; }
        { const float x = (float)k * (2.0f / FN); s = sinpif(x); c = cospif(x); TWN[k] = (f32x2){c, -s}; }
    }
}
__device__ __forceinline__ void transpose_item(const float* W, int K, int N, bf16* WT, int drow0, int k0, int n0, float* scr, int lane) {
#pragma unroll 8
    for (int i = 0; i < 32; ++i) { const int kk = 2 * i + (lane >> 5); scr[kk * 33 + (lane & 31)] = W[(size_t)(k0 + kk) * N + n0 + (lane & 31)]; }
    asm volatile("s_waitcnt vmcnt(0) lgkmcnt(0)" ::: "memory");
    const int c = lane & 7;
#pragma unroll
    for (int j = 0; j < 4; ++j) { const int n = (lane >> 3) + 8 * j; const float* s = scr + (8 * c) * 33 + n;
        u32x4 o; o.x = pk2(s[0 * 33], s[1 * 33]); o.y = pk2(s[2 * 33], s[3 * 33]); o.z = pk2(s[4 * 33], s[5 * 33]); o.w = pk2(s[6 * 33], s[7 * 33]);
        *(u32x4*)(WT + (size_t)(drow0 + n) * K + k0 + 8 * c) = o; }
    asm volatile("s_waitcnt lgkmcnt(0)" ::: "memory");
}
__device__ __forceinline__ int gu_row(int n, int up) { return (n >> 7) * 256 + (n & 127) + (up ? 128 : 0); }
__device__ __forceinline__ void ph_wconv(const Params& p, float* sm, int bid, int nb) {
    const int lane = threadIdx.x & 63, wave = threadIdx.x >> 6;
    float* scr = sm + wave * (64 * 33);
    const int gw = bid * 8 + wave, NGW = nb * 8;
    constexpr int I_IN = 16 * 80, I_OUT = 16 * 32, I_GU = 16 * 88, I_DN = 44 * 32;
    constexpr int PER_FFN = 3 * I_GU;
    static_assert(I_DN == I_GU, "");
    constexpr int NITEMS = 2 * I_IN + 2 * I_OUT + 9 * PER_FFN;
    for (int it = gw; it < NITEMS; it += NGW) {
        int r = it;
        if (r < 2 * I_IN) { const int l = r / I_IN; r %= I_IN; const int kb = r / 80, nb2 = r % 80;
            transpose_item(p.in[8] + (size_t)l * D * INC, D, INC, (bf16*)(p.ws + WS_WIN) + (size_t)l * INC * D, nb2 * 32, kb * 64, nb2 * 32, scr, lane); continue; }
        r -= 2 * I_IN;
        if (r < 2 * I_OUT) { const int l = r / I_OUT; r %= I_OUT; const int kb = r / 32, nb2 = r % 32;
            transpose_item(p.in[9] + (size_t)l * D * D, D, D, (bf16*)(p.ws + WS_WOUT) + (size_t)l * D * D, nb2 * 32, kb * 64, nb2 * 32, scr, lane); continue; }
        r -= 2 * I_OUT;
        const int f = r / PER_FFN; r %= PER_FFN;
        const int which = r / I_GU; r %= I_GU;
        const float* src; bf16* dgu; bf16* ddn;
        if (f == 0) { src = p.in[23 + which]; dgu = (bf16*)(p.ws + WS_WGU); ddn = (bf16*)(p.ws + WS_WDN); }
        else { src = p.in[28 + which] + (size_t)(f - 1) * D * FF; dgu = (bf16*)(p.ws + WS_MOEW) + (size_t)(f - 1) * MOEW_E; ddn = dgu + (size_t)5632 * 1024; }
        if (which < 2) { const int kb = r / 88, nb2 = r % 88; transpose_item(src, D, FF, dgu, gu_row(nb2 * 32, which), kb * 64, nb2 * 32, scr, lane); }
        else { const int kb = r / 32, nb2 = r % 32; transpose_item(src, FF, D, ddn, nb2 * 32, kb * 64, nb2 * 32, scr, lane); }
    }
}
__device__ __forceinline__ void ph_filt(const Params& p, float* sm, int bid, int nb) {
    const float dlo = -4.605170185988091f / 1.5f, dhi = -4.605170185988091f / 0.3f;
    float* col = sm + threadIdx.x;
    for (int it = bid; it < 260; it += nb) {
        int which, chunk, q;
        if (it < 256) { which = it >> 7; chunk = (it & 127) >> 2; q = it & 3; } else { which = 2; chunk = 0; q = it - 256; }
        const int l = (which == 2) ? 0 : which; const int Lf = (which == 2) ? CTXL : SEQ; const int NN = 2 * Lf;
        const int n = chunk * NT + threadIdx.x;
        if (n >= Lf) continue;
        float* taps = (which == 2) ? (float*)(p.ws + WS_TAPSC) : (float*)(p.ws + WS_HSPEC) + (size_t)which * 256 * FN;
        const float* w1 = p.in[12] + l * 33 * 64; const float* b1 = p.in[13] + l * 64; const float* w2 = p.in[14] + l * 4096; const float* b2 = p.in[15] + l * 64;
        const float* w3 = p.in[16] + l * 64 * 512; const float* b3 = p.in[17] + l * 512; const float* fr = p.in[18] + l * 64;
        const float t = (float)n / (float)(Lf - 1);
        float feat[33]; feat[0] = t;
#pragma unroll
        for (int b = 0; b < 16; ++b) { const float band = 1e-4f + (float)b * ((15.f - 1e-4f) / 15.f);
            const float rev2 = (2.0f / (float)Lf) * (float)n * band; feat[1 + b] = cospif(rev2); feat[17 + b] = -sinpif(rev2); }
#pragma unroll 1
        for (int j = 0; j < 64; ++j) { float a = b1[j];
#pragma unroll
            for (int i = 0; i < 33; ++i) a += feat[i] * w1[i * 64 + j];
            col[j * NT] = sinpif(fr[j] * a * 0.3183098861837907f); }
        float acc[64];
#pragma unroll
        for (int j = 0; j < 64; ++j) acc[j] = b2[j];
#pragma unroll 1
        for (int i = 0; i < 64; ++i) { const float x = col[i * NT];
#pragma unroll
            for (int j = 0; j < 64; ++j) acc[j] += x * w2[i * 64 + j]; }
#pragma unroll
        for (int j = 0; j < 64; ++j) col[j * NT] = acc[j];
#pragma unroll 1
        for (int j = 0; j < 64; ++j) col[j * NT] = sinpif(fr[j] * col[j * NT] * 0.3183098861837907f);
#pragma unroll
        for (int j = 0; j < 64; ++j) acc[j] = col[j * NT];
#pragma unroll 1
        for (int j = q * 128; j < q * 128 + 128; ++j) { float a = b3[j];
#pragma unroll
            for (int i = 0; i < 64; ++i) a += acc[i] * w3[i * 512 + j];
            const int dir = j >> 8, ch = j & 255;
            const float delta = fabsf(dlo + (float)ch * ((dhi - dlo) / 255.f));
            a *= __expf(-t * delta);
            if (dir == 0) taps[(size_t)ch * NN + n] = a;
            else { if (n >= 1) taps[(size_t)ch * NN + NN - n] = a; else taps[(size_t)ch * NN + Lf] = 0.f; } }
    }
}

__device__ __forceinline__ int brev14(int k) { return (int)(__brev((unsigned)k) >> 18); }
__device__ __forceinline__ void fft_dif(f32x2* buf, const f32x2* TW) {
    for (int half = FM / 2; half >= 1; half >>= 1) {
        const int tws = (FM / 2) / half;
        for (int j = threadIdx.x; j < FM / 2; j += NT) { const int pos = j & (half - 1), i0 = ((j - pos) << 1) + pos, i1 = i0 + half;
            const f32x2 u = buf[i0], v = buf[i1], w = TW[pos * tws]; const f32x2 d = u - v;
            buf[i0] = u + v; buf[i1] = (f32x2){d.x * w.x - d.y * w.y, d.x * w.y + d.y * w.x}; }
        __syncthreads();
    }
}
__device__ __forceinline__ void fft_dit_inv(f32x2* buf, const f32x2* TW) {
    for (int half = 1; half <= FM / 2; half <<= 1) {
        const int tws = (FM / 2) / half;
        for (int j = threadIdx.x; j < FM / 2; j += NT) { const int pos = j & (half - 1), i0 = ((j - pos) << 1) + pos, i1 = i0 + half;
            const f32x2 u = buf[i0], b = buf[i1], w = TW[pos * tws];
            const f32x2 v = (f32x2){b.x * w.x + b.y * w.y, b.y * w.x - b.x * w.y};
            buf[i0] = u + v; buf[i1] = u - v; }
        __syncthreads();
    }
}
__device__ __forceinline__ void ph_hfft(const Params& p, float* sm, int bid, int nb) {
    f32x2* buf = (f32x2*)sm; float* red = sm + 2 * FM;
    const f32x2* TW = (const f32x2*)(p.ws + WS_TW); const f32x2* TWN = (const f32x2*)(p.ws + WS_TWN);
    const int tid = threadIdx.x;
    for (int u = bid; u < 512; u += nb) {
        f32x2* g = (f32x2*)((float*)(p.ws + WS_HSPEC) + (size_t)u * FN);
        float asum = 0.f;
        for (int n = tid; n < FM; n += NT) { const f32x2 v = g[n]; buf[n] = v; asum += fabsf(v.x) + fabsf(v.y); }
        asum = wave_sum(asum);
        if ((tid & 63) == 0) red[tid >> 6] = asum;
        __syncthreads();
        float tot = 0.f;
#pragma unroll
        for (int w = 0; w < 8; ++w) tot += red[w];
        const float sc = 0.5f / (tot + EPS);
        fft_dif(buf, TW);
        for (int k = tid; k <= FM / 2; k += NT) {
            if (k == 0) { const f32x2 a = buf[0]; g[0] = (f32x2){(a.x + a.y) * 2.f * sc, (a.x - a.y) * 2.f * sc}; continue; }
            const int kk = FM - k; const f32x2 a = buf[brev14(k)], b = buf[brev14(kk)], w = TWN[k];
            const f32x2 E = (f32x2){a.x + b.x, a.y - b.y}, O = (f32x2){a.y + b.y, b.x - a.x};
            const f32x2 T = (f32x2){w.x * O.x - w.y * O.y, w.x * O.y + w.y * O.x};
            g[k] = (f32x2){(E.x + T.x) * sc, (E.y + T.y) * sc};
            g[kk] = (f32x2){(E.x - T.x) * sc, -(E.y - T.y) * sc};
        }
        __syncthreads();
    }
}
__device__ __forceinline__ void hconv_unit(const Params& p, int l, int ch, float* sm) {
    f32x2* buf = (f32x2*)sm;
    const f32x2* TW = (const f32x2*)(p.ws + WS_TW); const f32x2* TWN = (const f32x2*)(p.ws + WS_TWN);
    const f32x2* H = (const f32x2*)((const float*)(p.ws + WS_HSPEC) + (size_t)(l * 256 + ch) * FN);
    f32x2* z = (f32x2*)((float*)(p.ws + WS_ZT) + (size_t)ch * SEQ);
    const int tid = threadIdx.x;
    for (int n = tid; n < FM; n += NT) buf[n] = (n < SEQ / 2) ? z[n] : (f32x2){0.f, 0.f};
    __syncthreads();
    fft_dif(buf, TW);
    for (int k = tid; k <= FM / 2; k += NT) {
        if (k == 0) { const f32x2 a = buf[0], h = H[0]; const float y0 = (a.x + a.y) * h.x, ym = (a.x - a.y) * h.y; buf[0] = (f32x2){0.5f * (y0 + ym), 0.5f * (y0 - ym)}; continue; }
        const int kk = FM - k, rk = brev14(k), rkk = brev14(kk);
        const f32x2 a = buf[rk], b = buf[rkk], w = TWN[k], hk = H[k], hkk = H[kk];
        const f32x2 E = (f32x2){0.5f * (a.x + b.x), 0.5f * (a.y - b.y)}, O = (f32x2){0.5f * (a.y + b.y), 0.5f * (b.x - a.x)};
        const f32x2 T = (f32x2){w.x * O.x - w.y * O.y, w.x * O.y + w.y * O.x};
        const f32x2 Xk = E + T, Xkk = (f32x2){E.x - T.x, -(E.y - T.y)};
        const f32x2 Yk = (f32x2){Xk.x * hk.x - Xk.y * hk.y, Xk.x * hk.y + Xk.y * hk.x};
        const f32x2 Ykk = (f32x2){Xkk.x * hkk.x - Xkk.y * hkk.y, Xkk.x * hkk.y + Xkk.y * hkk.x};
        const f32x2 Ey = (f32x2){0.5f * (Yk.x + Ykk.x), 0.5f * (Yk.y - Ykk.y)};
        const f32x2 Dy = (f32x2){0.5f * (Yk.x - Ykk.x), 0.5f * (Yk.y + Ykk.y)};
        const f32x2 Oy = (f32x2){w.x * Dy.x + w.y * Dy.y, w.x * Dy.y - w.y * Dy.x};
        buf[rk] = (f32x2){Ey.x - Oy.y, Ey.y + Oy.x};
        if (kk != k) buf[rkk] = (f32x2){Ey.x + Oy.y, -(Ey.y - Oy.x)};
    }
    __syncthreads();
    fft_dit_inv(buf, TW);
    const float inv = 1.f / (float)FM;
    for (int n = tid; n < SEQ / 2; n += NT) { const f32x2 v = buf[n]; z[n] = (f32x2){v.x * inv, v.y * inv}; }
    __syncthreads();
}
__device__ __forceinline__ void hconv_ctx_unit(const Params& p, int ch, float* sm) {
    float* zc = (float*)(p.ws + WS_ZC) + ch * CTXL; const float* tc = (const float*)(p.ws + WS_TAPSC) + ch * 512;
    float* zs = sm; float* ts = sm + 256; float* red = sm + 768;
    const int tid = threadIdx.x;
    if (tid < 256) zs[tid] = zc[tid];
    const float tv = tc[tid]; ts[tid] = tv;
    const float a = wave_sum(fabsf(tv)); if ((tid & 63) == 0) red[tid >> 6] = a;
    __syncthreads();
    if (tid < 256) { float tot = 0.f;
#pragma unroll
        for (int w = 0; w < 8; ++w) tot += red[w];
        float acc = 0.f;
        for (int m = 0; m < 256; ++m) { const int lag = tid - m; acc += zs[m] * ts[lag >= 0 ? lag : 512 + lag]; }
        zc[tid] = acc / (tot + EPS); }
    __syncthreads();
}

__device__ __forceinline__ void ph_norm(const Params& p, int l, int which, bool first, int nrows, bool route, int bid, int nb) {
    const int lane = threadIdx.x & 63, wave = threadIdx.x >> 6;
    const float* g = p.in[which ? 7 : 6] + l * D;
    bf16* H = (bf16*)(p.ws + WS_H);
    for (int row = bid * 8 + wave; row < nrows; row += nb * 8) {
        const f32x4* xr = (const f32x4*)xsrc_row(p, first, row) + lane;
        const f32x4* sh = (const f32x4*)mod_vec(p, l, row, which ? 3 : 0) + lane; const f32x4* scv = (const f32x4*)mod_vec(p, l, row, which ? 4 : 1) + lane;
        f32x4 v[4]; float ss = 0.f;
#pragma unroll
        for (int j = 0; j < 4; ++j) { v[j] = xr[64 * j]; ss += (v[j].x * v[j].x + v[j].y * v[j].y) + (v[j].z * v[j].z + v[j].w * v[j].w); }
        const float r = rsqrtf(wave_sum(ss) * (1.f / D) + EPS);
        u32x2* o8 = (u32x2*)(H + (size_t)row * D) + lane;
#pragma unroll
        for (int j = 0; j < 4; ++j) { const f32x4 gg = ((const f32x4*)g)[lane + 64 * j], s1 = scv[64 * j], s0 = sh[64 * j];
            v[j] = v[j] * r * gg * (s1 + 1.f) + s0;
            o8[64 * j] = (u32x2){pk2(v[j].x, v[j].y), pk2(v[j].z, v[j].w)}; }
        if (route) {
            const float* rw = p.in[26]; const float* rb = p.in[27];
            float lg[8];
#pragma unroll
            for (int e = 0; e < 8; ++e) lg[e] = 0.f;
#pragma unroll
            for (int j = 0; j < 4; ++j)
#pragma unroll
                for (int i = 0; i < 4; ++i) { const int d = 4 * lane + 256 * j + i; const float hv = v[j][i];
                    const f32x4 w0 = *(const f32x4*)(rw + d * 8), w1 = *(const f32x4*)(rw + d * 8 + 4);
                    lg[0] += hv * w0.x; lg[1] += hv * w0.y; lg[2] += hv * w0.z; lg[3] += hv * w0.w; lg[4] += hv * w1.x; lg[5] += hv * w1.y; lg[6] += hv * w1.z; lg[7] += hv * w1.w; }
#pragma unroll
            for (int e = 0; e < 8; ++e) lg[e] = wave_sum(lg[e]) + rb[e];
            int i1 = 0; float v1 = lg[0];
#pragma unroll
            for (int e = 1; e < 8; ++e) if (lg[e] > v1) { v1 = lg[e]; i1 = e; }
            int i2 = -1; float v2 = -3.0e38f;
#pragma unroll
            for (int e = 0; e < 8; ++e) if (e != i1 && lg[e] > v2) { v2 = lg[e]; i2 = e; }
            const float ex = __expf(v2 - v1), g1 = 1.f / (1.f + ex), g2 = ex * g1;
            if (lane == 0) {
                unsigned* cnt = (unsigned*)(p.ws + WS_CTL) + CW_CNT;
                int* at = (int*)(p.ws + WS_ASGT); float* ag = (float*)(p.ws + WS_ASGG);
                const unsigned p1 = atomicAdd(&cnt[i1], 1u); at[i1 * SEQ + p1] = row * 2; ag[i1 * SEQ + p1] = g1;
                const unsigned p2 = atomicAdd(&cnt[i2], 1u); at[i2 * SEQ + p2] = row * 2 + 1; ag[i2 * SEQ + p2] = g2;
            }
        }
    }
}

namespace pg8 {
#define PG8_LAS __attribute__((address_space(3)))
typedef unsigned short bf16_t;
typedef short bf16x8 __attribute__((ext_vector_type(8)));
typedef float f32x4 __attribute__((ext_vector_type(4)));
typedef unsigned u32x4 __attribute__((ext_vector_type(4)));
constexpr int BM = 256, BK = 64, HALF = 128, HTB = HALF * BK * 2  , STAGE_BYTES = 8 * HTB, NXCD = 8, WGM = 8;

__host__ __device__ __forceinline__ int lds_byte(int r, int c) { const int st = (r >> 4) * 2 + (c >> 5), rr = r & 15, cc = c & 31, ob = rr * 64 + cc * 2; return st * 1024 + (ob ^ (((ob >> 9) & 1) << 5)); }
__host__ __device__ __forceinline__ void stage_rc(int b, int& R, int& C) { const int st = b / 1024, sb = b % 1024, swz = sb ^ (((sb >> 9) & 1) << 5); R = (st >> 1) * 16 + swz / 64; C = (st & 1) * 32 + (swz % 64) / 2; }
__host__ __device__ __forceinline__ int perm32(int rho) { const int n = rho >> 4, i = rho & 15; return 8 * (i >> 2) + 4 * n + (i & 3); }

struct Unit { int pm, pn; };
struct Gemm { const bf16_t* A; const bf16_t* Bt; int M, N, K; };

struct StaticOrder {
    int nM, nN, nwg, G, c; const int* tile_e = nullptr; size_t estride = 0;
    __host__ __device__ void init(int M, int N, int G_, int c_) { nM = M / BM; nN = N / BM; nwg = nM * nN; G = G_; c = c_; }
    __host__ __device__ bool next(int i, Unit& u) const {
        const long L = (long)i * G + c; if (L >= nwg) return false;
        int wgid = (int)L; { const int q = nwg / NXCD, r = nwg % NXCD, xcd = wgid % NXCD, off = wgid / NXCD; wgid = (xcd < r ? xcd * (q + 1) : r * (q + 1) + (xcd - r) * q) + off; }
        const int nig = WGM * nN, gid = wgid / nig, fm = gid * WGM, gsz = (nM - fm) < WGM ? (nM - fm) : WGM;
        u.pm = fm + ((wgid % nig) % gsz); u.pn = (wgid % nig) / gsz; return true;
    }
    __device__ __forceinline__ size_t b_extra(const Unit& u) const { return tile_e ? (size_t)tile_e[2 * u.pm] * estride : (size_t)0; }
    __device__ __forceinline__ void a_ready(const Unit&) const {}
    __device__ __forceinline__ void done(const Unit&) const {}
};

__device__ __forceinline__ unsigned cvt_pk_bf16(float lo, float hi) { unsigned r; asm volatile("v_cvt_pk_bf16_f32 %0, %1, %2" : "=v"(r) : "v"(lo), "v"(hi)); return r; }
template <class Epi, class Sched, bool ALIGN_EPI = false, bool SP2 = false>
__device__ __forceinline__ void gemm_phase(PG8_LAS unsigned char* lds, const Gemm g, const Sched& S, const Epi& E) {
    const int tid = threadIdx.x, wid = __builtin_amdgcn_readfirstlane(tid >> 6), lane = tid & 63, wr = wid >> 2, wc = wid & 3, fr = lane & 15, fq = lane >> 4;
    const int K = g.K, nt = K / BK;
    unsigned voffA[2], voffB[2];
#pragma unroll
    for (int i = 0; i < 2; ++i) { int R, C; stage_rc(tid * 16 + i * 8192, R, C); const int Rb = Epi::PERM ? ((R & ~31) + perm32(R & 31)) : R;
        voffA[i] = (unsigned)(R * K + C) * 2u; voffB[i] = (unsigned)(Rb * K + C) * 2u; }
    const size_t kstep = (size_t)(BK * 2);
    const size_t hstep = (size_t)HALF * K * 2;
    const size_t tstep = 2 * hstep;
    const unsigned ldsw = (unsigned)wid * 1024u;
    const int aoff = lds_byte(wr * 64 + fr, fq * 8), boff = lds_byte(wc * 32 + fr, fq * 8);
#define PG8_SA(b, h) (((b) * 2 + (h)) * HTB)
#define PG8_SB(b, h) ((4 + (b) * 2 + (h)) * HTB)
#define PG8_STAGE(bufoff, gbase, voff) do { _Pragma("unroll") for (int _i = 0; _i < 2; ++_i) \
        __builtin_amdgcn_global_load_lds((const unsigned*)((const char*)(gbase) + (voff)[_i]), (PG8_LAS unsigned*)(lds + (bufoff) + ldsw + _i * 8192), 16, 0, 0); } while (0)
#define PG8_LDA(dst, b, h) do { _Pragma("unroll") for (int m = 0; m < 4; ++m) _Pragma("unroll") for (int k = 0; k < 2; ++k) dst[m][k] = *(const PG8_LAS bf16x8*)(lds + PG8_SA(b, h) + aoff + m * 2048 + k * 1024); } while (0)
#define PG8_LDB(dst, b, h) do { _Pragma("unroll") for (int n = 0; n < 2; ++n) _Pragma("unroll") for (int k = 0; k < 2; ++k) dst[n][k] = *(const PG8_LAS bf16x8*)(lds + PG8_SB(b, h) + boff + n * 2048 + k * 1024); } while (0)
#define PG8_MMA(ai, bj, At, Bt) do { __builtin_amdgcn_s_setprio(1); _Pragma("unroll") for (int m = 0; m < 4; ++m) _Pragma("unroll") for (int n = 0; n < 2; ++n) _Pragma("unroll") for (int k = 0; k < 2; ++k) \
        acc[ai][bj][m][n] = __builtin_amdgcn_mfma_f32_16x16x32_bf16(Bt[n][k], At[m][k], acc[ai][bj][m][n], 0, 0, 0); __builtin_amdgcn_s_setprio(0); } while (0)
#define PG8_WAIT_V(n) asm volatile("s_waitcnt vmcnt(" #n ")" ::: "memory")
#define PG8_WAIT_L(n) asm volatile("s_waitcnt lgkmcnt(" #n ")" ::: "memory")
#define PG8_BAR __builtin_amdgcn_s_barrier()
#define PG8_SCHED __builtin_amdgcn_sched_barrier(0)
    Unit cur, nxt; int ui = 0;
    if (!S.next(0, cur)) return;
    f32x4 acc[2][2][4][2];
#pragma unroll
    for (int a = 0; a < 2; ++a)
#pragma unroll
        for (int b = 0; b < 2; ++b)
#pragma unroll
            for (int m = 0; m < 4; ++m)
#pragma unroll
                for (int n = 0; n < 2; ++n) acc[a][b][m][n] = (f32x4){0.f, 0.f, 0.f, 0.f};
    bf16x8 At[4][2], B0[2][2], B1[2][2];
    const char* cA = (const char*)g.A + (size_t)cur.pm * tstep; const char* cB = (const char*)g.Bt + (size_t)cur.pn * tstep + S.b_extra(cur);
    S.a_ready(cur);
    if constexpr (SP2) {
        PG8_STAGE(PG8_SB(0, 0), cB, voffB); PG8_STAGE(PG8_SB(0, 1), cB + hstep, voffB); PG8_STAGE(PG8_SA(0, 0), cA, voffA); PG8_STAGE(PG8_SA(0, 1), cA + hstep, voffA);
        if (wr == 1) PG8_BAR;
        PG8_WAIT_V(2); PG8_BAR;
        PG8_STAGE(PG8_SB(1, 0), cB + kstep, voffB); PG8_STAGE(PG8_SA(1, 0), cA + kstep, voffA); PG8_STAGE(PG8_SB(1, 1), cB + hstep + kstep, voffB);
        PG8_WAIT_V(6); PG8_BAR;
    } else {
        PG8_STAGE(PG8_SB(0, 0), cB, voffB); PG8_STAGE(PG8_SA(0, 0), cA, voffA); PG8_STAGE(PG8_SB(0, 1), cB + hstep, voffB); PG8_STAGE(PG8_SA(0, 1), cA + hstep, voffA);
        if (wr == 1) PG8_BAR;
        PG8_WAIT_V(4); PG8_BAR;
        PG8_STAGE(PG8_SB(1, 0), cB + kstep, voffB); PG8_STAGE(PG8_SA(1, 0), cA + kstep, voffA); PG8_STAGE(PG8_SB(1, 1), cB + hstep + kstep, voffB);
        PG8_WAIT_V(6); PG8_BAR;
    }
    for (;;) {
        const bool has_next = S.next(ui + 1, nxt);
        const char* nA = has_next ? (const char*)g.A + (size_t)nxt.pm * tstep : cA; const char* nB = has_next ? (const char*)g.Bt + (size_t)nxt.pn * tstep + S.b_extra(nxt) : cB;
        for (int t = 0; t < nt; t += 2) {
            const bool last = (t == nt - 2);
            const char* a1 = cA + (size_t)(t + 1) * kstep;
            const char* a2 = last ? nA : cA + (size_t)(t + 2) * kstep; const char* b2 = last ? nB : cB + (size_t)(t + 2) * kstep;
            const char* a3 = a2 + kstep; const char* b3 = b2 + kstep;
            if (last && has_next) S.a_ready(nxt);
            if constexpr (SP2) {
            PG8_LDB(B0, 0, 0); PG8_LDB(B1, 0, 1); PG8_SCHED; PG8_LDA(At, 0, 0); PG8_STAGE(PG8_SA(1, 1), a1 + hstep, voffA);
            PG8_WAIT_V(8); PG8_WAIT_L(0); PG8_BAR; PG8_MMA(0, 0, At, B0); PG8_MMA(0, 1, At, B1); PG8_BAR; PG8_SCHED;
            PG8_LDA(At, 0, 1); PG8_STAGE(PG8_SB(0, 0), b2, voffB); PG8_STAGE(PG8_SB(0, 1), b2 + hstep, voffB); PG8_STAGE(PG8_SA(0, 0), a2, voffA);
            PG8_WAIT_V(8); PG8_WAIT_L(0); PG8_BAR; PG8_MMA(1, 0, At, B0); PG8_MMA(1, 1, At, B1); PG8_BAR; PG8_SCHED;
            PG8_LDB(B0, 1, 0); PG8_LDB(B1, 1, 1); PG8_SCHED; PG8_LDA(At, 1, 0); PG8_STAGE(PG8_SA(0, 1), a2 + hstep, voffA);
            PG8_WAIT_V(8); PG8_WAIT_L(0); PG8_BAR; PG8_MMA(0, 0, At, B0); PG8_MMA(0, 1, At, B1); PG8_BAR; PG8_SCHED;
            PG8_LDA(At, 1, 1); PG8_STAGE(PG8_SB(1, 0), b3, voffB); PG8_STAGE(PG8_SB(1, 1), b3 + hstep, voffB); PG8_STAGE(PG8_SA(1, 0), a3, voffA);
            PG8_WAIT_V(8); PG8_WAIT_L(0); PG8_BAR; PG8_MMA(1, 0, At, B0); PG8_MMA(1, 1, At, B1); PG8_BAR; PG8_SCHED;
            } else {
            PG8_LDB(B0, 0, 0); PG8_SCHED; PG8_LDA(At, 0, 0); PG8_STAGE(PG8_SA(1, 1), a1 + hstep, voffA);
            PG8_WAIT_L(8); PG8_BAR; PG8_WAIT_L(0); PG8_MMA(0, 0, At, B0); PG8_BAR; PG8_SCHED;
            PG8_LDB(B1, 0, 1); PG8_STAGE(PG8_SB(0, 0), b2, voffB);
            PG8_BAR; PG8_WAIT_L(0); PG8_MMA(0, 1, At, B1); PG8_BAR;
            PG8_LDA(At, 0, 1); PG8_STAGE(PG8_SA(0, 0), a2, voffA);
            PG8_BAR; PG8_WAIT_L(0); PG8_MMA(1, 0, At, B0); PG8_BAR; PG8_SCHED;
            PG8_STAGE(PG8_SB(0, 1), b2 + hstep, voffB);
            PG8_WAIT_V(6); PG8_BAR; PG8_MMA(1, 1, At, B1); PG8_BAR;
            PG8_LDB(B0, 1, 0); PG8_SCHED; PG8_LDA(At, 1, 0); PG8_STAGE(PG8_SA(0, 1), a2 + hstep, voffA);
            PG8_WAIT_L(8); PG8_BAR; PG8_WAIT_L(0); PG8_MMA(0, 0, At, B0); PG8_BAR; PG8_SCHED;
            PG8_LDB(B1, 1, 1); PG8_STAGE(PG8_SB(1, 0), b3, voffB);
            PG8_BAR; PG8_WAIT_L(0); PG8_MMA(0, 1, At, B1); PG8_BAR;
            PG8_LDA(At, 1, 1); PG8_STAGE(PG8_SA(1, 0), a3, voffA);
            PG8_BAR; PG8_WAIT_L(0); PG8_MMA(1, 0, At, B0); PG8_BAR; PG8_SCHED;
            PG8_STAGE(PG8_SB(1, 1), b3 + hstep, voffB);
            PG8_WAIT_V(6); PG8_BAR; PG8_MMA(1, 1, At, B1); PG8_BAR;
            }
        }
        if constexpr (ALIGN_EPI) { if (wr == 0) PG8_BAR; }
        if constexpr (!Epi::AFTER_DRAIN) { E(acc, cur, wr, wc, fr, fq); S.done(cur); }
        if (!has_next) break;
#pragma unroll
        for (int a = 0; a < 2; ++a)
#pragma unroll
            for (int b = 0; b < 2; ++b)
#pragma unroll
                for (int m = 0; m < 4; ++m)
#pragma unroll
                    for (int n = 0; n < 2; ++n) acc[a][b][m][n] = (f32x4){0.f, 0.f, 0.f, 0.f};
        cur = nxt; cA = nA; cB = nB; ++ui;
        if constexpr (ALIGN_EPI) { if (wr == 1) PG8_BAR; }
    }
    PG8_WAIT_V(0);
    if constexpr (!ALIGN_EPI) { if (wr == 0) PG8_BAR; }
    PG8_BAR;
    if constexpr (Epi::AFTER_DRAIN) { E.fused(acc, cur, wr, wc, fr, fq, lds, wid, lane); S.done(cur); }
#undef PG8_SA
#undef PG8_SB
#undef PG8_STAGE
#undef PG8_LDA
#undef PG8_LDB
#undef PG8_MMA
#undef PG8_WAIT_V
#undef PG8_WAIT_L
#undef PG8_BAR
#undef PG8_SCHED
}
}
struct PgEpiP {
    static constexpr bool PERM = true, AFTER_DRAIN = false; bf16* O; int ldc;
    __device__ __forceinline__ void operator()(const pg8::f32x4 (&acc)[2][2][4][2], const pg8::Unit& u, int wr, int wc, int fr, int fq) const {
        const int row0 = u.pm * 256 + wr * 64 + fr, col0 = u.pn * 256 + wc * 32 + 8 * fq;
#pragma unroll
        for (int ai = 0; ai < 2; ++ai)
#pragma unroll
            for (int m = 0; m < 4; ++m) { bf16* rowp = O + (size_t)(row0 + ai * 128 + m * 16) * ldc + col0;
#pragma unroll
                for (int bj = 0; bj < 2; ++bj) { const f32x4 v0 = acc[ai][bj][m][0], v1 = acc[ai][bj][m][1];
                    *(u32x4*)(rowp + bj * 128) = (u32x4){pg8::cvt_pk_bf16(v0[0], v0[1]), pg8::cvt_pk_bf16(v0[2], v0[3]), pg8::cvt_pk_bf16(v1[0], v1[1]), pg8::cvt_pk_bf16(v1[2], v1[3])}; } }
    }
};
struct PgEpiRes {
    static constexpr bool PERM = true, AFTER_DRAIN = false; const Params* p; int l, gj; bool first;
    __device__ __forceinline__ void operator()(const pg8::f32x4 (&acc)[2][2][4][2], const pg8::Unit& u, int wr, int wc, int fr, int fq) const {
        const int row0 = u.pm * 256 + wr * 64 + fr, col0 = u.pn * 256 + wc * 32 + 8 * fq;
#pragma unroll
        for (int ai = 0; ai < 2; ++ai)
#pragma unroll
            for (int m = 0; m < 4; ++m) { const int row = row0 + ai * 128 + m * 16;
                const float* src = xsrc_row(*p, first, row) + col0; float* dst = xdst_row(*p, row) + col0; const float* md = mod_vec(*p, l, row, gj) + col0;
#pragma unroll
                for (int bj = 0; bj < 2; ++bj)
#pragma unroll
                    for (int n = 0; n < 2; ++n) { const f32x4 sv = *(const f32x4*)(src + bj * 128 + 4 * n), mm = *(const f32x4*)(md + bj * 128 + 4 * n);
                        *(f32x4*)(dst + bj * 128 + 4 * n) = sv + mm * acc[ai][bj][m][n]; } }
    }
};
struct PgEpiSwi {
    static constexpr bool PERM = true, AFTER_DRAIN = false; bf16* Hd;
    __device__ __forceinline__ void operator()(const pg8::f32x4 (&acc)[2][2][4][2], const pg8::Unit& u, int wr, int wc, int fr, int fq) const {
        const int row0 = u.pm * 256 + wr * 64 + fr, col0 = u.pn * 128 + wc * 32 + 8 * fq;
#pragma unroll
        for (int ai = 0; ai < 2; ++ai)
#pragma unroll
            for (int m = 0; m < 4; ++m) { const f32x4 g0 = acc[ai][0][m][0], g1 = acc[ai][0][m][1], u0 = acc[ai][1][m][0], u1 = acc[ai][1][m][1];
                *(u32x4*)(Hd + (size_t)(row0 + ai * 128 + m * 16) * FF + col0) = (u32x4){pg8::cvt_pk_bf16(silu_f(g0[0]) * u0[0], silu_f(g0[1]) * u0[1]), pg8::cvt_pk_bf16(silu_f(g0[2]) * u0[2], silu_f(g0[3]) * u0[3]),
                    pg8::cvt_pk_bf16(silu_f(g1[0]) * u1[0], silu_f(g1[1]) * u1[1]), pg8::cvt_pk_bf16(silu_f(g1[2]) * u1[2], silu_f(g1[3]) * u1[3])}; }
    }
};
struct PgEpiMoeDown {
    static constexpr bool PERM = true, AFTER_DRAIN = false; bf16* Y2; const int* rowd; const float* rowg;
    __device__ __forceinline__ void operator()(const pg8::f32x4 (&acc)[2][2][4][2], const pg8::Unit& u, int wr, int wc, int fr, int fq) const {
        const int row0 = u.pm * 256 + wr * 64 + fr, col0 = u.pn * 256 + wc * 32 + 8 * fq;
#pragma unroll
        for (int ai = 0; ai < 2; ++ai)
#pragma unroll
            for (int m = 0; m < 4; ++m) { const int row = row0 + ai * 128 + m * 16; const int d = rowd[row]; if (d < 0) continue; const float g = rowg[row];
                bf16* rowp = Y2 + (size_t)d * D + col0;
#pragma unroll
                for (int bj = 0; bj < 2; ++bj) { const f32x4 v0 = acc[ai][bj][m][0] * g, v1 = acc[ai][bj][m][1] * g;
                    *(u32x4*)(rowp + bj * 128) = (u32x4){pg8::cvt_pk_bf16(v0[0], v0[1]), pg8::cvt_pk_bf16(v0[2], v0[3]), pg8::cvt_pk_bf16(v1[0], v1[1]), pg8::cvt_pk_bf16(v1[2], v1[3])}; } }
    }
};
template <class Epi>
__device__ __forceinline__ void run_gemm(unsigned char* lds, const bf16* A, const bf16* Bt, int M, int N, int K, const Epi& E, const int* tile_e, size_t estride, int bid, int nb) {
    pg8::Gemm g{A, Bt, M, N, K}; pg8::StaticOrder S; S.init(M, N, nb, bid); S.tile_e = tile_e; S.estride = estride;
    pg8::gemm_phase<Epi, pg8::StaticOrder, true, true>((__attribute__((address_space(3))) unsigned char*)lds, g, S, E);
}

__device__ __forceinline__ void prep_qk(const Params& p, int l, int nrows, int bid, int nb) {
    const int lane = threadIdx.x & 63, wave = threadIdx.x >> 6;
    bf16* P = (bf16*)(p.ws + WS_P);
    const float gq = p.in[21][l * 64 + lane], gk = p.in[22][l * 64 + lane];
    const int sec = lane >> 5, j = lane & 31, i = j & 15;
    const float invf = exp2f(-(float)i * (13.287712379549449f / 16.f));
    for (int row = bid * 8 + wave; row < nrows; row += nb * 8) {
        float cs = 1.f, sn = 0.f;
        if (row < SEQ) { const float pos = (float)(sec ? (row & 63) : (row >> 6)); const float x = pos * invf * 0.3183098861837907f; sn = sinpif(x); cs = cospif(x); }
        bf16* pr = P + (size_t)row * INC;
#pragma unroll
        for (int hv = 0; hv < 10; ++hv) {
            const int off = (hv < 8) ? C_AQ + hv * 64 : C_AK + (hv - 8) * 64;
            const float v = bf2f(pr[off + lane]);
            const float ss = wave_sum(v * v);
            float y = v * rsqrtf(ss * (1.f / 64.f) + EPS) * (hv < 8 ? gq : gk);
            const float o = __shfl_xor(y, 16);
            y = (j < 16) ? y * cs - o * sn : y * cs + o * sn;
            if (hv < 8) y *= C2;
            pr[off + lane] = (bf16)f2bf(y);
        }
    }
}
__device__ __forceinline__ float conv3(const bf16* P, const float* cw, const float* cb, int t, int lo, int hi, int col) {
    float a = cb[col] + cw[768 + col] * bf2f(P[(size_t)t * INC + col]);
    if (t - 1 >= lo) a += cw[col] * bf2f(P[(size_t)(t - 1) * INC + col]);
    if (t + 1 < hi) a += cw[1536 + col] * bf2f(P[(size_t)(t + 1) * INC + col]);
    return a;
}
__device__ __forceinline__ void prep_hyz(const Params& p, int l, bool with_ctx, float* sm, int bid, int nb) {
    const bf16* P = (const bf16*)(p.ws + WS_P);
    const float* cw = p.in[10] + l * 3 * 768; const float* cb = p.in[11] + l * 768;
    const int ntile = with_ctx ? 260 : 256, tid = threadIdx.x;
    for (int tile = bid; tile < ntile; tile += nb) {
        const int t0 = tile * 64; const int lo = tile < 256 ? 0 : SEQ, hi = tile < 256 ? SEQ : R;
        for (int e = tid; e < 64 * 256; e += NT) { const int tl = e >> 8, ch = e & 255;
            sm[ch * 65 + tl] = conv3(P, cw, cb, t0 + tl, lo, hi, C_HX1 + ch) * conv3(P, cw, cb, t0 + tl, lo, hi, C_HV + ch); }
        __syncthreads();
        for (int e = tid; e < 64 * 256; e += NT) { const int ch = e >> 6, tl = e & 63;
            if (tile < 256) ((float*)(p.ws + WS_ZT))[(size_t)ch * SEQ + t0 + tl] = sm[ch * 65 + tl];
            else ((float*)(p.ws + WS_ZC))[ch * CTXL + (t0 - SEQ) + tl] = sm[ch * 65 + tl]; }
        __syncthreads();
    }
}
__device__ __forceinline__ void prep_retu(const Params& p, int l, float* sm, int bid, int nb) {
    const bf16* P = (const bf16*)(p.ws + WS_P);
    float* Ks = sm; float* Vs = sm + 8192; float* wf = sm + 16384; float* wb = wf + 128;
    const int tid = threadIdx.x;
    for (int it = bid; it < NCH * 4; it += nb) {
        const int c = it >> 2, h = it & 3; const int r0 = c * 128;
        const float lgf = -__expf(p.in[20][l * 8 + h]), lgb = -__expf(p.in[20][l * 8 + 4 + h]);
        if (tid < 128) { wf[tid] = __expf(lgf * (float)(127 - tid)); wb[tid] = __expf(lgb * (float)tid); }
        for (int e = tid; e < 128 * 64; e += NT) { const int m = e >> 6, d = e & 63; const bf16* pr = P + (size_t)(r0 + m) * INC + h * 64 + d;
            Ks[e] = bf2f(pr[C_RK]) * 0.125f; Vs[e] = bf2f(pr[C_RV]); }
        __syncthreads();
        const int d = tid >> 3, e0 = (tid & 7) * 8;
        float af[8], ab[8];
#pragma unroll
        for (int j = 0; j < 8; ++j) { af[j] = 0.f; ab[j] = 0.f; }
        for (int m = 0; m < 128; ++m) { const float kd = Ks[m * 64 + d], kf = kd * wf[m], kb = kd * wb[m];
            const f32x4 v0 = *(const f32x4*)&Vs[m * 64 + e0], v1 = *(const f32x4*)&Vs[m * 64 + e0 + 4];
#pragma unroll
            for (int j = 0; j < 4; ++j) { af[j] += kf * v0[j]; ab[j] += kb * v0[j]; af[4 + j] += kf * v1[j]; ab[4 + j] += kb * v1[j]; } }
        float* U = (float*)(p.ws + WS_RU);
        float* uf = U + ((size_t)(0 * 4 + h) * NCH + c) * 4096 + d * 64 + e0; float* ub = U + ((size_t)(1 * 4 + h) * NCH + c) * 4096 + d * 64 + e0;
        *(f32x4*)uf = (f32x4){af[0], af[1], af[2], af[3]}; *(f32x4*)(uf + 4) = (f32x4){af[4], af[5], af[6], af[7]};
        *(f32x4*)ub = (f32x4){ab[0], ab[1], ab[2], ab[3]}; *(f32x4*)(ub + 4) = (f32x4){ab[4], ab[5], ab[6], ab[7]};
        __syncthreads();
    }
}
__device__ __forceinline__ void ph_retscan(const Params& p, int l, int bid, int nb) {
    float* U = (float*)(p.ws + WS_RU);
    for (int g = bid * NT + threadIdx.x; g < 8 * 4096; g += nb * NT) {
        const int dir = g >> 14, h = (g >> 12) & 3, e = g & 4095;
        const float lg = -__expf(p.in[20][l * 8 + dir * 4 + h]); const float Dc = __expf(lg * 128.f);
        float* u = U + (size_t)(dir * 4 + h) * NCH * 4096 + e;
        const float uc0 = u[(size_t)128 * 4096], uc1 = u[(size_t)129 * 4096];
        if (dir == 0) {
            float s = Dc * uc0 + uc1; u[(size_t)128 * 4096] = 0.f; u[(size_t)129 * 4096] = uc0;
            for (int c = 0; c < 128; ++c) { const float t = u[(size_t)c * 4096]; u[(size_t)c * 4096] = s; s = Dc * s + t; }
        } else {
            float s = uc0 + Dc * uc1; u[(size_t)129 * 4096] = 0.f; u[(size_t)128 * 4096] = uc1;
            for (int c = 127; c >= 0; --c) { const float t = u[(size_t)c * 4096]; u[(size_t)c * 4096] = s; s = Dc * s + t; }
        }
    }
}

__device__ __forceinline__ void post_ret(const Params& p, int l, int nchunks, unsigned char* smb, int bid, int nb) {
    const bf16* P = (const bf16*)(p.ws + WS_P); bf16* Y = (bf16*)(p.ws + WS_YMIX);
    bf16* Qs = (bf16*)smb; bf16* Ks = Qs + 128 * 72; bf16* Vs = Ks + 128 * 72; float* S = (float*)(smb + 3 * 128 * 72 * 2); float* pf = S + 128 * 132; float* pb = pf + 128;
    const int tid = threadIdx.x;
    for (int it = bid; it < nchunks * 4; it += nb) {
        const int c = it >> 2, h = it & 3, r0 = c * 128;
        const float lgf = -__expf(p.in[20][l * 8 + h]), lgb = -__expf(p.in[20][l * 8 + 4 + h]);
        if (tid < 128) { pf[tid] = __expf(lgf * (float)tid); pb[tid] = __expf(lgb * (float)tid); }
        for (int e = tid; e < 128 * 8; e += NT) { const int m = e >> 3, dc = e & 7; const bf16* pr = P + (size_t)(r0 + m) * INC + h * 64 + dc * 8;
            *(u32x4*)(Qs + m * 72 + dc * 8) = *(const u32x4*)(pr + C_RQ); *(u32x4*)(Ks + m * 72 + dc * 8) = *(const u32x4*)(pr + C_RK); *(u32x4*)(Vs + m * 72 + dc * 8) = *(const u32x4*)(pr + C_RV); }
        __syncthreads();
        {
            const int tn = tid >> 4, tm = tid & 15;
            float acc[4][8];
#pragma unroll
            for (int i = 0; i < 4; ++i)
#pragma unroll
                for (int j = 0; j < 8; ++j) acc[i][j] = 0.f;
            for (int dc = 0; dc < 8; ++dc) {
                u32x4 q[4], k[8];
#pragma unroll
                for (int i = 0; i < 4; ++i) q[i] = *(const u32x4*)(Qs + (tn + 32 * i) * 72 + dc * 8);
#pragma unroll
                for (int j = 0; j < 8; ++j) k[j] = *(const u32x4*)(Ks + (tm + 16 * j) * 72 + dc * 8);
#pragma unroll
                for (int i = 0; i < 4; ++i)
#pragma unroll
                    for (int j = 0; j < 8; ++j)
#pragma unroll
                        for (int w = 0; w < 4; ++w) acc[i][j] += lo16(q[i][w]) * lo16(k[j][w]) + hi16(q[i][w]) * hi16(k[j][w]);
            }
#pragma unroll
            for (int i = 0; i < 4; ++i)
#pragma unroll
                for (int j = 0; j < 8; ++j) { const int n = tn + 32 * i, m = tm + 16 * j;
                    const float f = (n > m) ? pf[n - m] : ((n < m) ? pb[m - n] : 2.f);
                    S[n * 132 + m] = acc[i][j] * 0.125f * f; }
        }
        __syncthreads();
        {
            const int n = tid >> 2, eq = tid & 3;
            float acc[16];
#pragma unroll
            for (int e = 0; e < 16; ++e) acc[e] = 0.f;
            for (int m = 0; m < 128; ++m) { const float sv = S[n * 132 + m];
                const u32x4 v0 = *(const u32x4*)(Vs + m * 72 + eq * 16), v1 = *(const u32x4*)(Vs + m * 72 + eq * 16 + 8);
#pragma unroll
                for (int w = 0; w < 4; ++w) { acc[2 * w] += sv * lo16(v0[w]); acc[2 * w + 1] += sv * hi16(v0[w]); acc[8 + 2 * w] += sv * lo16(v1[w]); acc[9 + 2 * w] += sv * hi16(v1[w]); } }
            const float* SPf = (const float*)(p.ws + WS_RU) + ((size_t)(0 * 4 + h) * NCH + c) * 4096 + eq * 16;
            const float* SPb = (const float*)(p.ws + WS_RU) + ((size_t)(1 * 4 + h) * NCH + c) * 4096 + eq * 16;
            const float xif = pf[n] * pf[1], xib = pb[127 - n] * pb[1];
            for (int d = 0; d < 64; ++d) { const float qd = bf2f(Qs[n * 72 + d]), qf = qd * xif, qb = qd * xib;
#pragma unroll
                for (int w = 0; w < 4; ++w) { const f32x4 a = *(const f32x4*)(SPf + d * 64 + 4 * w), b = *(const f32x4*)(SPb + d * 64 + 4 * w);
                    acc[4 * w] += qf * a.x + qb * b.x; acc[4 * w + 1] += qf * a.y + qb * b.y; acc[4 * w + 2] += qf * a.z + qb * b.z; acc[4 * w + 3] += qf * a.w + qb * b.w; } }
            float s = 0.f;
#pragma unroll
            for (int e = 0; e < 16; ++e) s += acc[e];
            s += __shfl_xor(s, 1); s += __shfl_xor(s, 2);
            const float mu = s * (1.f / 64.f); float vs = 0.f;
#pragma unroll
            for (int e = 0; e < 16; ++e) { acc[e] -= mu; vs += acc[e] * acc[e]; }
            vs += __shfl_xor(vs, 1); vs += __shfl_xor(vs, 2);
            const float rs = rsqrtf(vs * (1.f / 64.f) + EPS);
            const bf16* gr = P + (size_t)(r0 + n) * INC + C_RG + h * 64 + eq * 16;
            const u32x4 g0 = *(const u32x4*)gr, g1 = *(const u32x4*)(gr + 8);
            u32x4 o0, o1;
#pragma unroll
            for (int w = 0; w < 4; ++w) { o0[w] = pk2(silu_f(lo16(g0[w])) * acc[2 * w] * rs, silu_f(hi16(g0[w])) * acc[2 * w + 1] * rs);
                o1[w] = pk2(silu_f(lo16(g1[w])) * acc[8 + 2 * w] * rs, silu_f(hi16(g1[w])) * acc[9 + 2 * w] * rs); }
            bf16* yo = Y + (size_t)(r0 + n) * D + 256 + h * 64 + eq * 16;
            *(u32x4*)yo = o0; *(u32x4*)(yo + 8) = o1;
        }
        __syncthreads();
    }
}
__device__ __forceinline__ void post_hy(const Params& p, int l, bool with_ctx, float* sm, int bid, int nb) {
    const bf16* P = (const bf16*)(p.ws + WS_P); bf16* Y = (bf16*)(p.ws + WS_YMIX);
    const float* cw = p.in[10] + l * 3 * 768; const float* cb = p.in[11] + l * 768; const float* hb = p.in[19] + l * 256;
    const int ntile = with_ctx ? 260 : 256, tid = threadIdx.x;
    for (int tile = bid; tile < ntile; tile += nb) {
        const int t0 = tile * 64; const int lo = tile < 256 ? 0 : SEQ, hi = tile < 256 ? SEQ : R;
        for (int e = tid; e < 64 * 256; e += NT) { const int ch = e >> 6, tl = e & 63;
            sm[ch * 65 + tl] = (tile < 256) ? ((const float*)(p.ws + WS_ZT))[(size_t)ch * SEQ + t0 + tl] : ((const float*)(p.ws + WS_ZC))[ch * CTXL + (t0 - SEQ) + tl]; }
        __syncthreads();
        for (int e = tid; e < 64 * 256; e += NT) { const int tl = e >> 8, ch = e & 255, t = t0 + tl;
            const float x0 = conv3(P, cw, cb, t, lo, hi, C_HX0 + ch), z = conv3(P, cw, cb, t, lo, hi, C_HX1 + ch) * conv3(P, cw, cb, t, lo, hi, C_HV + ch);
            Y[(size_t)t * D + ch] = (bf16)f2bf(x0 * (sm[ch * 65 + tl] + hb[ch] * z)); }
        __syncthreads();
    }
}

#include <hip/hip_bf16.h>
#include <cmath>
namespace attn_body {
using bf16=__hip_bfloat16;
using bf16x8=__attribute__((ext_vector_type(8)))short;
using s16x4=__attribute__((ext_vector_type(4)))short;
using f32x16=__attribute__((ext_vector_type(16)))float;
using u32x4=__attribute__((ext_vector_type(4)))unsigned;
constexpr int D=64;
constexpr int NW=8,QBLK=32,QB=QBLK*NW,KVBLK=64;
constexpr int QP=2560,KP=2560,OP=1024;
__device__ __forceinline__ int crow(int r,int hi){return (r&3)+8*(r>>2)+4*hi;}
#define SBAR() __builtin_amdgcn_sched_barrier(0)
__device__ __forceinline__ void cmask(f32x16&p0,f32x16&p1,int jb,int qrel,int hi){
  const float NEG=-INFINITY; int kb=64*jb+4*hi;
  #pragma unroll
  for(int r=0;r<16;++r){int kv=kb+(r&3)+8*(r>>2); if(kv>qrel)p0[r]=NEG; if(kv+32>qrel)p1[r]=NEG;}
}

constexpr int NSLOT=3, SLOTB=8192;
constexpr int LDS_K=0, LDS_V=NSLOT*SLOTB, LDS_WS=2*NSLOT*SLOTB, LDS_OST=LDS_WS+NW*64*4, LDS_BYTES=LDS_OST+NW*4096;
constexpr float C2=0.125f*1.4426950408889634f;
__device__ __forceinline__ void glds16(const void*gsrc,unsigned lds_dst){unsigned keep;
  asm volatile("s_mov_b32 %0, m0\n\ts_mov_b32 m0, %2\n\ts_nop 0\n\tglobal_load_lds_dwordx4 %1, off\n\ts_mov_b32 m0, %0":"=&s"(keep):"v"(gsrc),"s"(lds_dst):"memory");}
__device__ __forceinline__ float max3f(float a,float b,float c){float r;asm("v_max3_f32 %0, %1, %2, %3":"=v"(r):"v"(a),"v"(b),"v"(c));return r;}
__device__ __forceinline__ float max2f(float a,float b){float r;asm("v_max_f32_e32 %0, %1, %2":"=v"(r):"v"(a),"v"(b));return r;}
__device__ __forceinline__ float fadd_s(float a,float b){float r;asm("v_add_f32_e32 %0, %1, %2":"=v"(r):"v"(a),"v"(b));return r;}
__device__ __forceinline__ float fsub_s(float a,float b){float r;asm("v_sub_f32_e32 %0, %1, %2":"=v"(r):"v"(a),"v"(b));return r;}
typedef float f32x2_t __attribute__((ext_vector_type(2))); typedef __bf16 bf16x2_t __attribute__((ext_vector_type(2)));
__device__ __forceinline__ unsigned cvtpk_s(float lo,float hi){f32x2_t v={lo,hi};bf16x2_t b=__builtin_convertvector(v,bf16x2_t);return __builtin_bit_cast(unsigned,b);}
#define WAIT_BAR(N) asm volatile("s_waitcnt vmcnt(" #N ") lgkmcnt(0)\n\ts_barrier":::"memory")

__device__ __forceinline__ void qkt(f32x16&p0,f32x16&p1,const char*Kslot,const bf16x8*qr,const f32x16&negm,int r32,int hi){
  const char*kb=Kslot+hi*1024+r32*16;
  #pragma unroll
  for(int d0=0;d0<4;++d0){
    const bf16x8 b0=*reinterpret_cast<const bf16x8*>(kb+d0*2048);
    const bf16x8 b1=*reinterpret_cast<const bf16x8*>(kb+d0*2048+512);
    if(d0==0){p0=__builtin_amdgcn_mfma_f32_32x32x16_bf16(b0,qr[0],negm,0,0,0);p1=__builtin_amdgcn_mfma_f32_32x32x16_bf16(b1,qr[0],negm,0,0,0);}
    else{p0=__builtin_amdgcn_mfma_f32_32x32x16_bf16(b0,qr[d0],p0,0,0,0);p1=__builtin_amdgcn_mfma_f32_32x32x16_bf16(b1,qr[d0],p1,0,0,0);}}
}
typedef __attribute__((address_space(3))) const char* lds_cptr;
typedef short v4i16_t __attribute__((ext_vector_type(4)));
__device__ __forceinline__ void kload8(bf16x8*kf,lds_cptr kp){
  kf[0]=*(const __attribute__((address_space(3))) bf16x8*)(kp);      kf[1]=*(const __attribute__((address_space(3))) bf16x8*)(kp+512);
  kf[2]=*(const __attribute__((address_space(3))) bf16x8*)(kp+2048); kf[3]=*(const __attribute__((address_space(3))) bf16x8*)(kp+2560);
  kf[4]=*(const __attribute__((address_space(3))) bf16x8*)(kp+4096); kf[5]=*(const __attribute__((address_space(3))) bf16x8*)(kp+4608);
  kf[6]=*(const __attribute__((address_space(3))) bf16x8*)(kp+6144); kf[7]=*(const __attribute__((address_space(3))) bf16x8*)(kp+6656);
}
__device__ __forceinline__ void kload2(bf16x8*kf,lds_cptr kp,int j){ kf[2*j]=*(const __attribute__((address_space(3))) bf16x8*)(kp+j*2048); kf[2*j+1]=*(const __attribute__((address_space(3))) bf16x8*)(kp+j*2048+512); }
__device__ __forceinline__ s16x4 vtr(lds_cptr p){ return __builtin_bit_cast(s16x4,__builtin_amdgcn_ds_read_tr16_b64_v4i16((__attribute__((address_space(3))) v4i16_t*)p)); }
__device__ __forceinline__ float rowmax(const f32x16&p0,const f32x16&p1){
  float a=max3f(p0[0],p0[1],p1[0]),b=max3f(p0[2],p0[3],p1[1]);a=max3f(a,p1[2],p1[3]);
  #pragma unroll
  for(int r=4;r<16;r+=4){a=max3f(a,p0[r],p0[r+1]);b=max3f(b,p0[r+2],p0[r+3]);a=max3f(a,p1[r],p1[r+1]);b=max3f(b,p1[r+2],p1[r+3]);}
  const float m=max2f(a,b);
  auto rr=__builtin_amdgcn_permlane32_swap(__float_as_uint(m),__float_as_uint(m),false,false);
  return max2f(__uint_as_float(rr[0]),__uint_as_float(rr[1]));
}
__device__ __forceinline__ void pv(f32x16*o,int vb,bf16x8 pa0,bf16x8 pa1,bf16x8 pa2,bf16x8 pa3){
  #pragma unroll
  for(int d0=0;d0<2;++d0){s16x4 lo[4],hi[4];
    #pragma unroll
    for(int ks=0;ks<4;++ks){
      asm volatile("ds_read_b64_tr_b16 %0,%1 offset:%c2":"=&v"(lo[ks]):"v"(vb),"i"(d0*4096+ks*1024):"memory");
      asm volatile("ds_read_b64_tr_b16 %0,%1 offset:%c2":"=&v"(hi[ks]):"v"(vb),"i"(d0*4096+ks*1024+512):"memory");}
    asm volatile("s_waitcnt lgkmcnt(0)":::"memory");SBAR();
    #define PK(k) (bf16x8){lo[k][0],lo[k][1],lo[k][2],lo[k][3],hi[k][0],hi[k][1],hi[k][2],hi[k][3]}
    o[d0]=__builtin_amdgcn_mfma_f32_32x32x16_bf16(pa0,PK(0),o[d0],0,0,0);
    o[d0]=__builtin_amdgcn_mfma_f32_32x32x16_bf16(pa1,PK(1),o[d0],0,0,0);
    o[d0]=__builtin_amdgcn_mfma_f32_32x32x16_bf16(pa2,PK(2),o[d0],0,0,0);
    o[d0]=__builtin_amdgcn_mfma_f32_32x32x16_bf16(pa3,PK(3),o[d0],0,0,0);
    #undef PK
  }
}

#ifndef ATTN_STORE16
#define ATTN_STORE16(p,v) (*(u32x4*)(p)=(v))
#endif
template<int THRL> __device__ __forceinline__ void attn_unit(const bf16*Qh,const bf16*__restrict__ Kh,const bf16*__restrict__ Vh,bf16*Oh,const int NT,char*shm){
  const int tid=threadIdx.x,lane=tid&63,r32=lane&31,hi=lane>>5; const int wid=__builtin_amdgcn_readfirstlane(tid>>6);
  const bf16*Qw=Qh+(long)(wid*QBLK)*QP;
  const unsigned lds0=(unsigned)(uintptr_t)shm;
  float*wsf=(float*)(shm+LDS_WS)+wid*64;
  const bf16*ksrc=Kh+(long)lane*KP+wid*8;
  const bf16*vsrc=Vh+(long)(16*(wid&3)+(lane>>2))*KP+(wid>>2)*32+(lane&3)*8;
  const unsigned kdst=lds0+LDS_K+wid*1024, vdst=lds0+LDS_V+wid*1024;
  #define DMA_K(t,slot) glds16(ksrc+(long)(t)*KVBLK*KP,(unsigned)__builtin_amdgcn_readfirstlane(kdst+(slot)))
  #define DMA_V(t,slot) glds16(vsrc+(long)(t)*KVBLK*KP,(unsigned)__builtin_amdgcn_readfirstlane(vdst+(slot)))
  const int vb0=(int)(lds0+LDS_V)+((lane>>4)&1)*32+(lane&3)*8+(4*hi+((lane&15)>>2))*64;
  const char*Kbase=shm+LDS_K; bf16x8 kf[8];
  const lds_cptr shm3=(lds_cptr)shm; const lds_cptr kp0=shm3+LDS_K+hi*1024+r32*16; const lds_cptr vp0=shm3+LDS_V+((lane>>4)&1)*32+(lane&3)*8+(4*hi+((lane&15)>>2))*64;
  DMA_K(0,0);DMA_V(0,0);DMA_K(1,SLOTB);
  bf16x8 qr[4];
  #pragma unroll
  for(int d0=0;d0<4;++d0)qr[d0]=*reinterpret_cast<const bf16x8*>(&Qw[(long)r32*QP+d0*16+hi*8]);
  float mhat=0.f,l_reg=0.f;f32x16 o[2];o[0]=f32x16{};o[1]=f32x16{};f32x16 negm=f32x16{};asm volatile("":"+v"(negm));
  const int qrel=wid*QBLK+r32;
  #define CMASK(P0,P1,t) do{}while(0)
  bool resc=false;
  #define START(P0,P1) do{ const float rm=rowmax(P0,P1); resc=false; \
    { const float dl=rm; mhat=fadd_s(mhat,dl); \
      _Pragma("unroll") for(int r=0;r<16;++r){P0[r]=fsub_s(P0[r],dl);P1[r]=fsub_s(P1[r],dl);} \
      _Pragma("unroll") for(int r=0;r<16;++r)negm[r]=-mhat; asm volatile("":"+v"(negm)); } \
    _Pragma("unroll") for(int r=0;r<16;++r)P0[r]=__builtin_amdgcn_exp2f(P0[r]); }while(0)
  #define RESC() do{ if(resc){ asm volatile("s_waitcnt lgkmcnt(0)":::"memory"); \
      _Pragma("unroll") for(int d_=0;d_<2;++d_) _Pragma("unroll") for(int r=0;r<16;++r)o[d_][r]*=wsf[crow(r,hi)]; } }while(0)
  f32x16 pA0,pA1,pB0,pB1;
  int sl_prev=0,sl_cur=0,sl_next=SLOTB;
  #define ROT() do{sl_prev=sl_cur;sl_cur=sl_next;sl_next=(sl_next==(NSLOT-1)*SLOTB)?0:sl_next+SLOTB;}while(0)
  DMA_K(2,2*SLOTB);
  WAIT_BAR(3);
  qkt(pA0,pA1,Kbase,qr,negm,r32,hi);asm volatile("s_nop 15\n\ts_nop 7":"+v"(pA0),"+v"(pA1));CMASK(pA0,pA1,0);
  START(pA0,pA1);
  _Pragma("unroll") for(int r=0;r<16;++r)pA1[r]=__builtin_amdgcn_exp2f(pA1[r]);
  WAIT_BAR(0);
  DMA_K(3,0);DMA_V(1,SLOTB);
  ROT();
  kload8(kf,kp0+sl_cur);
  WAIT_BAR(2);
  s16x4 vlo[8],vhi[8]; u32x4 pw0,pw1,pw2,pw3;
  #define PKW(P,B) cvtpk_s(P[B],P[B+1])
  #define PAF(k) __builtin_bit_cast(bf16x8,pw##k)
  #define VFR(i) (bf16x8){vlo[i][0],vlo[i][1],vlo[i][2],vlo[i][3],vhi[i][0],vhi[i][1],vhi[i][2],vhi[i][3]}
  #define PIN(x) asm volatile("":"+v"(x))
  #define MX3(a,b,c) __builtin_fmaxf(__builtin_fmaxf((a),(b)),(c))
  #define GAPA(MF,A0,A1,A2,A3,W0,W1,PW) do{ MF; sacc+=A0; sacc+=A1; sacc+=A2; sacc+=A3; PIN(sacc); W0; W1; PIN(PW); SBAR(); }while(0)
  #define EX(v) __builtin_amdgcn_exp2f(v)
  #define GAPB(MF,X,B) do{ MF; X[B]=EX(X[B]); X[B+1]=EX(X[B+1]); X[B+2]=EX(X[B+2]); X[B+3]=EX(X[B+3]); PIN(X); SBAR(); }while(0)
  #define VRD(i) do{ vlo[i]=vtr(vp_+(((i)>>2)*4096+((i)&3)*1024)); vhi[i]=vtr(vp_+(((i)>>2)*4096+((i)&3)*1024+512)); }while(0)
  #define KRD(G,j) do{ if(G){ kload2(kf,kp0+sl_next,j); SBAR(); } }while(0)
  #define STEP(C0,C1,P0,P1,t,GK,GV,GL) do{ SBAR(); \
    const lds_cptr vp_=vp0+sl_prev; \
    VRD(0); SBAR(); float sacc=(P0[0]+P0[1]); \
    GAPA(C0=__builtin_amdgcn_mfma_f32_32x32x16_bf16(kf[0],qr[0],negm,0,0,0), P0[2],P0[3],P0[4],P0[5],     pw0[0]=PKW(P0,0), pw0[1]=PKW(P0,2), pw0); \
    VRD(4); SBAR(); GAPA(C1=__builtin_amdgcn_mfma_f32_32x32x16_bf16(kf[1],qr[0],negm,0,0,0), P0[6],P0[7],P0[8],P0[9],     pw0[2]=PKW(P0,4), pw0[3]=PKW(P0,6), pw0); \
    VRD(1); SBAR(); GAPA(C0=__builtin_amdgcn_mfma_f32_32x32x16_bf16(kf[2],qr[1],C0,0,0,0),   P0[10],P0[11],P0[12],P0[13], pw1[0]=PKW(P0,8), pw1[1]=PKW(P0,10), pw1); \
    VRD(5); SBAR(); GAPA(C1=__builtin_amdgcn_mfma_f32_32x32x16_bf16(kf[3],qr[1],C1,0,0,0),   P0[14],P0[15],P1[0],P1[1],   pw1[2]=PKW(P0,12),pw1[3]=PKW(P0,14), pw1); \
    VRD(2); SBAR(); GAPA(C0=__builtin_amdgcn_mfma_f32_32x32x16_bf16(kf[4],qr[2],C0,0,0,0),   P1[2],P1[3],P1[4],P1[5],     pw2[0]=PKW(P1,0), pw2[1]=PKW(P1,2), pw2); \
    VRD(6); SBAR(); GAPA(C1=__builtin_amdgcn_mfma_f32_32x32x16_bf16(kf[5],qr[2],C1,0,0,0),   P1[6],P1[7],P1[8],P1[9],     pw2[2]=PKW(P1,4), pw2[3]=PKW(P1,6), pw2); \
    VRD(3); SBAR(); GAPA(C0=__builtin_amdgcn_mfma_f32_32x32x16_bf16(kf[6],qr[3],C0,0,0,0),   P1[10],P1[11],P1[12],P1[13], pw3[0]=PKW(P1,8), pw3[1]=PKW(P1,10), pw3); \
    VRD(7); SBAR(); GAPA(C1=__builtin_amdgcn_mfma_f32_32x32x16_bf16(kf[7],qr[3],C1,0,0,0),   P1[14],P1[15],0.f,0.f,       pw3[2]=PKW(P1,12),pw3[3]=PKW(P1,14), pw3); \
    l_reg+=sacc; \
    if(GK){DMA_K((t)+3,sl_cur);} if(GV){DMA_V((t)+1,sl_next);} \
    CMASK(C0,C1,t); \
    { float a=MX3(C0[0],C0[1],C1[0]),b=MX3(C0[2],C0[3],C1[1]); a=MX3(a,C1[2],C1[3]); \
      _Pragma("unroll") for(int r=4;r<16;r+=4){a=MX3(a,C0[r],C0[r+1]);b=MX3(b,C0[r+2],C0[r+3]);a=MX3(a,C1[r],C1[r+1]);b=MX3(b,C1[r+2],C1[r+3]);} \
      float rm=__builtin_fmaxf(a,b); { auto rr=__builtin_amdgcn_permlane32_swap(__float_as_uint(rm),__float_as_uint(rm),false,false); rm=__builtin_fmaxf(__uint_as_float(rr[0]),__uint_as_float(rr[1])); } \
      resc=false; \
      if(__builtin_expect(__any(rm>(float)THRL),0)){ const float dl=__builtin_fmaxf(rm,0.f); mhat+=dl; \
        _Pragma("unroll") for(int r=0;r<16;++r){C0[r]-=dl;C1[r]-=dl;} \
        _Pragma("unroll") for(int r=0;r<16;++r)negm[r]=-mhat; asm volatile("":"+v"(negm)); \
        const float f=__builtin_amdgcn_exp2f(-dl); l_reg*=f; if(hi==0)wsf[r32]=f; resc=true; } } \
    SBAR(); \
    GAPB(o[0]=__builtin_amdgcn_mfma_f32_32x32x16_bf16(PAF(0),VFR(0),o[0],0,0,0), C0,0); \
    GAPB(o[1]=__builtin_amdgcn_mfma_f32_32x32x16_bf16(PAF(0),VFR(4),o[1],0,0,0), C0,4); \
    KRD(GL,0); GAPB(o[0]=__builtin_amdgcn_mfma_f32_32x32x16_bf16(PAF(1),VFR(1),o[0],0,0,0), C0,8); \
    KRD(GL,1); GAPB(o[1]=__builtin_amdgcn_mfma_f32_32x32x16_bf16(PAF(1),VFR(5),o[1],0,0,0), C0,12); \
    KRD(GL,2); GAPB(o[0]=__builtin_amdgcn_mfma_f32_32x32x16_bf16(PAF(2),VFR(2),o[0],0,0,0), C1,0); \
    KRD(GL,3); GAPB(o[1]=__builtin_amdgcn_mfma_f32_32x32x16_bf16(PAF(2),VFR(6),o[1],0,0,0), C1,4); \
    GAPB(o[0]=__builtin_amdgcn_mfma_f32_32x32x16_bf16(PAF(3),VFR(3),o[0],0,0,0), C1,8); \
    GAPB(o[1]=__builtin_amdgcn_mfma_f32_32x32x16_bf16(PAF(3),VFR(7),o[1],0,0,0), C1,12); \
    }while(0)
  int t=1;
  #undef CMASK
  #define CMASK(P0,P1,t) do{}while(0)
  for(;t+5<NT;t+=2){
    STEP(pB0,pB1,pA0,pA1,t,true,true,true);     WAIT_BAR(2); RESC(); ROT();
    STEP(pA0,pA1,pB0,pB1,t+1,true,true,true);   WAIT_BAR(2); RESC(); ROT();
  }
  #undef CMASK
  #define CMASK(P0,P1,t) do{}while(0)
  #define ENDW(tt) do{ if((tt)+3<NT){WAIT_BAR(2);} else if((tt)+2<NT){WAIT_BAR(1);} else {WAIT_BAR(0);} }while(0)
  for(;t+1<NT;t+=2){
    STEP(pB0,pB1,pA0,pA1,t,(t+3<NT),(t+1<NT),(t+1<NT));       ENDW(t);   RESC(); ROT();
    STEP(pA0,pA1,pB0,pB1,t+1,(t+4<NT),(t+2<NT),(t+2<NT));     ENDW(t+1); RESC(); ROT();
  }
  STEP(pB0,pB1,pA0,pA1,NT-1,false,false,false); RESC();
  { float sacc=pB0[0]+pB0[1]; _Pragma("unroll") for(int r=2;r<16;++r)sacc+=pB0[r]; _Pragma("unroll") for(int r=0;r<16;++r)sacc+=pB1[r]; l_reg+=sacc;
    pw0=(u32x4){PKW(pB0,0),PKW(pB0,2),PKW(pB0,4),PKW(pB0,6)};pw1=(u32x4){PKW(pB0,8),PKW(pB0,10),PKW(pB0,12),PKW(pB0,14)};pw2=(u32x4){PKW(pB1,0),PKW(pB1,2),PKW(pB1,4),PKW(pB1,6)};pw3=(u32x4){PKW(pB1,8),PKW(pB1,10),PKW(pB1,12),PKW(pB1,14)};
    SBAR(); pv(o,vb0+sl_cur,PAF(0),PAF(1),PAF(2),PAF(3)); }
  #undef PKW
  #undef PAF
  #undef VFR
  #undef PIN
  #undef MX3
  #undef GAPA
  #undef GAPB
  #undef EX
  #undef VRD
  #undef KRD
  #undef STEP
  #undef ENDW
  {auto rr=__builtin_amdgcn_permlane32_swap(__float_as_uint(l_reg),__float_as_uint(l_reg),false,false);l_reg=__uint_as_float(rr[0])+__uint_as_float(rr[1]);}
  if(hi==0)wsf[32+r32]=l_reg;asm volatile("s_waitcnt lgkmcnt(0)":::"memory");
  float rli[16];
  #pragma unroll
  for(int r=0;r<16;++r)rli[r]=__builtin_amdgcn_rcpf(wsf[32+crow(r,hi)]);
  bf16*Ow=Oh+(long)(wid*QBLK)*OP;
  { bf16*stg=(bf16*)(shm+LDS_OST)+wid*2048;
    #pragma unroll
    for(int r=0;r<16;++r){const int orow=crow(r,hi);
      #pragma unroll
      for(int d0=0;d0<2;++d0)stg[orow*64+d0*32+r32]=__float2bfloat16(o[d0][r]*rli[r]);}
    asm volatile("s_waitcnt lgkmcnt(0)":::"memory");
    #pragma unroll
    for(int i=0;i<4;++i){const int row=i*8+(lane>>3),ch=lane&7; const u32x4 v=*(const u32x4*)(stg+row*64+ch*8); ATTN_STORE16(Ow+(long)row*OP+ch*8,v);} }
  asm volatile("s_waitcnt lgkmcnt(0)\n\ts_barrier":::"memory");
  #undef DMA_K
  #undef DMA_V
  #undef CMASK
  #undef START
  #undef RESC
  #undef ROT
}
#undef SBAR
#undef WAIT_BAR
}

__device__ __forceinline__ void attn_fast(const Params& p, bool with_ctx, unsigned char* lds, int bid, int nb) {
    typedef attn_body::bf16 abf;
    const abf* P = (const abf*)(p.ws + WS_P); abf* Y = (abf*)(p.ws + WS_YMIX);
    const int nunits = with_ctx ? 520 : 512;
    for (int u = bid; u < nunits; u += nb) {
        int h, q0, k0, ntile;
        if (u < 512) { h = u >> 6; q0 = (u & 63) * 256; k0 = 0; ntile = R / 64; } else { h = u - 512; q0 = SEQ; k0 = SEQ; ntile = CTXL / 64; }
        const int kvh = h >> 2;
        attn_body::attn_unit<8>(P + (size_t)q0 * INC + C_AQ + h * 64, P + (size_t)k0 * INC + C_AK + kvh * 64, P + (size_t)k0 * INC + C_AV + kvh * 64, Y + (size_t)q0 * D + 512 + h * 64, ntile, (char*)lds);
    }
}

__device__ __forceinline__ int moe_segments(const Params& p, int* seg  , int* tile_e  ) {
    const unsigned* cnt = (const unsigned*)(p.ws + WS_CTL) + CW_CNT;
    if (threadIdx.x == 0) { int s = 0; for (int e = 0; e < 8; ++e) { seg[e] = s; s += (int)((cnt[e] + 255u) >> 8) << 8; } seg[8] = s; }
    __syncthreads();
    const int total = seg[8];
    for (int t = threadIdx.x; t < total / 128; t += NT) { int e = 0; while (t * 128 >= seg[e + 1]) ++e; tile_e[t] = e; }
    __syncthreads();
    return total;
}
__device__ __forceinline__ void ph_gather(const Params& p, int* ism, int bid, int nb) {
    int* seg = ism; int* tile_e = ism + 16;
    const int total = moe_segments(p, seg, tile_e);
    const unsigned* cnt = (const unsigned*)(p.ws + WS_CTL) + CW_CNT;
    const int lane = threadIdx.x & 63, wave = threadIdx.x >> 6;
    const bf16* H = (const bf16*)(p.ws + WS_H); bf16* XS = (bf16*)(p.ws + WS_XS);
    int* rowd = (int*)(p.ws + WS_ROWD); float* rowg = (float*)(p.ws + WS_ROWG);
    const int* at = (const int*)(p.ws + WS_ASGT); const float* ag = (const float*)(p.ws + WS_ASGG);
    for (int s = bid * 8 + wave; s < total; s += nb * 8) {
        const int e = tile_e[s >> 7], pos = s - seg[e];
        u32x4 v0 = (u32x4){0u, 0u, 0u, 0u}, v1 = v0; int dd = -1; float gg = 0.f;
        if (pos < (int)cnt[e]) { dd = at[e * SEQ + pos]; gg = ag[e * SEQ + pos]; const u32x4* src = (const u32x4*)(H + (size_t)(dd >> 1) * D); v0 = src[lane]; v1 = src[64 + lane]; }
        u32x4* dst = (u32x4*)(XS + (size_t)s * D); dst[lane] = v0; dst[64 + lane] = v1;
        if (lane == 0) { rowd[s] = dd; rowg[s] = gg; }
    }
}
__device__ __forceinline__ void ph_final(const Params& p, int bid, int nb) {
    const int lane = threadIdx.x & 63, wave = threadIdx.x >> 6;
    const bf16* Y2 = (const bf16*)(p.ws + WS_Y2); const float* g = p.in[31];
    for (int row = bid * 8 + wave; row < SEQ; row += nb * 8) {
        f32x4* xr = (f32x4*)(p.out + (size_t)row * D) + lane; const f32x4* m5 = (const f32x4*)mod_vec(p, 1, row, 5) + lane;
        const u32x2* ya = (const u32x2*)(Y2 + (size_t)(2 * row) * D) + lane; const u32x2* yb = (const u32x2*)(Y2 + (size_t)(2 * row + 1) * D) + lane;
        f32x4 v[4]; float ss = 0.f;
#pragma unroll
        for (int j = 0; j < 4; ++j) { const u32x2 a = ya[64 * j], b = yb[64 * j]; const f32x4 m = m5[64 * j];
            const f32x4 y = (f32x4){lo16(a.x) + lo16(b.x), hi16(a.x) + hi16(b.x), lo16(a.y) + lo16(b.y), hi16(a.y) + hi16(b.y)};
            v[j] = xr[64 * j] + m * y; ss += (v[j].x * v[j].x + v[j].y * v[j].y) + (v[j].z * v[j].z + v[j].w * v[j].w); }
        const float r = rsqrtf(wave_sum(ss) * (1.f / D) + EPS);
#pragma unroll
        for (int j = 0; j < 4; ++j) xr[64 * j] = v[j] * r * ((const f32x4*)g)[lane + 64 * j];
    }
}

#define LAS __attribute__((address_space(3)))
#define XB_TMO      128
#define XB_XCNT(j)  (256  + 64 * (j))
#define XB_XSUB(j)  (1280 + 64 * (j))
#define XB_XGEN(j)  (2304 + 64 * (j))
#define XB_TOP      3328
#define XB_TOPGEN   3392
#define XCD_BAR_WORDS 3456
#define XB_SPIN_CAP (1u << 18)
__device__ __forceinline__ unsigned xb_ld(unsigned* p)              { return __hip_atomic_load(p, __ATOMIC_RELAXED, __HIP_MEMORY_SCOPE_AGENT); }
__device__ __forceinline__ unsigned xb_add(unsigned* p, unsigned v) { return __hip_atomic_fetch_add(p, v, __ATOMIC_RELAXED, __HIP_MEMORY_SCOPE_AGENT); }
__device__ __forceinline__ unsigned xb_xcc_id() { return (unsigned)__builtin_amdgcn_s_getreg((3 << 11) | 20) & 0xFu; }
#define XB_SPIN(cond, bar) do { unsigned _sp = 0; while (cond) { __builtin_amdgcn_s_sleep(1); \
    if ((++_sp & 255u) == 0u) { if (xb_ld(&(bar)[XB_TMO])) break; if (_sp > XB_SPIN_CAP) { atomicAdd(&(bar)[XB_TMO], 1u); break; } } } } while (0)
struct XcdBarrier { unsigned* bar; unsigned x; volatile LAS unsigned* st; };
__device__ __forceinline__ XcdBarrier xcd_barrier_post(unsigned* bar, volatile LAS unsigned* st) {
    XcdBarrier b; b.bar = bar; b.x = xb_xcc_id(); b.st = st;
    if (threadIdx.x == 0) (void)xb_add(&bar[XB_XCNT(b.x)], 1u);
    return b;
}
__device__ __forceinline__ void xcd_barrier_complete(unsigned* bar, unsigned x, unsigned& nloc, unsigned& nx) {
    const unsigned G = gridDim.x * gridDim.y * gridDim.z;
    unsigned sum, cnt, mine, sp = 0u;
    for (;;) {
        sum = 0u; cnt = 0u; mine = 0u;
#pragma unroll
        for (unsigned j = 0; j < 16; ++j) { const unsigned c = xb_ld(&bar[XB_XCNT(j)]); sum += c; cnt += (c > 0u) ? 1u : 0u; mine = (j == x) ? c : mine; }
        if (sum == G) break;
        __builtin_amdgcn_s_sleep(1);
        if ((++sp & 255u) == 0u) { if (xb_ld(&bar[XB_TMO])) break; if (sp > XB_SPIN_CAP) { atomicAdd(&bar[XB_TMO], 1u); break; } }
    }
    nloc = mine > 0u ? mine : 1u; nx = cnt > 0u ? cnt : 1u;
}
__device__ __forceinline__ void xcd_barrier(const XcdBarrier& b) {
    asm volatile("s_waitcnt vmcnt(0)" ::: "memory");
    __syncthreads();
    if (threadIdx.x == 0) {
        unsigned* bar = b.bar;
        __builtin_amdgcn_s_waitcnt(0);
        unsigned nloc = b.st[0], nx = b.st[1];
        if (nloc == 0u) { xcd_barrier_complete(bar, b.x, nloc, nx); b.st[0] = nloc; b.st[1] = nx; }
        const unsigned old = xb_add(&bar[XB_XSUB(b.x)], 1u);
        const unsigned gen = old / nloc;
        if (old + 1u == (gen + 1u) * nloc) {
            __builtin_amdgcn_fence(__ATOMIC_RELEASE, "agent");
            asm volatile("s_waitcnt vmcnt(0)" ::: "memory");
            const unsigned og = xb_add(&bar[XB_TOP], 1u);
            const unsigned tg = og / nx;
            if (og + 1u == (tg + 1u) * nx) xb_add(&bar[XB_TOPGEN], 1u);
            else XB_SPIN(xb_ld(&bar[XB_TOPGEN]) == tg, bar);
            __builtin_amdgcn_fence(__ATOMIC_ACQUIRE, "agent");
            xb_add(&bar[XB_XGEN(b.x)], 1u);
            asm volatile("s_waitcnt vmcnt(0)" ::: "memory");
        } else {
            XB_SPIN(xb_ld(&bar[XB_XGEN(b.x)]) == gen, bar);
            __builtin_amdgcn_fence(__ATOMIC_ACQUIRE, "agent");
            asm volatile("s_waitcnt vmcnt(0)" ::: "memory");
        }
    }
    __syncthreads();
}

constexpr int LDS_BYTES = 147456;
constexpr int LDS_MISC = 131072 + 8192;
constexpr int NPHASE = 21;

__global__ void __launch_bounds__(NT, 2) k_run(Params p) {
    extern __shared__ __attribute__((aligned(16))) unsigned char lds[];
    float* sm = (float*)lds;
    const int bid = blockIdx.x, nb = gridDim.x;
    volatile LAS unsigned* misc = (volatile LAS unsigned*)((LAS unsigned char*)lds + LDS_MISC);
    if (threadIdx.x < 16) misc[threadIdx.x] = 0u;
    __syncthreads();
    XcdBarrier bar; bar.bar = (unsigned*)(p.ws + WS_CTL) + CW_BAR; bar.x = 0; bar.st = nullptr;
    if (p.ph_hi - p.ph_lo > 1) bar = xcd_barrier_post((unsigned*)(p.ws + WS_CTL) + CW_BAR, misc + 8);
    const int lo = p.ph_lo, hi = p.ph_hi;
#ifndef ONLY_PH
#define ONLY_PH -1
#endif
#define IN(k) ((ONLY_PH < 0 || ONLY_PH == (k)) && lo <= (k) && (k) < hi)
#define SEAM(k) do { if (IN(k) && IN((k) + 1)) xcd_barrier(bar); } while (0)

    if (IN(0)) { ph_mod(p, sm, bid, nb); ph_tw(p, bid, nb); __syncthreads(); ph_filt(p, sm, bid, nb); __syncthreads(); ph_wconv(p, sm, bid, nb); } SEAM(0);
    if (IN(1)) { ph_hfft(p, sm, bid, nb); ph_norm(p, 0, 0, true, R, false, bid, nb); } SEAM(1);
    if (IN(2)) { PgEpiP E{(bf16*)(p.ws + WS_P), INC}; run_gemm(lds, (const bf16*)(p.ws + WS_H), (const bf16*)(p.ws + WS_WIN), R, INC, D, E, nullptr, 0, bid, nb); } SEAM(2);
    if (IN(3)) { prep_qk(p, 0, R, bid, nb); prep_hyz(p, 0, true, sm, bid, nb); prep_retu(p, 0, sm, bid, nb); } SEAM(3);
    if (IN(4)) { ph_retscan(p, 0, bid, nb);
        for (int u = bid; u < 512; u += nb) { if (u < 256) hconv_unit(p, 0, u, sm); else hconv_ctx_unit(p, u - 256, sm); }
        attn_fast(p, true, lds, bid, nb); } SEAM(4);
    if (IN(5)) { post_ret(p, 0, NCH, lds, bid, nb); post_hy(p, 0, true, sm, bid, nb); } SEAM(5);
    if (IN(6)) { PgEpiRes E{&p, 0, 2, true}; run_gemm(lds, (const bf16*)(p.ws + WS_YMIX), (const bf16*)(p.ws + WS_WOUT), R, D, D, E, nullptr, 0, bid, nb); } SEAM(6);
    if (IN(7)) { ph_norm(p, 0, 1, false, R, false, bid, nb); } SEAM(7);
    if (IN(8)) { PgEpiSwi E{(bf16*)(p.ws + WS_HID)}; run_gemm(lds, (const bf16*)(p.ws + WS_H), (const bf16*)(p.ws + WS_WGU), R, 2 * FF, D, E, nullptr, 0, bid, nb); } SEAM(8);
    if (IN(9)) { PgEpiRes E{&p, 0, 5, false}; run_gemm(lds, (const bf16*)(p.ws + WS_HID), (const bf16*)(p.ws + WS_WDN), R, D, FF, E, nullptr, 0, bid, nb); } SEAM(9);
    if (IN(10)) { ph_norm(p, 1, 0, false, R, false, bid, nb); } SEAM(10);
    if (IN(11)) { PgEpiP E{(bf16*)(p.ws + WS_P), INC}; run_gemm(lds, (const bf16*)(p.ws + WS_H), (const bf16*)(p.ws + WS_WIN) + (size_t)INC * D, R, INC, D, E, nullptr, 0, bid, nb); } SEAM(11);
    if (IN(12)) { prep_qk(p, 1, R, bid, nb); prep_hyz(p, 1, false, sm, bid, nb); prep_retu(p, 1, sm, bid, nb); } SEAM(12);
    if (IN(13)) { ph_retscan(p, 1, bid, nb);
        for (int u = bid; u < 256; u += nb) hconv_unit(p, 1, u, sm);
        attn_fast(p, false, lds, bid, nb); } SEAM(13);
    if (IN(14)) { post_ret(p, 1, 128, lds, bid, nb); post_hy(p, 1, false, sm, bid, nb); } SEAM(14);
    if (IN(15)) { PgEpiRes E{&p, 1, 2, false}; run_gemm(lds, (const bf16*)(p.ws + WS_YMIX), (const bf16*)(p.ws + WS_WOUT) + (size_t)D * D, SEQ, D, D, E, nullptr, 0, bid, nb); } SEAM(15);
    if (IN(16)) { ph_norm(p, 1, 1, false, SEQ, true, bid, nb); } SEAM(16);
    if (IN(17)) { ph_gather(p, (int*)(lds + LDS_MISC + 256), bid, nb); } SEAM(17);
    if (IN(18)) { int* ism = (int*)(lds + LDS_MISC + 256); const int total = moe_segments(p, ism, ism + 16);
        PgEpiSwi E{(bf16*)(p.ws + WS_HIDM)}; run_gemm(lds, (const bf16*)(p.ws + WS_XS), (const bf16*)(p.ws + WS_MOEW), total, 2 * FF, D, E, ism + 16, MOEW_E * 2, bid, nb); } SEAM(18);
    if (IN(19)) { int* ism = (int*)(lds + LDS_MISC + 256); const int total = moe_segments(p, ism, ism + 16);
        PgEpiMoeDown E{(bf16*)(p.ws + WS_Y2), (const int*)(p.ws + WS_ROWD), (const float*)(p.ws + WS_ROWG)};
        run_gemm(lds, (const bf16*)(p.ws + WS_HIDM), (const bf16*)(p.ws + WS_MOEW) + (size_t)5632 * 1024, total, D, FF, E, ism + 16, MOEW_E * 2, bid, nb); } SEAM(19);
    if (IN(20)) { ph_final(p, bid, nb); }
#undef IN
#undef SEAM
}

extern "C" void kernel_launch(void* const* d_in, const int* in_sizes, int n_in, void* d_out, int out_size, void* d_ws, size_t ws_size, hipStream_t stream) {
    static int grid = 0;
    if (grid == 0) {
        if (n_in != 32 || out_size != SEQ * D || ws_size < WS_END) { fprintf(stderr, "kernel_launch: unexpected problem (n_in %d out %d ws %zu)\n", n_in, out_size, ws_size); grid = -1; return; }
        int dev = 0, cus = 0;
        if (hipGetDevice(&dev) != hipSuccess || hipDeviceGetAttribute(&cus, hipDeviceAttributeMultiprocessorCount, dev) != hipSuccess) { grid = -1; return; }
        if (hipFuncSetAttribute((const void*)k_run, hipFuncAttributeMaxDynamicSharedMemorySize, LDS_BYTES) != hipSuccess) { fprintf(stderr, "kernel_launch: LDS attribute failed\n"); grid = -1; return; }
        int per_cu = 0; (void)hipOccupancyMaxActiveBlocksPerMultiprocessor(&per_cu, (const void*)k_run, NT, LDS_BYTES); (void)hipGetLastError();
        grid = cus > 0 ? cus : 256;
    }
    if (grid < 0) return;
    (void)hipMemsetAsync((char*)d_ws + WS_CTL, 0, CTL_BYTES, stream);
    Params p; memset(&p, 0, sizeof(p));
    for (int i = 0; i < 32; ++i) p.in[i] = (const float*)d_in[i];
    p.out = (float*)d_out; p.ws = (unsigned char*)d_ws;
#if N_LAUNCH_MODE == 1
    p.ph_lo = 0; p.ph_hi = NPHASE;
    hipLaunchKernelGGL(k_run, dim3(grid), dim3(NT), LDS_BYTES, stream, p);
#else
    for (int ph = 0; ph < NPHASE; ++ph) { p.ph_lo = ph; p.ph_hi = ph + 1; hipLaunchKernelGGL(k_run, dim3(grid), dim3(NT), LDS_BYTES, stream, p); }
#endif
}
```

```cpp
#include <hip/hip_runtime.h>
#include <cstdio>
#include <cstdint>
#include <cstring>

typedef unsigned short bf16;
typedef unsigned u32x4 __attribute__((ext_vector_type(4)));
typedef unsigned u32x2 __attribute__((ext_vector_type(2)));
typedef float f32x4 __attribute__((ext_vector_type(4)));
typedef float f32x2 __attribute__((ext_vector_type(2)));

#ifndef N_LAUNCH_MODE
#define N_LAUNCH_MODE 1
#endif

constexpr int D = 1024, SEQ = 16384, CTXL = 256, R = SEQ + CTXL;
constexpr int INC = 2560, FF = 2816, NE = 8;
constexpr int C_HX0 = 0, C_HX1 = 256, C_HV = 512, C_RQ = 768, C_RK = 1024, C_RV = 1280, C_RG = 1536, C_AQ = 1792, C_AK = 2304, C_AV = 2432;
constexpr int FN = 32768, FM = 16384;
constexpr int NCH = 130;
constexpr float EPS = 1e-6f;
constexpr float C2 = 0.125f * 1.4426950408889634f;
constexpr int NT = 512;
constexpr int MOE_MAXROWS = 34560;

constexpr size_t MiB = 1u << 20;
constexpr size_t WS_CTL = 0, CTL_BYTES = MiB;
constexpr size_t WS_MOD = 1 * MiB;
constexpr size_t WS_TW = 1 * MiB + 128 * 1024;
constexpr size_t WS_TWN = 1 * MiB + 256 * 1024;
constexpr size_t WS_XC = 2 * MiB;
constexpr size_t WS_ASGT = 3 * MiB;
constexpr size_t WS_ASGG = 3 * MiB + 512 * 1024;
constexpr size_t WS_ROWD = 4 * MiB;
constexpr size_t WS_ROWG = 4 * MiB + 256 * 1024;
constexpr size_t WS_TAPSC = 5 * MiB;
constexpr size_t WS_ZC = 5 * MiB + 512 * 1024;
constexpr size_t WS_HSPEC = 8 * MiB;
constexpr size_t WS_ZT = 72 * MiB;
constexpr size_t WS_RU = 88 * MiB;
constexpr size_t WS_WIN = 105 * MiB;
constexpr size_t WS_WOUT = 115 * MiB;
constexpr size_t WS_WGU = 119 * MiB;
constexpr size_t WS_WDN = 130 * MiB;
constexpr size_t WS_H = 136 * MiB;
constexpr size_t WS_P = 169 * MiB;
constexpr size_t WS_YMIX = 251 * MiB;
constexpr size_t WS_HID = 169 * MiB;
constexpr size_t WS_MOEW = 306 * MiB;
constexpr size_t WS_H2 = 8 * MiB;
constexpr size_t WS_ROWS16 = 4 * MiB + 512 * 1024;
constexpr size_t WS_Y2 = 8 * MiB;
constexpr size_t WS_HIDM = 105 * MiB;
constexpr size_t WS_END = 438 * MiB;
constexpr size_t MOEW_E = (size_t)(5632 * 1024 + 1024 * 2816);
static_assert(WS_HIDM + (size_t)MOE_MAXROWS * FF * 2 <= WS_MOEW, "map");
static_assert(WS_H2 + (size_t)(SEQ + 1) * D * 2 <= WS_HIDM, "map");
static_assert(WS_MOEW + 8 * MOEW_E * 2 <= WS_END, "map");

constexpr int CW_CNT = 64;
constexpr int CW_BAR = 4096;

struct Params { const float* in[32]; float* out; unsigned char* ws; int ph_lo, ph_hi; };

__device__ __forceinline__ float bf2f(bf16 v) { return __uint_as_float((unsigned)v << 16); }
__device__ __forceinline__ unsigned pk2(float lo, float hi) { unsigned r; asm("v_cvt_pk_bf16_f32 %0, %1, %2" : "=v"(r) : "v"(lo), "v"(hi)); return r; }
__device__ __forceinline__ unsigned f2bf(float f) { return pk2(f, f) & 0xffffu; }
__device__ __forceinline__ float lo16(unsigned w) { return __uint_as_float(w << 16); }
__device__ __forceinline__ float hi16(unsigned w) { return __uint_as_float(w & 0xffff0000u); }
__device__ __forceinline__ float wave_sum(float v) {
#pragma unroll
    for (int o = 1; o < 64; o <<= 1) v += __shfl_xor(v, o);
    return v;
}
__device__ __forceinline__ float silu_f(float x) { return x * __builtin_amdgcn_rcpf(1.f + __expf(-x)); }
__device__ __forceinline__ const float* xrow_f32(const Params& p, int xmode, int row) {
    if (xmode == 0) return row < SEQ ? p.in[0] + (size_t)row * D : p.in[2] + (size_t)(row - SEQ) * D;
    return row < SEQ ? p.out + (size_t)row * D : (const float*)(p.ws + WS_XC) + (size_t)(row - SEQ) * D;
}
__device__ __forceinline__ bf16* xb_row(const Params& p, int xmode, int row) { return (bf16*)(p.ws + (xmode == 3 ? WS_ZT : WS_HSPEC)) + (size_t)row * D; }
__device__ __forceinline__ const float* mod_vec(const Params& p, int l, int row, int j) {
    return (const float*)(p.ws + WS_MOD) + (size_t)((l * 2 + (row >= SEQ ? 1 : 0)) * 6 + j) * D;
}

__device__ __forceinline__ void ph_mod(const Params& p, float* sm, int bid, int nb) {
    const float* c = p.in[1]; const float* cc = p.in[3]; const float* W = p.in[4]; const float* B = p.in[5];
    float* MOD = (float*)(p.ws + WS_MOD);
    float* sc = sm; float* scc = sm + 1024; float* red = sm + 2048;
    const int tid = threadIdx.x;
    for (int i = tid; i < 1024; i += NT) { sc[i] = silu_f(c[i]); scc[i] = silu_f(cc[i]); }
    __syncthreads();
    for (int it = bid; it < 192; it += nb) {
        const int l = it / 96, cl = tid & 63, col = (it % 96) * 64 + cl, kg = tid >> 6;
        const float* w = W + (size_t)l * 1024 * 6144 + col;
        float a0 = 0.f, a1 = 0.f;
#pragma unroll 8
        for (int k = kg * 128; k < kg * 128 + 128; ++k) { const float wv = w[(size_t)k * 6144]; a0 += sc[k] * wv; a1 += scc[k] * wv; }
        red[(kg * 64 + cl) * 2] = a0; red[(kg * 64 + cl) * 2 + 1] = a1;
        __syncthreads();
        if (tid < 128) { const int c2 = tid & 63, s = tid >> 6; float sum = 0.f;
            for (int g = 0; g < 8; ++g) sum += red[(g * 64 + c2) * 2 + s];
            const int colg = (it % 96) * 64 + c2; MOD[(size_t)(l * 2 + s) * 6144 + colg] = sum + B[l * 6144 + colg]; }
        __syncthreads();
    }
}
__device__ __forceinline__ void ph_tw(const Params& p, int bid, int nb) {
    f32x2* TW = (f32x2*)(p.ws + WS_TW); f32x2* TWN = (f32x2*)(p.ws + WS_TWN);
    for (int k = bid * NT + threadIdx.x; k <= FM / 2; k += nb * NT) {
        float s, c;
        if (k < FM / 2) { const float x = (float)k * (2.0f / FM); s = sinpif(x); c = cospif(x); TW[k] = (f32x2){c, -s}; }
        { const float x = (float)k * (2.0f / FN); s = sinpif(x); c = cospif(x); TWN[k] = (f32x2){c, -s}; }
    }
}
__device__ __forceinline__ int gu_row(int n, int up) { return (n >> 7) * 256 + (n & 127) + (up ? 128 : 0); }
struct WcItem { const float* W; bf16* WT; int K, N, k0, n0, gu; };
constexpr int WCONV_DENSE = 2 * 160 + 2 * 64 + 3 * 176, WCONV_ALL = WCONV_DENSE + 8 * 3 * 176;
__device__ __forceinline__ WcItem wc_decode(const Params& p, int it) {
    constexpr int I_IN = 8 * 20, I_OUT = 8 * 8, I_GU = 8 * 22, PER_FFN = 3 * I_GU;
    WcItem d; int r = it;
    if (r < 2 * I_IN) { const int l = r / I_IN; r %= I_IN; d.W = p.in[8] + (size_t)l * D * INC; d.WT = (bf16*)(p.ws + WS_WIN) + (size_t)l * INC * D; d.K = D; d.N = INC; d.k0 = (r / 20) * 128; d.n0 = (r % 20) * 128; d.gu = -1; return d; }
    r -= 2 * I_IN;
    if (r < 2 * I_OUT) { const int l = r / I_OUT; r %= I_OUT; d.W = p.in[9] + (size_t)l * D * D; d.WT = (bf16*)(p.ws + WS_WOUT) + (size_t)l * D * D; d.K = D; d.N = D; d.k0 = (r / 8) * 128; d.n0 = (r % 8) * 128; d.gu = -1; return d; }
    r -= 2 * I_OUT;
    const int f = r / PER_FFN; r %= PER_FFN; const int which = r / I_GU; r %= I_GU;
    bf16* dgu; bf16* ddn;
    if (f == 0) { d.W = p.in[23 + which]; dgu = (bf16*)(p.ws + WS_WGU); ddn = (bf16*)(p.ws + WS_WDN); }
    else { d.W = p.in[28 + which] + (size_t)(f - 1) * D * FF; dgu = (bf16*)(p.ws + WS_MOEW) + (size_t)(f - 1) * MOEW_E; ddn = dgu + (size_t)5632 * 1024; }
    if (which < 2) { d.WT = dgu; d.K = D; d.N = FF; d.k0 = (r / 22) * 128; d.n0 = (r % 22) * 128; d.gu = which; }
    else { d.WT = ddn; d.K = FF; d.N = D; d.k0 = (r / 8) * 128; d.n0 = (r % 8) * 128; d.gu = -1; }
    return d;
}
__device__ __forceinline__ void ph_wconv(const Params& p, float* sm, int it_lo, int it_hi, int bid, int nb) {
    const int tid = threadIdx.x, lane = tid & 63, wave = tid >> 6;
    for (int it = it_lo + bid; it < it_hi; it += nb) {
        const WcItem d = wc_decode(p, it);
        float tv[32];
#pragma unroll
        for (int i = 0; i < 16; ++i)
#pragma unroll
            for (int j = 0; j < 2; ++j) tv[i * 2 + j] = d.W[(size_t)(d.k0 + wave * 16 + i) * d.N + d.n0 + lane + 64 * j];
#pragma unroll
        for (int i = 0; i < 16; ++i)
#pragma unroll
            for (int j = 0; j < 2; ++j) sm[(wave * 16 + i) * 129 + lane + 64 * j] = tv[i * 2 + j];
        __syncthreads();
        const int c = tid & 15;
#pragma unroll
        for (int j = 0; j < 4; ++j) { const int n = (tid >> 4) + 32 * j; const float* sp = sm + (8 * c) * 129 + n;
            const u32x4 o = (u32x4){pk2(sp[0 * 129], sp[1 * 129]), pk2(sp[2 * 129], sp[3 * 129]), pk2(sp[4 * 129], sp[5 * 129]), pk2(sp[6 * 129], sp[7 * 129])};
            const int dr = (d.gu < 0) ? (d.n0 + n) : gu_row(d.n0 + n, d.gu);
            *(u32x4*)(d.WT + (size_t)dr * d.K + d.k0 + 8 * c) = o; }
        __syncthreads();
    }
}
__device__ __forceinline__ void wconv_in_tail(const Params& p, float* sm, int nwg, int it_lo, int it_hi, int bid, int nb) {
    const int rounds = (nwg + nb - 1) / nb, busy_last = nwg - (rounds - 1) * nb;
    if (busy_last >= nb) { ph_wconv(p, sm, it_lo, it_hi, bid, nb); return; }
    if (bid >= busy_last) ph_wconv(p, sm, it_lo, it_hi, bid - busy_last, nb - busy_last);
}
typedef float f32x16_f __attribute__((ext_vector_type(16)));
__device__ __forceinline__ void ph_filt(const Params& p, float* sm, int bid, int nb) {
    const float dlo = -4.605170185988091f / 1.5f, dhi = -4.605170185988091f / 0.3f;
    float* featL = sm; float* h1L = sm + 32 * 37; float* h2L = h1L + 32 * 65; float* tile = h2L + 32 * 65;
    const int tid = threadIdx.x, lane = tid & 63, wave = tid >> 6, r = lane & 31, hh = lane >> 5;
    for (int it = bid; it < 264; it += nb) {
        int which, n_base, nsub;
        if (it < 256) { which = it >> 7; n_base = (it & 127) * 128; nsub = 4; } else { which = 2; n_base = (it - 256) * 32; nsub = 1; }
        const int l = (which == 2) ? 0 : which; const int Lf = (which == 2) ? CTXL : SEQ; const int NN = 2 * Lf;
        float* taps = (which == 2) ? (float*)(p.ws + WS_TAPSC) : (float*)(p.ws + WS_HSPEC) + (size_t)which * 256 * FN;
        const int cstride = (which == 2) ? NN : 2 * NN;
        const float* w1 = p.in[12] + l * 33 * 64; const float* w2 = p.in[14] + l * 4096; const float* w3 = p.in[16] + l * 64 * 512;
        const int t12 = wave & 1;
        float w3b[1][32];
        float* w1L = tile + 32 * 513; float* w2L = w1L + 34 * 64;
        for (int i = tid; i < 34 * 64; i += NT) w1L[i] = (i < 33 * 64) ? w1[i] : 0.f;
        for (int i = tid; i < 64 * 64; i += NT) w2L[i] = w2[i];
#pragma unroll
        for (int ks = 0; ks < 32; ++ks) w3b[0][ks] = w3[(2 * ks + hh) * 512 + wave * 64 + r];
        const float b1c = p.in[13][l * 64 + 32 * t12 + r], b2c = p.in[15][l * 64 + 32 * t12 + r];
        const float b3a = p.in[17][l * 512 + wave * 64 + r], b3b = p.in[17][l * 512 + wave * 64 + 32 + r];
        const float* frq = p.in[18] + l * 64;
        const float invL1 = 1.f / (float)(Lf - 1);
#pragma unroll 1
        for (int sc = 0; sc < nsub; ++sc) {
            const int n0 = n_base + sc * 32;
            {
                const int pos = tid >> 4, b = tid & 15, n = n0 + pos; const float band = 1e-4f + (float)b * ((15.f - 1e-4f) / 15.f);
                const float rev2 = (2.0f / (float)Lf) * (float)n * band;
                featL[pos * 37 + 1 + b] = cospif(rev2); featL[pos * 37 + 17 + b] = -sinpif(rev2);
                if (b == 0) { featL[pos * 37] = (float)n * invL1; featL[pos * 37 + 33] = 0.f; }
            }
            __syncthreads();
            if (wave < 2) {
                f32x16_f acc;
#pragma unroll
                for (int g = 0; g < 16; ++g) acc[g] = b1c;
#pragma unroll
                for (int ks = 0; ks < 17; ++ks) { const int k = 2 * ks + hh;
                    acc = __builtin_amdgcn_mfma_f32_32x32x2f32(featL[r * 37 + k], w1L[k * 64 + 32 * t12 + r], acc, 0, 0, 0); }
#pragma unroll
                for (int g = 0; g < 16; ++g) h1L[((g & 3) + 8 * (g >> 2) + 4 * hh) * 65 + 32 * t12 + r] = acc[g];
            }
            __syncthreads();
            for (int e = tid; e < 32 * 64; e += NT) { const int pos = e >> 6, j = e & 63; h1L[pos * 65 + j] = sinpif(frq[j] * 0.3183098861837907f * h1L[pos * 65 + j]); }
            __syncthreads();
            if (wave < 2) {
                f32x16_f acc;
#pragma unroll
                for (int g = 0; g < 16; ++g) acc[g] = b2c;
#pragma unroll
                for (int ks = 0; ks < 32; ++ks) acc = __builtin_amdgcn_mfma_f32_32x32x2f32(h1L[r * 65 + 2 * ks + hh], w2L[(2 * ks + hh) * 64 + 32 * t12 + r], acc, 0, 0, 0);
#pragma unroll
                for (int g = 0; g < 16; ++g) h2L[((g & 3) + 8 * (g >> 2) + 4 * hh) * 65 + 32 * t12 + r] = acc[g];
            }
            __syncthreads();
            for (int e = tid; e < 32 * 64; e += NT) { const int pos = e >> 6, j = e & 63; h2L[pos * 65 + j] = sinpif(frq[j] * 0.3183098861837907f * h2L[pos * 65 + j]); }
            __syncthreads();
            {
                f32x16_f acc;
#pragma unroll
                for (int g = 0; g < 16; ++g) acc[g] = b3a;
#pragma unroll
                for (int ks = 0; ks < 32; ++ks) acc = __builtin_amdgcn_mfma_f32_32x32x2f32(h2L[r * 65 + 2 * ks + hh], w3b[0][ks], acc, 0, 0, 0);
#pragma unroll
                for (int g = 0; g < 16; ++g) tile[((g & 3) + 8 * (g >> 2) + 4 * hh) * 513 + wave * 64 + r] = acc[g];
                asm volatile("" ::: "memory");
#pragma unroll
                for (int g = 0; g < 16; ++g) acc[g] = b3b;
#pragma unroll 8
                for (int ks = 0; ks < 32; ++ks) acc = __builtin_amdgcn_mfma_f32_32x32x2f32(h2L[r * 65 + 2 * ks + hh], w3[(2 * ks + hh) * 512 + wave * 64 + 32 + r], acc, 0, 0, 0);
#pragma unroll
                for (int g = 0; g < 16; ++g) tile[((g & 3) + 8 * (g >> 2) + 4 * hh) * 513 + wave * 64 + 32 + r] = acc[g];
            }
            __syncthreads();
            {
                const int pos = tid & 31, jg = tid >> 5, n = n0 + pos; const float t = (float)n * invL1;
#pragma unroll 4
                for (int jj = 0; jj < 32; ++jj) { const int j = jg * 32 + jj, dir = j >> 8, ch = j & 255;
                    const float delta = fabsf(dlo + (float)ch * ((dhi - dlo) / 255.f));
                    const float v = tile[pos * 513 + j] * __expf(-t * delta);
                    bf16* tb = (bf16*)taps + (size_t)ch * cstride; const bf16 vb = (bf16)f2bf(v);
                    if (dir == 0) tb[n] = vb; else { if (n >= 1) tb[NN - n] = vb; else tb[Lf] = 0; } }
            }
        }
        __syncthreads();
    }
}

__device__ __forceinline__ int brev14(int k) { return (int)(__brev((unsigned)k) >> 18); }
__device__ __forceinline__ int fphys(int i) { return i + (i >> 5) + (i >> 8); }
constexpr int FBUF = FM + FM / 32 + FM / 256;
constexpr float R32C[16] = {1.000000000f, 0.980785280f, 0.923879533f, 0.831469612f, 0.707106781f, 0.555570233f, 0.382683432f, 0.195090322f, 0.000000000f, -0.195090322f, -0.382683432f, -0.555570233f, -0.707106781f, -0.831469612f, -0.923879533f, -0.980785280f};
constexpr float R32S[16] = {0.000000000f, 0.195090322f, 0.382683432f, 0.555570233f, 0.707106781f, 0.831469612f, 0.923879533f, 0.980785280f, 1.000000000f, 0.980785280f, 0.923879533f, 0.831469612f, 0.707106781f, 0.555570233f, 0.382683432f, 0.195090322f};
__device__ __forceinline__ f32x2 cmul(f32x2 a, f32x2 b) { return (f32x2){a.x * b.x - a.y * b.y, a.x * b.y + a.y * b.x}; }
__device__ __forceinline__ f32x2 cmulc(f32x2 a, f32x2 b) { return (f32x2){a.x * b.x + a.y * b.y, a.y * b.x - a.x * b.y}; }
template <int NP, bool HAS_T> __device__ __forceinline__ void reg_dif(f32x2 (&x)[NP], const f32x2* Th) {
    constexpr int L = (NP == 32) ? 5 : 4;
#pragma unroll
    for (int s2 = 0; s2 < L; ++s2) { const int hl = NP >> (s2 + 1), lh = L - 1 - s2;
#pragma unroll
        for (int a = 0; a < NP; ++a) { if (a & hl) continue; const int q = a & (hl - 1), m = q * (16 / hl);
            const f32x2 u = x[a], v = x[a + hl]; x[a] = u + v; f32x2 d = u - v;
            if (HAS_T) d = cmul(d, cmul((f32x2){R32C[m], -R32S[m]}, Th[lh]));
            else if (q != 0) d = cmul(d, (f32x2){R32C[m], -R32S[m]});
            x[a + hl] = d; } }
}
template <int NP, bool HAS_T> __device__ __forceinline__ void reg_dit(f32x2 (&x)[NP], const f32x2* Th) {
    constexpr int L = (NP == 32) ? 5 : 4;
#pragma unroll
    for (int s2 = 0; s2 < L; ++s2) { const int hl = 1 << s2;
#pragma unroll
        for (int a = 0; a < NP; ++a) { if (a & hl) continue; const int q = a & (hl - 1), m = q * (16 / hl);
            const f32x2 u = x[a]; f32x2 v = x[a + hl];
            if (HAS_T) v = cmulc(v, cmul((f32x2){R32C[m], -R32S[m]}, Th[s2]));
            else if (q != 0) v = cmulc(v, (f32x2){R32C[m], -R32S[m]});
            x[a] = u + v; x[a + hl] = u - v; } }
}
__device__ __forceinline__ void fft_dif(f32x2* buf, const f32x2* TW) {
    const int tid = threadIdx.x;
#pragma unroll 1
    for (int c2 = 0; c2 < 2; ++c2) { const int j = tid + 512 * c2, base = j + (j >> 5) + (j >> 8); f32x2 x[16], Th[4];
#pragma unroll
        for (int lh = 0; lh < 4; ++lh) Th[lh] = TW[(j * 8) >> lh];
#pragma unroll
        for (int a = 0; a < 16; ++a) x[a] = buf[a * 1060 + base];
        reg_dif<16, true>(x, Th);
#pragma unroll
        for (int a = 0; a < 16; ++a) buf[a * 1060 + base] = x[a]; }
    __syncthreads();
    { const int g = tid >> 5, jp = tid & 31, base = g * 1060 + jp; f32x2 x[32], Th[5];
#pragma unroll
        for (int lh = 0; lh < 5; ++lh) Th[lh] = TW[(jp * 256) >> lh];
#pragma unroll
        for (int a = 0; a < 32; ++a) x[a] = buf[base + a * 33 + (a >> 3)];
        reg_dif<32, true>(x, Th);
#pragma unroll
        for (int a = 0; a < 32; ++a) buf[base + a * 33 + (a >> 3)] = x[a]; }
    __syncthreads();
    { const int base = tid * 33 + (tid >> 3); f32x2 x[32];
#pragma unroll
        for (int a = 0; a < 32; ++a) x[a] = buf[base + a];
        reg_dif<32, false>(x, nullptr);
#pragma unroll
        for (int a = 0; a < 32; ++a) buf[base + a] = x[a]; }
    __syncthreads();
}
__device__ __forceinline__ void fft_dit_inv(f32x2* buf, const f32x2* TW) {
    const int tid = threadIdx.x;
    { const int base = tid * 33 + (tid >> 3); f32x2 x[32];
#pragma unroll
        for (int a = 0; a < 32; ++a) x[a] = buf[base + a];
        reg_dit<32, false>(x, nullptr);
#pragma unroll
        for (int a = 0; a < 32; ++a) buf[base + a] = x[a]; }
    __syncthreads();
    { const int g = tid >> 5, jp = tid & 31, base = g * 1060 + jp; f32x2 x[32], Th[5];
#pragma unroll
        for (int lh = 0; lh < 5; ++lh) Th[lh] = TW[(jp * 256) >> lh];
#pragma unroll
        for (int a = 0; a < 32; ++a) x[a] = buf[base + a * 33 + (a >> 3)];
        reg_dit<32, true>(x, Th);
#pragma unroll
        for (int a = 0; a < 32; ++a) buf[base + a * 33 + (a >> 3)] = x[a]; }
    __syncthreads();
#pragma unroll 1
    for (int c2 = 0; c2 < 2; ++c2) { const int j = tid + 512 * c2, base = j + (j >> 5) + (j >> 8); f32x2 x[16], Th[4];
#pragma unroll
        for (int lh = 0; lh < 4; ++lh) Th[lh] = TW[(j * 8) >> lh];
#pragma unroll
        for (int a = 0; a < 16; ++a) x[a] = buf[a * 1060 + base];
        reg_dit<16, true>(x, Th);
#pragma unroll
        for (int a = 0; a < 16; ++a) buf[a * 1060 + base] = x[a]; }
    __syncthreads();
}
__device__ __forceinline__ void ph_hfft(const Params& p, float* sm, float* red, int bid, int nb) {
    f32x2* buf = (f32x2*)sm;
    const f32x2* TW = (const f32x2*)(p.ws + WS_TW); const f32x2* TWN = (const f32x2*)(p.ws + WS_TWN);
    const int tid = threadIdx.x;
    for (int u = bid; u < 512; u += nb) {
        unsigned* g = (unsigned*)((float*)(p.ws + WS_HSPEC) + (size_t)u * FN);
        float asum = 0.f;
#pragma unroll 8
        for (int n = tid; n < FM; n += NT) { const unsigned w = g[n]; const f32x2 v = (f32x2){lo16(w), hi16(w)}; buf[fphys(n)] = v; asum += fabsf(v.x) + fabsf(v.y); }
        asum = wave_sum(asum);
        if ((tid & 63) == 0) red[tid >> 6] = asum;
        __syncthreads();
        float tot = 0.f;
#pragma unroll
        for (int w = 0; w < 8; ++w) tot += red[w];
        const float sc = 0.5f / (tot + EPS);
        fft_dif(buf, TW);
#pragma unroll 4
        for (int k = tid; k <= FM / 2; k += NT) {
            if (k == 0) { const f32x2 a = buf[0]; g[0] = pk2((a.x + a.y) * 2.f * sc, (a.x - a.y) * 2.f * sc); continue; }
            const int kk = FM - k; const f32x2 a = buf[fphys(brev14(k))], b = buf[fphys(brev14(kk))], w = TWN[k];
            const f32x2 E = (f32x2){a.x + b.x, a.y - b.y}, O = (f32x2){a.y + b.y, b.x - a.x};
            const f32x2 T = (f32x2){w.x * O.x - w.y * O.y, w.x * O.y + w.y * O.x};
            g[k] = pk2((E.x + T.x) * sc, (E.y + T.y) * sc);
            g[kk] = pk2((E.x - T.x) * sc, -(E.y - T.y) * sc);
        }
        __syncthreads();
    }
}
__device__ __forceinline__ void hconv_unit(const Params& p, int l, int ch, float* sm) {
    f32x2* buf = (f32x2*)sm;
    const f32x2* TW = (const f32x2*)(p.ws + WS_TW); const f32x2* TWN = (const f32x2*)(p.ws + WS_TWN);
    const unsigned* H = (const unsigned*)((const float*)(p.ws + WS_HSPEC) + (size_t)(l * 256 + ch) * FN);
    f32x2* z = (f32x2*)((float*)(p.ws + WS_ZT) + (size_t)ch * SEQ);
    const int tid = threadIdx.x;
#pragma unroll 8
    for (int n = tid; n < FM; n += NT) buf[fphys(n)] = (n < SEQ / 2) ? z[n] : (f32x2){0.f, 0.f};
    __syncthreads();
    fft_dif(buf, TW);
#pragma unroll 8
    for (int k = tid; k <= FM / 2; k += NT) {
        if (k == 0) { const f32x2 a = buf[0]; const unsigned hw = H[0]; const f32x2 h = (f32x2){lo16(hw), hi16(hw)}; const float y0 = (a.x + a.y) * h.x, ym = (a.x - a.y) * h.y; buf[0] = (f32x2){0.5f * (y0 + ym), 0.5f * (y0 - ym)}; continue; }
        const int kk = FM - k, rk = fphys(brev14(k)), rkk = fphys(brev14(kk));
        const unsigned hw0 = H[k], hw1 = H[kk]; const f32x2 a = buf[rk], b = buf[rkk], w = TWN[k], hk = (f32x2){lo16(hw0), hi16(hw0)}, hkk = (f32x2){lo16(hw1), hi16(hw1)};
        const f32x2 E = (f32x2){0.5f * (a.x + b.x), 0.5f * (a.y - b.y)}, O = (f32x2){0.5f * (a.y + b.y), 0.5f * (b.x - a.x)};
        const f32x2 T = (f32x2){w.x * O.x - w.y * O.y, w.x * O.y + w.y * O.x};
        const f32x2 Xk = E + T, Xkk = (f32x2){E.x - T.x, -(E.y - T.y)};
        const f32x2 Yk = (f32x2){Xk.x * hk.x - Xk.y * hk.y, Xk.x * hk.y + Xk.y * hk.x};
        const f32x2 Ykk = (f32x2){Xkk.x * hkk.x - Xkk.y * hkk.y, Xkk.x * hkk.y + Xkk.y * hkk.x};
        const f32x2 Ey = (f32x2){0.5f * (Yk.x + Ykk.x), 0.5f * (Yk.y - Ykk.y)};
        const f32x2 Dy = (f32x2){0.5f * (Yk.x - Ykk.x), 0.5f * (Yk.y + Ykk.y)};
        const f32x2 Oy = (f32x2){w.x * Dy.x + w.y * Dy.y, w.x * Dy.y - w.y * Dy.x};
        buf[rk] = (f32x2){Ey.x - Oy.y, Ey.y + Oy.x};
        if (kk != k) buf[rkk] = (f32x2){Ey.x + Oy.y, -(Ey.y - Oy.x)};
    }
    __syncthreads();
    fft_dit_inv(buf, TW);
    const float inv = 1.f / (float)FM;
#pragma unroll 8
    for (int n = tid; n < SEQ / 2; n += NT) { const f32x2 v = buf[fphys(n)]; z[n] = (f32x2){v.x * inv, v.y * inv}; }
    __syncthreads();
}
__device__ __forceinline__ void hconv_ctx_unit(const Params& p, int ch, float* sm) {
    float* zc = (float*)(p.ws + WS_ZC) + ch * CTXL; const bf16* tc = (const bf16*)(p.ws + WS_TAPSC) + ch * 512;
    float* zs = sm; float* ts = sm + 256; float* red = sm + 768;
    const int tid = threadIdx.x;
    if (tid < 256) zs[tid] = zc[tid];
    const float tv = bf2f(tc[tid]); ts[tid] = tv;
    const float a = wave_sum(fabsf(tv)); if ((tid & 63) == 0) red[tid >> 6] = a;
    __syncthreads();
    if (tid < 256) { float tot = 0.f;
#pragma unroll
        for (int w = 0; w < 8; ++w) tot += red[w];
        float acc = 0.f;
        for (int m = 0; m < 256; ++m) { const int lag = tid - m; acc += zs[m] * ts[lag >= 0 ? lag : 512 + lag]; }
        zc[tid] = acc / (tot + EPS); }
    __syncthreads();
}

__device__ __forceinline__ void ph_norm(const Params& p, int l, int which, int xmode, int nrows, bool route, int bid, int nb, float* sm = nullptr, size_t ws_out = WS_H) {
    const int lane = threadIdx.x & 63, wave = threadIdx.x >> 6;
    unsigned* lcnt = (unsigned*)sm; unsigned* lbase = lcnt + 8; int* r_row = (int*)sm + 16; int* r_e = r_row + 2048; int* r_pos = r_e + 4096; float* r_g = (float*)(r_pos + 4096);
    int nloc = 0; const int nloc_max = (nrows + nb * 8 - 1) / (nb * 8);
    float* rwL = sm + 16384;
    if (route) { if (threadIdx.x < 8) lcnt[threadIdx.x] = 0u; for (int i = threadIdx.x; i < 2048; i += NT) r_row[i] = -1;
        const float* rw = p.in[26];
        for (int i = threadIdx.x; i < 8192; i += NT) rwL[(i & 7) * 1024 + (i >> 3)] = rw[i];
        __syncthreads(); }
    const float* g = p.in[which ? 7 : 6] + l * D;
    bf16* H = (bf16*)(p.ws + ws_out);
    const int rstride = nb * 8;
    for (int row0 = bid * 8 + wave; row0 < nrows; row0 += 4 * rstride) {
        f32x4 v[4][4];
#pragma unroll
        for (int k = 0; k < 4; ++k) { const int row = row0 + k * rstride;
            if (row < nrows) {
                if ((xmode & 1) && row < SEQ) { const u32x2* xb = (const u32x2*)xb_row(p, xmode, row) + lane;
#pragma unroll
                    for (int j = 0; j < 4; ++j) { const u32x2 w = xb[64 * j]; v[k][j] = (f32x4){lo16(w.x), hi16(w.x), lo16(w.y), hi16(w.y)}; } }
                else { const f32x4* xr = (const f32x4*)xrow_f32(p, xmode, row) + lane;
#pragma unroll
                    for (int j = 0; j < 4; ++j) v[k][j] = xr[64 * j]; } } }
#pragma unroll
        for (int k = 0; k < 4; ++k) { const int row = row0 + k * rstride;
            if (row >= nrows) break;
            const f32x4* sh = (const f32x4*)mod_vec(p, l, row, which ? 3 : 0) + lane; const f32x4* scv = (const f32x4*)mod_vec(p, l, row, which ? 4 : 1) + lane;
            float ss = 0.f;
#pragma unroll
            for (int j = 0; j < 4; ++j) ss += (v[k][j].x * v[k][j].x + v[k][j].y * v[k][j].y) + (v[k][j].z * v[k][j].z + v[k][j].w * v[k][j].w);
            const float r = rsqrtf(wave_sum(ss) * (1.f / D) + EPS);
            u32x2* o8 = (u32x2*)(H + (size_t)row * D) + lane;
#pragma unroll
            for (int j = 0; j < 4; ++j) { const f32x4 gg = ((const f32x4*)g)[lane + 64 * j], s1 = scv[64 * j], s0 = sh[64 * j];
                v[k][j] = v[k][j] * r * gg * (s1 + 1.f) + s0;
                o8[64 * j] = (u32x2){pk2(v[k][j].x, v[k][j].y), pk2(v[k][j].z, v[k][j].w)}; }
            if (route) {
                const float* rb = p.in[27];
                float lg[8];
#pragma unroll
                for (int e = 0; e < 8; ++e) { float a = 0.f;
#pragma unroll
                    for (int j = 0; j < 4; ++j) { const f32x4 w = *(const f32x4*)(rwL + e * 1024 + 4 * lane + 256 * j); a += (v[k][j].x * w.x + v[k][j].y * w.y) + (v[k][j].z * w.z + v[k][j].w * w.w); }
                    lg[e] = a; }
                {
                    float t4[4], t2[2], t1;
#pragma unroll
                    for (int e = 0; e < 4; ++e) { const float keep = (lane & 4) ? lg[e + 4] : lg[e], send = (lane & 4) ? lg[e] : lg[e + 4]; t4[e] = keep + __shfl_xor(send, 4); }
#pragma unroll
                    for (int e = 0; e < 2; ++e) { const float keep = (lane & 2) ? t4[e + 2] : t4[e], send = (lane & 2) ? t4[e] : t4[e + 2]; t2[e] = keep + __shfl_xor(send, 2); }
                    { const float keep = (lane & 1) ? t2[1] : t2[0], send = (lane & 1) ? t2[0] : t2[1]; t1 = keep + __shfl_xor(send, 1); }
                    t1 += __shfl_xor(t1, 8); t1 += __shfl_xor(t1, 16); t1 += __shfl_xor(t1, 32);
#pragma unroll
                    for (int e = 0; e < 8; ++e) lg[e] = __shfl(t1, e) + rb[e];
                }
                int i1 = 0; float v1 = lg[0];
#pragma unroll
                for (int e = 1; e < 8; ++e) if (lg[e] > v1) { v1 = lg[e]; i1 = e; }
                int i2 = -1; float v2 = -3.0e38f;
#pragma unroll
                for (int e = 0; e < 8; ++e) if (e != i1 && lg[e] > v2) { v2 = lg[e]; i2 = e; }
                if (i2 < 0) { i2 = (i1 + 1) & 7; v2 = v1; }
                const float ex = __expf(v2 - v1), g1 = 1.f / (1.f + ex), g2 = ex * g1;
                if (lane == 0 && nloc < 256) {
                    const int sl = nloc * 8 + wave;
                    r_e[2 * sl] = i1; r_e[2 * sl + 1] = i2; r_g[2 * sl] = g1; r_g[2 * sl + 1] = g2; r_row[sl] = row;
                    r_pos[2 * sl] = (int)atomicAdd(&lcnt[i1], 1u); r_pos[2 * sl + 1] = (int)atomicAdd(&lcnt[i2], 1u);
                }
                ++nloc;
            }
        }
    }
    if (route) {
        __syncthreads();
        if (threadIdx.x < 8) lbase[threadIdx.x] = atomicAdd((unsigned*)(p.ws + WS_CTL) + CW_CNT + threadIdx.x, lcnt[threadIdx.x]);
        __syncthreads();
        int* at = (int*)(p.ws + WS_ASGT); float* ag = (float*)(p.ws + WS_ASGG);
        const int nslot = nloc_max * 8;
        for (int a2 = threadIdx.x; a2 < nslot * 2; a2 += NT) { const int sl = a2 >> 1, k = a2 & 1; const int row = r_row[sl];
            if (row >= 0) { const int e = r_e[a2]; const unsigned pos = lbase[e] + (unsigned)r_pos[a2]; at[e * SEQ + pos] = row * 2 + k; ag[e * SEQ + pos] = r_g[a2]; } }
        __syncthreads();
    }
}

namespace pg8 {
#define PG8_LAS __attribute__((address_space(3)))
typedef unsigned short bf16_t;
typedef short bf16x8 __attribute__((ext_vector_type(8)));
typedef float f32x4 __attribute__((ext_vector_type(4)));
typedef unsigned u32x4 __attribute__((ext_vector_type(4)));
constexpr int BM = 256, BK = 64, HALF = 128, HTB = HALF * BK * 2  , STAGE_BYTES = 8 * HTB, NXCD = 8, WGM = 8;

__host__ __device__ __forceinline__ int lds_byte(int r, int c) { const int st = (r >> 4) * 2 + (c >> 5), rr = r & 15, cc = c & 31, ob = rr * 64 + cc * 2; return st * 1024 + (ob ^ (((ob >> 9) & 1) << 5)); }
__host__ __device__ __forceinline__ void stage_rc(int b, int& R, int& C) { const int st = b / 1024, sb = b % 1024, swz = sb ^ (((sb >> 9) & 1) << 5); R = (st >> 1) * 16 + swz / 64; C = (st & 1) * 32 + (swz % 64) / 2; }
__host__ __device__ __forceinline__ int perm32(int rho) { const int n = rho >> 4, i = rho & 15; return 8 * (i >> 2) + 4 * n + (i & 3); }

struct Unit { int pm, pn, idx; };
struct Gemm { const bf16_t* A; const bf16_t* Bt; int M, N, K; };

struct StaticOrder {
    int nM, nN, nwg, G, c; const int* tile_e = nullptr; size_t estride = 0;
    __host__ __device__ void init(int M, int N, int G_, int c_) { nM = M / BM; nN = N / BM; nwg = nM * nN; G = G_; c = c_; }
    __host__ __device__ bool next(int i, Unit& u) const {
        const long L = (long)i * G + c; if (L >= nwg) return false;
        int wgid = (int)L; { const int q = nwg / NXCD, r = nwg % NXCD, xcd = wgid % NXCD, off = wgid / NXCD; wgid = (xcd < r ? xcd * (q + 1) : r * (q + 1) + (xcd - r) * q) + off; }
        const int nig = WGM * nN, gid = wgid / nig, fm = gid * WGM, gsz = (nM - fm) < WGM ? (nM - fm) : WGM;
        u.pm = fm + ((wgid % nig) % gsz); u.pn = (wgid % nig) / gsz; u.idx = i; return true;
    }
    __device__ __forceinline__ size_t b_extra(const Unit& u) const { return tile_e ? (size_t)tile_e[2 * u.pm] * estride : (size_t)0; }
    __device__ __forceinline__ void a_ready(const Unit&) const {}
    __device__ __forceinline__ void done(const Unit&) const {}
};

__device__ __forceinline__ unsigned cvt_pk_bf16(float lo, float hi) { unsigned r; asm volatile("v_cvt_pk_bf16_f32 %0, %1, %2" : "=v"(r) : "v"(lo), "v"(hi)); return r; }
template <class Epi, class Sched, bool ALIGN_EPI = false, bool SP2 = false, bool GATHER = false>
__device__ __forceinline__ void gemm_phase(PG8_LAS unsigned char* lds, const Gemm g, const Sched& S, const Epi& E, const PG8_LAS unsigned short* grows = nullptr) {
    static_assert(!GATHER || SP2, "GATHER is wired into the SP2 loop only");
    const int tid = threadIdx.x, wid = __builtin_amdgcn_readfirstlane(tid >> 6), lane = tid & 63, wr = wid >> 2, wc = wid & 3, fr = lane & 15, fq = lane >> 4;
    const int K = g.K, nt = K / BK;
    unsigned voffA[2], voffB[2]; int Rl[2], Cl[2];
#pragma unroll
    for (int i = 0; i < 2; ++i) { int R, C; stage_rc(tid * 16 + i * 8192, R, C); const int Rb = Epi::PERM ? ((R & ~31) + perm32(R & 31)) : R; Rl[i] = R; Cl[i] = C;
        voffA[i] = (unsigned)(R * K + C) * 2u; voffB[i] = (unsigned)(Rb * K + C) * 2u; }
    unsigned gc[2][2] = {{0u, 0u}, {0u, 0u}}, gn[2][2] = {{0u, 0u}, {0u, 0u}};
#define PG8_GOFF(dst, ui_) do { _Pragma("unroll") for (int _h = 0; _h < 2; ++_h) _Pragma("unroll") for (int _i = 0; _i < 2; ++_i) \
        dst[_h][_i] = (unsigned)grows[(ui_) * 256 + _h * HALF + Rl[_i]] * (unsigned)(K * 2) + (unsigned)Cl[_i] * 2u; } while (0)
    const size_t kstep = (size_t)(BK * 2);
    const size_t hstep = (size_t)HALF * K * 2;
    const size_t tstep = 2 * hstep;
    const unsigned ldsw = (unsigned)wid * 1024u;
    const int aoff = lds_byte(wr * 64 + fr, fq * 8), boff = lds_byte(wc * 32 + fr, fq * 8);
#define PG8_SA(b, h) (((b) * 2 + (h)) * HTB)
#define PG8_SB(b, h) ((4 + (b) * 2 + (h)) * HTB)
#define PG8_STAGE(bufoff, gbase, voff) do { _Pragma("unroll") for (int _i = 0; _i < 2; ++_i) \
        __builtin_amdgcn_global_load_lds((const unsigned*)((const char*)(gbase) + (voff)[_i]), (PG8_LAS unsigned*)(lds + (bufoff) + ldsw + _i * 8192), 16, 0, 0); } while (0)
#define PG8_STAGE_A(bufoff, ptr, half, nextsel) do { if constexpr (GATHER) { if (nextsel) PG8_STAGE(bufoff, ptr, gn[half]); else PG8_STAGE(bufoff, ptr, gc[half]); } \
        else PG8_STAGE(bufoff, (ptr) + (size_t)(half) * hstep, voffA); } while (0)
#define PG8_LDA(dst, b, h) do { _Pragma("unroll") for (int m = 0; m < 4; ++m) _Pragma("unroll") for (int k = 0; k < 2; ++k) dst[m][k] = *(const PG8_LAS bf16x8*)(lds + PG8_SA(b, h) + aoff + m * 2048 + k * 1024); } while (0)
#define PG8_LDB(dst, b, h) do { _Pragma("unroll") for (int n = 0; n < 2; ++n) _Pragma("unroll") for (int k = 0; k < 2; ++k) dst[n][k] = *(const PG8_LAS bf16x8*)(lds + PG8_SB(b, h) + boff + n * 2048 + k * 1024); } while (0)
#define PG8_MMA(ai, bj, At, Bt) do { __builtin_amdgcn_s_setprio(1); _Pragma("unroll") for (int m = 0; m < 4; ++m) _Pragma("unroll") for (int n = 0; n < 2; ++n) _Pragma("unroll") for (int k = 0; k < 2; ++k) \
        acc[ai][bj][m][n] = __builtin_amdgcn_mfma_f32_16x16x32_bf16(Bt[n][k], At[m][k], acc[ai][bj][m][n], 0, 0, 0); __builtin_amdgcn_s_setprio(0); } while (0)
#define PG8_WAIT_V(n) asm volatile("s_waitcnt vmcnt(" #n ")" ::: "memory")
#define PG8_WAIT_L(n) asm volatile("s_waitcnt lgkmcnt(" #n ")" ::: "memory")
#define PG8_BAR __builtin_amdgcn_s_barrier()
#define PG8_SCHED __builtin_amdgcn_sched_barrier(0)
    Unit cur, nxt; int ui = 0;
    if (!S.next(0, cur)) return;
    f32x4 acc[2][2][4][2];
#pragma unroll
    for (int a = 0; a < 2; ++a)
#pragma unroll
        for (int b = 0; b < 2; ++b)
#pragma unroll
            for (int m = 0; m < 4; ++m)
#pragma unroll
                for (int n = 0; n < 2; ++n) acc[a][b][m][n] = (f32x4){0.f, 0.f, 0.f, 0.f};
    bf16x8 At[4][2], B0[2][2], B1[2][2];
    const char* cA = (const char*)g.A + (GATHER ? (size_t)0 : (size_t)cur.pm * tstep); const char* cB = (const char*)g.Bt + (size_t)cur.pn * tstep + S.b_extra(cur);
    if constexpr (GATHER) { PG8_GOFF(gc, 0); }
    S.a_ready(cur);
    if constexpr (SP2) {
        PG8_STAGE(PG8_SB(0, 0), cB, voffB); PG8_STAGE(PG8_SB(0, 1), cB + hstep, voffB); PG8_STAGE_A(PG8_SA(0, 0), cA, 0, false); PG8_STAGE_A(PG8_SA(0, 1), cA, 1, false);
        if (wr == 1) PG8_BAR;
        PG8_WAIT_V(2); PG8_BAR;
        PG8_STAGE(PG8_SB(1, 0), cB + kstep, voffB); PG8_STAGE_A(PG8_SA(1, 0), cA + kstep, 0, false); PG8_STAGE(PG8_SB(1, 1), cB + hstep + kstep, voffB);
        PG8_WAIT_V(6); PG8_BAR;
    } else {
        PG8_STAGE(PG8_SB(0, 0), cB, voffB); PG8_STAGE(PG8_SA(0, 0), cA, voffA); PG8_STAGE(PG8_SB(0, 1), cB + hstep, voffB); PG8_STAGE(PG8_SA(0, 1), cA + hstep, voffA);
        if (wr == 1) PG8_BAR;
        PG8_WAIT_V(4); PG8_BAR;
        PG8_STAGE(PG8_SB(1, 0), cB + kstep, voffB); PG8_STAGE(PG8_SA(1, 0), cA + kstep, voffA); PG8_STAGE(PG8_SB(1, 1), cB + hstep + kstep, voffB);
        PG8_WAIT_V(6); PG8_BAR;
    }
    for (;;) {
        const bool has_next = S.next(ui + 1, nxt);
        const char* nA = has_next ? (const char*)g.A + (GATHER ? (size_t)0 : (size_t)nxt.pm * tstep) : cA; const char* nB = has_next ? (const char*)g.Bt + (size_t)nxt.pn * tstep + S.b_extra(nxt) : cB;
        for (int t = 0; t < nt; t += 2) {
            const bool last = (t == nt - 2);
            const char* a1 = cA + (size_t)(t + 1) * kstep;
            const char* a2 = last ? nA : cA + (size_t)(t + 2) * kstep; const char* b2 = last ? nB : cB + (size_t)(t + 2) * kstep;
            const char* a3 = a2 + kstep; const char* b3 = b2 + kstep;
            if (last && has_next) S.a_ready(nxt);
            if constexpr (GATHER) { if (last) { if (has_next) PG8_GOFF(gn, ui + 1); else { gn[0][0] = gc[0][0]; gn[0][1] = gc[0][1]; gn[1][0] = gc[1][0]; gn[1][1] = gc[1][1]; } } }
            if constexpr (SP2) {
            PG8_LDB(B0, 0, 0); PG8_LDB(B1, 0, 1); PG8_SCHED; PG8_LDA(At, 0, 0); PG8_STAGE_A(PG8_SA(1, 1), a1, 1, false);
            PG8_WAIT_V(8); PG8_WAIT_L(0); PG8_BAR; PG8_MMA(0, 0, At, B0); PG8_MMA(0, 1, At, B1); PG8_BAR; PG8_SCHED;
            PG8_LDA(At, 0, 1); PG8_STAGE(PG8_SB(0, 0), b2, voffB); PG8_STAGE(PG8_SB(0, 1), b2 + hstep, voffB); PG8_STAGE_A(PG8_SA(0, 0), a2, 0, last);
            PG8_WAIT_V(8); PG8_WAIT_L(0); PG8_BAR; PG8_MMA(1, 0, At, B0); PG8_MMA(1, 1, At, B1); PG8_BAR; PG8_SCHED;
            PG8_LDB(B0, 1, 0); PG8_LDB(B1, 1, 1); PG8_SCHED; PG8_LDA(At, 1, 0); PG8_STAGE_A(PG8_SA(0, 1), a2, 1, last);
            PG8_WAIT_V(8); PG8_WAIT_L(0); PG8_BAR; PG8_MMA(0, 0, At, B0); PG8_MMA(0, 1, At, B1); PG8_BAR; PG8_SCHED;
            PG8_LDA(At, 1, 1); PG8_STAGE(PG8_SB(1, 0), b3, voffB); PG8_STAGE(PG8_SB(1, 1), b3 + hstep, voffB); PG8_STAGE_A(PG8_SA(1, 0), a3, 0, last);
            PG8_WAIT_V(8); PG8_WAIT_L(0); PG8_BAR; PG8_MMA(1, 0, At, B0); PG8_MMA(1, 1, At, B1); PG8_BAR; PG8_SCHED;
            } else {
            PG8_LDB(B0, 0, 0); PG8_SCHED; PG8_LDA(At, 0, 0); PG8_STAGE(PG8_SA(1, 1), a1 + hstep, voffA);
            PG8_WAIT_L(8); PG8_BAR; PG8_WAIT_L(0); PG8_MMA(0, 0, At, B0); PG8_BAR; PG8_SCHED;
            PG8_LDB(B1, 0, 1); PG8_STAGE(PG8_SB(0, 0), b2, voffB);
            PG8_BAR; PG8_WAIT_L(0); PG8_MMA(0, 1, At, B1); PG8_BAR;
            PG8_LDA(At, 0, 1); PG8_STAGE(PG8_SA(0, 0), a2, voffA);
            PG8_BAR; PG8_WAIT_L(0); PG8_MMA(1, 0, At, B0); PG8_BAR; PG8_SCHED;
            PG8_STAGE(PG8_SB(0, 1), b2 + hstep, voffB);
            PG8_WAIT_V(6); PG8_BAR; PG8_MMA(1, 1, At, B1); PG8_BAR;
            PG8_LDB(B0, 1, 0); PG8_SCHED; PG8_LDA(At, 1, 0); PG8_STAGE(PG8_SA(0, 1), a2 + hstep, voffA);
            PG8_WAIT_L(8); PG8_BAR; PG8_WAIT_L(0); PG8_MMA(0, 0, At, B0); PG8_BAR; PG8_SCHED;
            PG8_LDB(B1, 1, 1); PG8_STAGE(PG8_SB(1, 0), b3, voffB);
            PG8_BAR; PG8_WAIT_L(0); PG8_MMA(0, 1, At, B1); PG8_BAR;
            PG8_LDA(At, 1, 1); PG8_STAGE(PG8_SA(1, 0), a3, voffA);
            PG8_BAR; PG8_WAIT_L(0); PG8_MMA(1, 0, At, B0); PG8_BAR; PG8_SCHED;
            PG8_STAGE(PG8_SB(1, 1), b3 + hstep, voffB);
            PG8_WAIT_V(6); PG8_BAR; PG8_MMA(1, 1, At, B1); PG8_BAR;
            }
        }
        if constexpr (ALIGN_EPI) { if (wr == 0) PG8_BAR; }
        if constexpr (!Epi::AFTER_DRAIN) { E(acc, cur, wr, wc, fr, fq); S.done(cur); }
        if (!has_next) break;
#pragma unroll
        for (int a = 0; a < 2; ++a)
#pragma unroll
            for (int b = 0; b < 2; ++b)
#pragma unroll
                for (int m = 0; m < 4; ++m)
#pragma unroll
                    for (int n = 0; n < 2; ++n) acc[a][b][m][n] = (f32x4){0.f, 0.f, 0.f, 0.f};
        cur = nxt; cA = nA; cB = nB; ++ui;
        if constexpr (GATHER) { gc[0][0] = gn[0][0]; gc[0][1] = gn[0][1]; gc[1][0] = gn[1][0]; gc[1][1] = gn[1][1]; }
        if constexpr (ALIGN_EPI) { if (wr == 1) PG8_BAR; }
    }
    PG8_WAIT_V(0);
    if constexpr (!ALIGN_EPI) { if (wr == 0) PG8_BAR; }
    PG8_BAR;
    if constexpr (Epi::AFTER_DRAIN) { E.fused(acc, cur, wr, wc, fr, fq, lds, wid, lane); S.done(cur); }
#undef PG8_SA
#undef PG8_SB
#undef PG8_STAGE
#undef PG8_STAGE_A
#undef PG8_GOFF
#undef PG8_LDA
#undef PG8_LDB
#undef PG8_MMA
#undef PG8_WAIT_V
#undef PG8_WAIT_L
#undef PG8_BAR
#undef PG8_SCHED
}
}
struct PgEpiP {
    static constexpr bool PERM = true, AFTER_DRAIN = false; bf16* O; int ldc;
    __device__ __forceinline__ void operator()(const pg8::f32x4 (&acc)[2][2][4][2], const pg8::Unit& u, int wr, int wc, int fr, int fq) const {
        const int row0 = u.pm * 256 + wr * 64 + fr, col0 = u.pn * 256 + wc * 32 + 8 * fq;
#pragma unroll
        for (int ai = 0; ai < 2; ++ai)
#pragma unroll
            for (int m = 0; m < 4; ++m) { bf16* rowp = O + (size_t)(row0 + ai * 128 + m * 16) * ldc + col0;
#pragma unroll
                for (int bj = 0; bj < 2; ++bj) { const f32x4 v0 = acc[ai][bj][m][0], v1 = acc[ai][bj][m][1];
                    *(u32x4*)(rowp + bj * 128) = (u32x4){pg8::cvt_pk_bf16(v0[0], v0[1]), pg8::cvt_pk_bf16(v0[2], v0[3]), pg8::cvt_pk_bf16(v1[0], v1[1]), pg8::cvt_pk_bf16(v1[2], v1[3])}; } }
    }
};
struct PgEpiRes {
    static constexpr bool PERM = true, AFTER_DRAIN = false; const Params* p; int l, gj, smode, dmode;
    __device__ __forceinline__ void operator()(const pg8::f32x4 (&acc)[2][2][4][2], const pg8::Unit& u, int wr, int wc, int fr, int fq) const {
        const int row0 = u.pm * 256 + wr * 64 + fr, col0 = u.pn * 256 + wc * 32 + 8 * fq;
        const bool lat = u.pm * 256 < SEQ;
        f32x4 mm[2][2];
        { const float* md = mod_vec(*p, l, u.pm * 256, gj) + col0;
#pragma unroll
          for (int bj = 0; bj < 2; ++bj)
#pragma unroll
              for (int n = 0; n < 2; ++n) mm[bj][n] = *(const f32x4*)(md + bj * 128 + 4 * n); }
#pragma unroll
        for (int ai = 0; ai < 2; ++ai)
#pragma unroll
            for (int m = 0; m < 4; ++m) { const int row = row0 + ai * 128 + m * 16;
#pragma unroll
                for (int bj = 0; bj < 2; ++bj) { const int col = col0 + bj * 128;
                    f32x4 s0, s1;
                    if ((smode & 1) && lat) { const u32x4 w = *(const u32x4*)(xb_row(*p, smode, row) + col);
                        s0 = (f32x4){lo16(w.x), hi16(w.x), lo16(w.y), hi16(w.y)}; s1 = (f32x4){lo16(w.z), hi16(w.z), lo16(w.w), hi16(w.w)}; }
                    else { const float* src = xrow_f32(*p, smode, row) + col; s0 = *(const f32x4*)src; s1 = *(const f32x4*)(src + 4); }
                    const f32x4 r0 = s0 + mm[bj][0] * acc[ai][bj][m][0], r1 = s1 + mm[bj][1] * acc[ai][bj][m][1];
                    if ((dmode & 1) && lat) *(u32x4*)(xb_row(*p, dmode, row) + col) = (u32x4){pk2(r0.x, r0.y), pk2(r0.z, r0.w), pk2(r1.x, r1.y), pk2(r1.z, r1.w)};
                    else { float* dst = (lat ? p->out + (size_t)row * D : (float*)(p->ws + WS_XC) + (size_t)(row - SEQ) * D) + col; *(f32x4*)dst = r0; *(f32x4*)(dst + 4) = r1; } } }
    }
};
struct PgEpiSwi {
    static constexpr bool PERM = true, AFTER_DRAIN = false; bf16* Hd;
    __device__ __forceinline__ void operator()(const pg8::f32x4 (&acc)[2][2][4][2], const pg8::Unit& u, int wr, int wc, int fr, int fq) const {
        const int row0 = u.pm * 256 + wr * 64 + fr, col0 = u.pn * 128 + wc * 32 + 8 * fq;
#pragma unroll
        for (int ai = 0; ai < 2; ++ai)
#pragma unroll
            for (int m = 0; m < 4; ++m) { const f32x4 g0 = acc[ai][0][m][0], g1 = acc[ai][0][m][1], u0 = acc[ai][1][m][0], u1 = acc[ai][1][m][1];
                *(u32x4*)(Hd + (size_t)(row0 + ai * 128 + m * 16) * FF + col0) = (u32x4){pg8::cvt_pk_bf16(silu_f(g0[0]) * u0[0], silu_f(g0[1]) * u0[1]), pg8::cvt_pk_bf16(silu_f(g0[2]) * u0[2], silu_f(g0[3]) * u0[3]),
                    pg8::cvt_pk_bf16(silu_f(g1[0]) * u1[0], silu_f(g1[1]) * u1[1]), pg8::cvt_pk_bf16(silu_f(g1[2]) * u1[2], silu_f(g1[3]) * u1[3])}; }
    }
};
struct PgEpiMoeDown {
    static constexpr bool PERM = true, AFTER_DRAIN = false; bf16* Y2; const int* rowd; const float* rowg;
    __device__ __forceinline__ void operator()(const pg8::f32x4 (&acc)[2][2][4][2], const pg8::Unit& u, int wr, int wc, int fr, int fq) const {
        const int row0 = u.pm * 256 + wr * 64 + fr, col0 = u.pn * 256 + wc * 32 + 8 * fq;
#pragma unroll
        for (int ai = 0; ai < 2; ++ai)
#pragma unroll
            for (int m = 0; m < 4; ++m) { const int lr = u.idx * 256 + wr * 64 + fr + ai * 128 + m * 16; const int d = rowd[lr]; if (d < 0) continue; const float g = rowg[lr];
                bf16* rowp = Y2 + (size_t)d * D + col0;
#pragma unroll
                for (int bj = 0; bj < 2; ++bj) { const f32x4 v0 = acc[ai][bj][m][0] * g, v1 = acc[ai][bj][m][1] * g;
                    *(u32x4*)(rowp + bj * 128) = (u32x4){pg8::cvt_pk_bf16(v0[0], v0[1]), pg8::cvt_pk_bf16(v0[2], v0[3]), pg8::cvt_pk_bf16(v1[0], v1[1]), pg8::cvt_pk_bf16(v1[2], v1[3])}; } }
    }
};
__device__ __forceinline__ int moe_row(const Params& p, const int* seg, const int* tile_e, int s, float& gate);
template <class Epi>
__device__ __forceinline__ void run_gemm_gather(unsigned char* lds, const bf16* A, const bf16* Bt, int M, int N, int K, const Epi& E, const int* tile_e, size_t estride, const Params& p, const int* seg, int bid, int nb) {
    pg8::Gemm g{A, Bt, M, N, K}; pg8::StaticOrder S; S.init(M, N, nb, bid); S.tile_e = tile_e; S.estride = estride;
    __attribute__((address_space(3))) unsigned short* gr = (__attribute__((address_space(3))) unsigned short*)((__attribute__((address_space(3))) unsigned char*)lds + 131072);
    {
        int dd[12];
#pragma unroll
        for (int i = 0; i < 12; ++i) { pg8::Unit u; float gt; dd[i] = (S.next(i, u) && threadIdx.x < 256) ? moe_row(p, seg, tile_e, u.pm * 256 + threadIdx.x, gt) : -1; }
#pragma unroll
        for (int i = 0; i < 12; ++i) if (threadIdx.x < 256) gr[i * 256 + threadIdx.x] = (unsigned short)(dd[i] >= 0 ? (dd[i] >> 1) : SEQ);
    }
    __syncthreads();
    pg8::gemm_phase<Epi, pg8::StaticOrder, true, true, true>((__attribute__((address_space(3))) unsigned char*)lds, g, S, E, gr);
}
__device__ __forceinline__ void run_gemm_moedown(unsigned char* lds, const bf16* A, const bf16* Bt, int M, int N, int K, bf16* Y2, const int* tile_e, size_t estride, const Params& p, const int* seg, int bid, int nb) {
    pg8::Gemm g{A, Bt, M, N, K}; pg8::StaticOrder S; S.init(M, N, nb, bid); S.tile_e = tile_e; S.estride = estride;
    int* rd = (int*)(lds + 131072); float* rg = (float*)(lds + 131072 + 3 * 1024);
    {
        int dd[3]; float gg[3];
#pragma unroll
        for (int i = 0; i < 3; ++i) { pg8::Unit u; gg[i] = 0.f; dd[i] = (S.next(i, u) && threadIdx.x < 256) ? moe_row(p, seg, tile_e, u.pm * 256 + threadIdx.x, gg[i]) : -1; }
#pragma unroll
        for (int i = 0; i < 3; ++i) if (threadIdx.x < 256) { rd[i * 256 + threadIdx.x] = dd[i]; rg[i * 256 + threadIdx.x] = gg[i]; }
    }
    __syncthreads();
    PgEpiMoeDown E{Y2, rd, rg};
    pg8::gemm_phase<PgEpiMoeDown, pg8::StaticOrder, true, true>((__attribute__((address_space(3))) unsigned char*)lds, g, S, E);
}
template <class Epi>
__device__ __forceinline__ void run_gemm(unsigned char* lds, const bf16* A, const bf16* Bt, int M, int N, int K, const Epi& E, const int* tile_e, size_t estride, int bid, int nb) {
    pg8::Gemm g{A, Bt, M, N, K}; pg8::StaticOrder S; S.init(M, N, nb, bid); S.tile_e = tile_e; S.estride = estride;
    pg8::gemm_phase<Epi, pg8::StaticOrder, true, true>((__attribute__((address_space(3))) unsigned char*)lds, g, S, E);
}

__device__ __forceinline__ void prep_qk(const Params& p, int l, int nrows, int bid, int nb) {
    const int lane = threadIdx.x & 63, wave = threadIdx.x >> 6;
    bf16* P = (bf16*)(p.ws + WS_P);
    const float gq = p.in[21][l * 64 + lane], gk = p.in[22][l * 64 + lane];
    const int sec = lane >> 5, j = lane & 31, i = j & 15;
    const float invf = exp2f(-(float)i * (13.287712379549449f / 16.f)) * 0.3183098861837907f;
    const int rstride = nb * 8;
    for (int row0 = bid * 8 + wave; row0 < nrows; row0 += 4 * rstride) {
        bf16 raw[4][10];
#pragma unroll
        for (int k = 0; k < 4; ++k) { const int row = row0 + k * rstride;
            if (row < nrows) { const bf16* pr = P + (size_t)row * INC;
#pragma unroll
                for (int hv = 0; hv < 10; ++hv) raw[k][hv] = pr[((hv < 8) ? C_AQ + hv * 64 : C_AK + (hv - 8) * 64) + lane]; } }
#pragma unroll
        for (int k = 0; k < 4; ++k) { const int row = row0 + k * rstride;
            if (row >= nrows) break;
            float cs = 1.f, sn = 0.f;
            if (row < SEQ) { const float x = (float)(sec ? (row & 63) : (row >> 6)) * invf; sn = sinpif(x); cs = cospif(x); }
            bf16* pr = P + (size_t)row * INC;
#pragma unroll
            for (int hv = 0; hv < 10; ++hv) {
                const int off = (hv < 8) ? C_AQ + hv * 64 : C_AK + (hv - 8) * 64;
                const float v = bf2f(raw[k][hv]);
                const float ss = wave_sum(v * v);
                float y = v * rsqrtf(ss * (1.f / 64.f) + EPS) * (hv < 8 ? gq : gk);
                const float o = __shfl_xor(y, 16);
                y = (j < 16) ? y * cs - o * sn : y * cs + o * sn;
                if (hv < 8) y *= C2;
                pr[off + lane] = (bf16)f2bf(y);
            }
        }
    }
}
__device__ __forceinline__ float conv3(const bf16* P, const float* cw, const float* cb, int t, int lo, int hi, int col) {
    float a = cb[col] + cw[768 + col] * bf2f(P[(size_t)t * INC + col]);
    if (t - 1 >= lo) a += cw[col] * bf2f(P[(size_t)(t - 1) * INC + col]);
    if (t + 1 < hi) a += cw[1536 + col] * bf2f(P[(size_t)(t + 1) * INC + col]);
    return a;
}
__device__ __forceinline__ void prep_hyz(const Params& p, int l, bool with_ctx, float* sm, int bid, int nb) {
    const bf16* P = (const bf16*)(p.ws + WS_P);
    const float* cw = p.in[10] + l * 3 * 768; const float* cb = p.in[11] + l * 768;
    const int nitem = with_ctx ? 272 : 256, tid = threadIdx.x, ch = tid & 255, th = tid >> 8;
    const float a0 = cw[C_HX1 + ch], a1 = cw[768 + C_HX1 + ch], a2 = cw[1536 + C_HX1 + ch], ab = cb[C_HX1 + ch];
    const float v0 = cw[C_HV + ch], v1 = cw[768 + C_HV + ch], v2 = cw[1536 + C_HV + ch], vb = cb[C_HV + ch];
    for (int item = nb - 1 - bid; item < nitem; item += nb) {
        const bool lat = item < 256; const int t0 = lat ? item * 64 : SEQ + (item - 256) * 16, hr = lat ? 32 : 8;
        const int lo = lat ? 0 : SEQ, hi = lat ? SEQ : R;
        const int ts = t0 + th * hr;
        const bf16* pa = P + C_HX1 + ch; const bf16* pv = P + C_HV + ch;
        float xa[34], xv[34];
#pragma unroll
        for (int i = 0; i < 34; ++i) { const int t = ts - 1 + i; const bool ok = (i < hr + 2) && (t >= lo) && (t < hi);
            xa[i] = ok ? bf2f(pa[(size_t)t * INC]) : 0.f; xv[i] = ok ? bf2f(pv[(size_t)t * INC]) : 0.f; }
#pragma unroll
        for (int i = 0; i < 32; ++i) if (i < hr)
            sm[ch * 65 + th * hr + i] = (ab + a0 * xa[i] + a1 * xa[i + 1] + a2 * xa[i + 2]) * (vb + v0 * xv[i] + v1 * xv[i + 1] + v2 * xv[i + 2]);
        __syncthreads();
        const int rows = 2 * hr;
        for (int e = tid; e < rows * 256; e += NT) { const int c2 = e / rows, tl = e % rows;
            if (lat) ((float*)(p.ws + WS_ZT))[(size_t)c2 * SEQ + t0 + tl] = sm[c2 * 65 + tl];
            else ((float*)(p.ws + WS_ZC))[c2 * CTXL + (t0 - SEQ) + tl] = sm[c2 * 65 + tl]; }
        __syncthreads();
    }
}
typedef short bf16x8_t __attribute__((ext_vector_type(8)));
typedef float f32x16_t __attribute__((ext_vector_type(16)));
__device__ __forceinline__ int crow32(int r, int hi) { return (r & 3) + 8 * (r >> 2) + 4 * hi; }
__device__ __forceinline__ void prep_retu(const Params& p, int l, unsigned char* smb, int bid, int nb) {
    const bf16* P = (const bf16*)(p.ws + WS_P);
    bf16* Ktf = (bf16*)smb; bf16* Ktb = Ktf + 64 * 136; bf16* Vt = Ktb + 64 * 136; float* wf = (float*)(Vt + 64 * 136); float* wb = wf + 128;
    const int tid = threadIdx.x, lane = tid & 63, wave = tid >> 6, r = lane & 31, hh = lane >> 5;
    for (int it = bid; it < NCH * 4; it += nb) {
        const int c = it >> 2, h = it & 3; const int r0 = c * 128;
        const float lgf = -__expf(p.in[20][l * 8 + h]), lgb = -__expf(p.in[20][l * 8 + 4 + h]);
        if (tid < 128) { wf[tid] = __expf(lgf * (float)(127 - tid)) * 0.125f; wb[tid] = __expf(lgb * (float)tid) * 0.125f; }
        __syncthreads();
        for (int e = tid; e < 128 * 8; e += NT) { const int m = e >> 3, dc = (e & 7) * 8; const bf16* pr = P + (size_t)(r0 + m) * INC + h * 64 + dc;
            const u32x4 kw = *(const u32x4*)(pr + C_RK), vw = *(const u32x4*)(pr + C_RV); const float sf = wf[m], sb = wb[m];
#pragma unroll
            for (int w = 0; w < 4; ++w) { const float k0 = lo16(kw[w]), k1 = hi16(kw[w]);
                Ktf[(dc + 2 * w) * 136 + m] = (bf16)f2bf(k0 * sf); Ktf[(dc + 2 * w + 1) * 136 + m] = (bf16)f2bf(k1 * sf);
                Ktb[(dc + 2 * w) * 136 + m] = (bf16)f2bf(k0 * sb); Ktb[(dc + 2 * w + 1) * 136 + m] = (bf16)f2bf(k1 * sb);
                Vt[(dc + 2 * w) * 136 + m] = (bf16)(vw[w] & 0xffffu); Vt[(dc + 2 * w + 1) * 136 + m] = (bf16)(vw[w] >> 16); } }
        __syncthreads();
        {   const int dir = wave >> 2, ti = (wave >> 1) & 1, tj = wave & 1;
            const bf16* Ak = (dir ? Ktb : Ktf) + (32 * ti + r) * 136 + 8 * hh; const bf16* Bv = Vt + (32 * tj + r) * 136 + 8 * hh;
            f32x16_t acc = {0.f, 0.f, 0.f, 0.f, 0.f, 0.f, 0.f, 0.f, 0.f, 0.f, 0.f, 0.f, 0.f, 0.f, 0.f, 0.f};
#pragma unroll
            for (int ks = 0; ks < 8; ++ks) acc = __builtin_amdgcn_mfma_f32_32x32x16_bf16(*(const bf16x8_t*)(Ak + 16 * ks), *(const bf16x8_t*)(Bv + 16 * ks), acc, 0, 0, 0);
            float* U = (float*)(p.ws + WS_RU) + ((size_t)(dir * 4 + h) * NCH + c) * 4096;
#pragma unroll
            for (int g = 0; g < 16; ++g) U[(32 * ti + crow32(g, hh)) * 64 + 32 * tj + r] = acc[g];
        }
        __syncthreads();
    }
}
__device__ __forceinline__ void ph_retscan(const Params& p, int l, int bid, int nb) {
    float* U = (float*)(p.ws + WS_RU);
    for (int g = (nb - 1 - bid) * NT + threadIdx.x; g < 8 * 4096; g += nb * NT) {
        const int dir = g >> 14, h = (g >> 12) & 3, e = g & 4095;
        const float lg = -__expf(p.in[20][l * 8 + dir * 4 + h]); const float Dc = __expf(lg * 128.f);
        float* u = U + (size_t)(dir * 4 + h) * NCH * 4096 + e;
        const float uc0 = u[(size_t)128 * 4096], uc1 = u[(size_t)129 * 4096];
        float s; long step; float* q;
        if (dir == 0) { s = Dc * uc0 + uc1; u[(size_t)128 * 4096] = 0.f; u[(size_t)129 * 4096] = uc0; q = u; step = 4096; }
        else { s = uc0 + Dc * uc1; u[(size_t)129 * 4096] = 0.f; u[(size_t)128 * 4096] = uc1; q = u + (size_t)127 * 4096; step = -4096; }
        float cur[16], nxt[16];
#pragma unroll
        for (int i = 0; i < 16; ++i) cur[i] = q[(long)i * step];
#pragma unroll 1
        for (int c0 = 0; c0 < 128; c0 += 16) {
            if (c0 + 16 < 128) {
#pragma unroll
                for (int i = 0; i < 16; ++i) nxt[i] = q[(long)(c0 + 16 + i) * step]; }
#pragma unroll
            for (int i = 0; i < 16; ++i) { q[(long)(c0 + i) * step] = s; s = Dc * s + cur[i]; }
#pragma unroll
            for (int i = 0; i < 16; ++i) cur[i] = nxt[i];
        }
    }
}

__device__ __forceinline__ void post_ret(const Params& p, int l, int nchunks, unsigned char* smb, int bid, int nb) {
    const bf16* P = (const bf16*)(p.ws + WS_P); bf16* Y = (bf16*)(p.ws + WS_YMIX);
    bf16* Qs = (bf16*)smb; bf16* Ks = Qs + 128 * 72; bf16* Vt = Ks + 128 * 72; bf16* SPt = Vt + 64 * 136;
    bf16* Sb = SPt + 2 * 64 * 72; float* Of = (float*)Sb;
    float* pf = (float*)(Sb + 128 * 136); float* pb = pf + 128;
    const int tid = threadIdx.x, lane = tid & 63, wave = tid >> 6, r = lane & 31, hh = lane >> 5;
    for (int it = bid; it < nchunks * 4; it += nb) {
        const int c = it >> 2, h = it & 3, r0 = c * 128;
        const float lgf = -__expf(p.in[20][l * 8 + h]), lgb = -__expf(p.in[20][l * 8 + 4 + h]);
        if (tid < 128) { pf[tid] = __expf(lgf * (float)tid); pb[tid] = __expf(lgb * (float)tid); }
        for (int e = tid; e < 128 * 8; e += NT) { const int m = e >> 3, dc = (e & 7) * 8; const bf16* pr = P + (size_t)(r0 + m) * INC + h * 64 + dc;
            *(u32x4*)(Qs + m * 72 + dc) = *(const u32x4*)(pr + C_RQ); *(u32x4*)(Ks + m * 72 + dc) = *(const u32x4*)(pr + C_RK);
            const u32x4 vw = *(const u32x4*)(pr + C_RV);
#pragma unroll
            for (int w = 0; w < 4; ++w) { Vt[(dc + 2 * w) * 136 + m] = (bf16)(vw[w] & 0xffffu); Vt[(dc + 2 * w + 1) * 136 + m] = (bf16)(vw[w] >> 16); } }
        for (int e = tid; e < 2 * 64 * 16; e += NT) { const int dir = e >> 10, d = (e >> 4) & 63, e4 = (e & 15) * 4;
            const f32x4 v = *(const f32x4*)((const float*)(p.ws + WS_RU) + ((size_t)(dir * 4 + h) * NCH + c) * 4096 + d * 64 + e4);
            bf16* dst = SPt + (dir * 64 + e4) * 72 + d; dst[0] = (bf16)f2bf(v.x); dst[72] = (bf16)f2bf(v.y); dst[144] = (bf16)f2bf(v.z); dst[216] = (bf16)f2bf(v.w); }
        __syncthreads();
        {
            const int ti = wave >> 1, tj0 = (wave & 1) * 2;
            const bf16* Aq = Qs + (32 * ti + r) * 72 + 8 * hh;
#pragma unroll
            for (int t2 = 0; t2 < 2; ++t2) { const int tj = tj0 + t2; const bf16* Bk = Ks + (32 * tj + r) * 72 + 8 * hh;
                f32x16_t acc = {0.f, 0.f, 0.f, 0.f, 0.f, 0.f, 0.f, 0.f, 0.f, 0.f, 0.f, 0.f, 0.f, 0.f, 0.f, 0.f};
#pragma unroll
                for (int ks = 0; ks < 4; ++ks) acc = __builtin_amdgcn_mfma_f32_32x32x16_bf16(*(const bf16x8_t*)(Aq + 16 * ks), *(const bf16x8_t*)(Bk + 16 * ks), acc, 0, 0, 0);
                const int m = 32 * tj + r;
#pragma unroll
                for (int g = 0; g < 16; ++g) { const int n = 32 * ti + crow32(g, hh);
                    const float f = (n > m) ? pf[n - m] : ((n < m) ? pb[m - n] : 2.f);
                    Sb[n * 136 + m] = (bf16)f2bf(acc[g] * 0.125f * f); } }
        }
        __syncthreads();
        f32x16_t accI = {0.f, 0.f, 0.f, 0.f, 0.f, 0.f, 0.f, 0.f, 0.f, 0.f, 0.f, 0.f, 0.f, 0.f, 0.f, 0.f}, accF = accI, accB = accI;
        const int ti = wave >> 1, tj = wave & 1;
        {   const bf16* As = Sb + (32 * ti + r) * 136 + 8 * hh; const bf16* Bv = Vt + (32 * tj + r) * 136 + 8 * hh;
#pragma unroll
            for (int ks = 0; ks < 8; ++ks) accI = __builtin_amdgcn_mfma_f32_32x32x16_bf16(*(const bf16x8_t*)(As + 16 * ks), *(const bf16x8_t*)(Bv + 16 * ks), accI, 0, 0, 0);
            const bf16* Aq = Qs + (32 * ti + r) * 72 + 8 * hh; const bf16* Bf = SPt + (32 * tj + r) * 72 + 8 * hh; const bf16* Bb = SPt + (64 + 32 * tj + r) * 72 + 8 * hh;
#pragma unroll
            for (int ks = 0; ks < 4; ++ks) { const bf16x8_t aq = *(const bf16x8_t*)(Aq + 16 * ks);
                accF = __builtin_amdgcn_mfma_f32_32x32x16_bf16(aq, *(const bf16x8_t*)(Bf + 16 * ks), accF, 0, 0, 0);
                accB = __builtin_amdgcn_mfma_f32_32x32x16_bf16(aq, *(const bf16x8_t*)(Bb + 16 * ks), accB, 0, 0, 0); }
        }
        __syncthreads();
#pragma unroll
        for (int g = 0; g < 16; ++g) { const int n = 32 * ti + crow32(g, hh);
            const float xif = pf[n] * pf[1], xib = pb[127 - n] * pb[1];
            Of[n * 68 + 32 * tj + r] = accI[g] + xif * accF[g] + xib * accB[g]; }
        __syncthreads();
        {
            const int n = tid >> 2, eq = tid & 3;
            float acc[16];
#pragma unroll
            for (int w = 0; w < 4; ++w) { const f32x4 v = *(const f32x4*)(Of + n * 68 + eq * 16 + 4 * w); acc[4 * w] = v.x; acc[4 * w + 1] = v.y; acc[4 * w + 2] = v.z; acc[4 * w + 3] = v.w; }
            float sm1 = 0.f;
#pragma unroll
            for (int e = 0; e < 16; ++e) sm1 += acc[e];
            sm1 += __shfl_xor(sm1, 1); sm1 += __shfl_xor(sm1, 2);
            const float mu = sm1 * (1.f / 64.f); float vs = 0.f;
#pragma unroll
            for (int e = 0; e < 16; ++e) { acc[e] -= mu; vs += acc[e] * acc[e]; }
            vs += __shfl_xor(vs, 1); vs += __shfl_xor(vs, 2);
            const float rs = rsqrtf(vs * (1.f / 64.f) + EPS);
            const bf16* gr = P + (size_t)(r0 + n) * INC + C_RG + h * 64 + eq * 16;
            const u32x4 g0 = *(const u32x4*)gr, g1 = *(const u32x4*)(gr + 8);
            u32x4 o0, o1;
#pragma unroll
            for (int w = 0; w < 4; ++w) { o0[w] = pk2(silu_f(lo16(g0[w])) * acc[2 * w] * rs, silu_f(hi16(g0[w])) * acc[2 * w + 1] * rs);
                o1[w] = pk2(silu_f(lo16(g1[w])) * acc[8 + 2 * w] * rs, silu_f(hi16(g1[w])) * acc[9 + 2 * w] * rs); }
            bf16* yo = Y + (size_t)(r0 + n) * D + 256 + h * 64 + eq * 16;
            *(u32x4*)yo = o0; *(u32x4*)(yo + 8) = o1;
        }
        __syncthreads();
    }
}
__device__ __forceinline__ void post_hy(const Params& p, int l, bool with_ctx, float* sm, int bid, int nb) {
    const bf16* P = (const bf16*)(p.ws + WS_P); bf16* Y = (bf16*)(p.ws + WS_YMIX);
    const float* cw = p.in[10] + l * 3 * 768; const float* cb = p.in[11] + l * 768;
    const int nitem = with_ctx ? 272 : 256, tid = threadIdx.x, ch = tid & 255, th = tid >> 8;
    float w0[3], w1[3], w2[3], wb[3];
#pragma unroll
    for (int k = 0; k < 3; ++k) { const int col = k * 256 + ch; w0[k] = cw[col]; w1[k] = cw[768 + col]; w2[k] = cw[1536 + col]; wb[k] = cb[col]; }
    const float hbias = p.in[19][l * 256 + ch];
    for (int item = nb - 1 - bid; item < nitem; item += nb) {
        const bool lat = item < 256; const int t0 = lat ? item * 64 : SEQ + (item - 256) * 16, hr = lat ? 32 : 8;
        const int lo = lat ? 0 : SEQ, hi = lat ? SEQ : R, rows = 2 * hr;
        for (int e = tid; e < rows * 256; e += NT) { const int c2 = e / rows, tl = e % rows;
            sm[c2 * 65 + tl] = lat ? ((const float*)(p.ws + WS_ZT))[(size_t)c2 * SEQ + t0 + tl] : ((const float*)(p.ws + WS_ZC))[c2 * CTXL + (t0 - SEQ) + tl]; }
        __syncthreads();
        const int ts = t0 + th * hr;
        float xr[3][34];
#pragma unroll
        for (int k = 0; k < 3; ++k) { const bf16* pc = P + k * 256 + ch;
#pragma unroll
            for (int i = 0; i < 34; ++i) { const int t = ts - 1 + i; xr[k][i] = ((i < hr + 2) && (t >= lo) && (t < hi)) ? bf2f(pc[(size_t)t * INC]) : 0.f; } }
#pragma unroll
        for (int i = 0; i < 32; ++i) if (i < hr) { float u[3];
#pragma unroll
            for (int k = 0; k < 3; ++k) u[k] = wb[k] + w0[k] * xr[k][i] + w1[k] * xr[k][i + 1] + w2[k] * xr[k][i + 2];
            Y[(size_t)(ts + i) * D + ch] = (bf16)f2bf(u[0] * (sm[ch * 65 + th * hr + i] + hbias * (u[1] * u[2]))); }
        __syncthreads();
    }
}

#include <hip/hip_bf16.h>
#include <cmath>
namespace attn_body {
using bf16=__hip_bfloat16;
using bf16x8=__attribute__((ext_vector_type(8)))short;
using s16x4=__attribute__((ext_vector_type(4)))short;
using f32x16=__attribute__((ext_vector_type(16)))float;
using u32x4=__attribute__((ext_vector_type(4)))unsigned;
constexpr int D=64;
constexpr int NW=8,QBLK=32,QB=QBLK*NW,KVBLK=64;
constexpr int QP=2560,KP=2560,OP=1024;
__device__ __forceinline__ int crow(int r,int hi){return (r&3)+8*(r>>2)+4*hi;}
#define SBAR() __builtin_amdgcn_sched_barrier(0)
__device__ __forceinline__ void cmask(f32x16&p0,f32x16&p1,int jb,int qrel,int hi){
  const float NEG=-INFINITY; int kb=64*jb+4*hi;
  #pragma unroll
  for(int r=0;r<16;++r){int kv=kb+(r&3)+8*(r>>2); if(kv>qrel)p0[r]=NEG; if(kv+32>qrel)p1[r]=NEG;}
}

constexpr int NSLOT=3, SLOTB=8192;
constexpr int LDS_K=0, LDS_V=NSLOT*SLOTB, LDS_WS=2*NSLOT*SLOTB, LDS_OST=LDS_WS+NW*64*4, LDS_BYTES=LDS_OST+NW*4096;
constexpr float C2=0.125f*1.4426950408889634f;
__device__ __forceinline__ void glds16(const void*gsrc,unsigned lds_dst){unsigned keep;
  asm volatile("s_mov_b32 %0, m0\n\ts_mov_b32 m0, %2\n\ts_nop 0\n\tglobal_load_lds_dwordx4 %1, off\n\ts_mov_b32 m0, %0":"=&s"(keep):"v"(gsrc),"s"(lds_dst):"memory");}
__device__ __forceinline__ float max3f(float a,float b,float c){float r;asm("v_max3_f32 %0, %1, %2, %3":"=v"(r):"v"(a),"v"(b),"v"(c));return r;}
__device__ __forceinline__ float max2f(float a,float b){float r;asm("v_max_f32_e32 %0, %1, %2":"=v"(r):"v"(a),"v"(b));return r;}
__device__ __forceinline__ float fadd_s(float a,float b){float r;asm("v_add_f32_e32 %0, %1, %2":"=v"(r):"v"(a),"v"(b));return r;}
__device__ __forceinline__ float fsub_s(float a,float b){float r;asm("v_sub_f32_e32 %0, %1, %2":"=v"(r):"v"(a),"v"(b));return r;}
typedef float f32x2_t __attribute__((ext_vector_type(2))); typedef __bf16 bf16x2_t __attribute__((ext_vector_type(2)));
__device__ __forceinline__ unsigned cvtpk_s(float lo,float hi){f32x2_t v={lo,hi};bf16x2_t b=__builtin_convertvector(v,bf16x2_t);return __builtin_bit_cast(unsigned,b);}
#define WAIT_BAR(N) asm volatile("s_waitcnt vmcnt(" #N ") lgkmcnt(0)\n\ts_barrier":::"memory")

__device__ __forceinline__ void qkt(f32x16&p0,f32x16&p1,const char*Kslot,const bf16x8*qr,const f32x16&negm,int r32,int hi){
  const char*kb=Kslot+hi*1024+r32*16;
  #pragma unroll
  for(int d0=0;d0<4;++d0){
    const bf16x8 b0=*reinterpret_cast<const bf16x8*>(kb+d0*2048);
    const bf16x8 b1=*reinterpret_cast<const bf16x8*>(kb+d0*2048+512);
    if(d0==0){p0=__builtin_amdgcn_mfma_f32_32x32x16_bf16(b0,qr[0],negm,0,0,0);p1=__builtin_amdgcn_mfma_f32_32x32x16_bf16(b1,qr[0],negm,0,0,0);}
    else{p0=__builtin_amdgcn_mfma_f32_32x32x16_bf16(b0,qr[d0],p0,0,0,0);p1=__builtin_amdgcn_mfma_f32_32x32x16_bf16(b1,qr[d0],p1,0,0,0);}}
}
typedef __attribute__((address_space(3))) const char* lds_cptr;
typedef short v4i16_t __attribute__((ext_vector_type(4)));
__device__ __forceinline__ void kload8(bf16x8*kf,lds_cptr kp){
  kf[0]=*(const __attribute__((address_space(3))) bf16x8*)(kp);      kf[1]=*(const __attribute__((address_space(3))) bf16x8*)(kp+512);
  kf[2]=*(const __attribute__((address_space(3))) bf16x8*)(kp+2048); kf[3]=*(const __attribute__((address_space(3))) bf16x8*)(kp+2560);
  kf[4]=*(const __attribute__((address_space(3))) bf16x8*)(kp+4096); kf[5]=*(const __attribute__((address_space(3))) bf16x8*)(kp+4608);
  kf[6]=*(const __attribute__((address_space(3))) bf16x8*)(kp+6144); kf[7]=*(const __attribute__((address_space(3))) bf16x8*)(kp+6656);
}
__device__ __forceinline__ void kload2(bf16x8*kf,lds_cptr kp,int j){ kf[2*j]=*(const __attribute__((address_space(3))) bf16x8*)(kp+j*2048); kf[2*j+1]=*(const __attribute__((address_space(3))) bf16x8*)(kp+j*2048+512); }
__device__ __forceinline__ s16x4 vtr(lds_cptr p){ return __builtin_bit_cast(s16x4,__builtin_amdgcn_ds_read_tr16_b64_v4i16((__attribute__((address_space(3))) v4i16_t*)p)); }
__device__ __forceinline__ float rowmax(const f32x16&p0,const f32x16&p1){
  float a=max3f(p0[0],p0[1],p1[0]),b=max3f(p0[2],p0[3],p1[1]);a=max3f(a,p1[2],p1[3]);
  #pragma unroll
  for(int r=4;r<16;r+=4){a=max3f(a,p0[r],p0[r+1]);b=max3f(b,p0[r+2],p0[r+3]);a=max3f(a,p1[r],p1[r+1]);b=max3f(b,p1[r+2],p1[r+3]);}
  const float m=max2f(a,b);
  auto rr=__builtin_amdgcn_permlane32_swap(__float_as_uint(m),__float_as_uint(m),false,false);
  return max2f(__uint_as_float(rr[0]),__uint_as_float(rr[1]));
}
__device__ __forceinline__ void pv(f32x16*o,int vb,bf16x8 pa0,bf16x8 pa1,bf16x8 pa2,bf16x8 pa3){
  #pragma unroll
  for(int d0=0;d0<2;++d0){s16x4 lo[4],hi[4];
    #pragma unroll
    for(int ks=0;ks<4;++ks){
      asm volatile("ds_read_b64_tr_b16 %0,%1 offset:%c2":"=&v"(lo[ks]):"v"(vb),"i"(d0*4096+ks*1024):"memory");
      asm volatile("ds_read_b64_tr_b16 %0,%1 offset:%c2":"=&v"(hi[ks]):"v"(vb),"i"(d0*4096+ks*1024+512):"memory");}
    asm volatile("s_waitcnt lgkmcnt(0)":::"memory");SBAR();
    #define PK(k) (bf16x8){lo[k][0],lo[k][1],lo[k][2],lo[k][3],hi[k][0],hi[k][1],hi[k][2],hi[k][3]}
    o[d0]=__builtin_amdgcn_mfma_f32_32x32x16_bf16(pa0,PK(0),o[d0],0,0,0);
    o[d0]=__builtin_amdgcn_mfma_f32_32x32x16_bf16(pa1,PK(1),o[d0],0,0,0);
    o[d0]=__builtin_amdgcn_mfma_f32_32x32x16_bf16(pa2,PK(2),o[d0],0,0,0);
    o[d0]=__builtin_amdgcn_mfma_f32_32x32x16_bf16(pa3,PK(3),o[d0],0,0,0);
    #undef PK
  }
}

#ifndef ATTN_STORE16
#define ATTN_STORE16(p,v) (*(u32x4*)(p)=(v))
#endif
template<int THRL,bool FIXREF> __device__ __forceinline__ void attn_unit(const bf16*Qh,const bf16*__restrict__ Kh,const bf16*__restrict__ Vh,bf16*Oh,const int NT,char*shm,const float bound){
  const int tid=threadIdx.x,lane=tid&63,r32=lane&31,hi=lane>>5; const int wid=__builtin_amdgcn_readfirstlane(tid>>6);
  const bf16*Qw=Qh+(long)(wid*QBLK)*QP;
  const unsigned lds0=(unsigned)(uintptr_t)shm;
  float*wsf=(float*)(shm+LDS_WS)+wid*64;
  const bf16*ksrc=Kh+(long)lane*KP+wid*8;
  const bf16*vsrc=Vh+(long)(16*(wid&3)+(lane>>2))*KP+(wid>>2)*32+(lane&3)*8;
  const unsigned kdst=lds0+LDS_K+wid*1024, vdst=lds0+LDS_V+wid*1024;
  #define DMA_K(t,slot) glds16(ksrc+(long)(t)*KVBLK*KP,(unsigned)__builtin_amdgcn_readfirstlane(kdst+(slot)))
  #define DMA_V(t,slot) glds16(vsrc+(long)(t)*KVBLK*KP,(unsigned)__builtin_amdgcn_readfirstlane(vdst+(slot)))
  const int vb0=(int)(lds0+LDS_V)+((lane>>4)&1)*32+(lane&3)*8+(4*hi+((lane&15)>>2))*64;
  const char*Kbase=shm+LDS_K; bf16x8 kf[8];
  const lds_cptr shm3=(lds_cptr)shm; const lds_cptr kp0=shm3+LDS_K+hi*1024+r32*16; const lds_cptr vp0=shm3+LDS_V+((lane>>4)&1)*32+(lane&3)*8+(4*hi+((lane&15)>>2))*64;
  DMA_K(0,0);DMA_V(0,0);DMA_K(1,SLOTB);
  bf16x8 qr[4];
  #pragma unroll
  for(int d0=0;d0<4;++d0)qr[d0]=*reinterpret_cast<const bf16x8*>(&Qw[(long)r32*QP+d0*16+hi*8]);
  float mhat=0.f,l_reg=0.f;f32x16 o[2];o[0]=f32x16{};o[1]=f32x16{};f32x16 negm=f32x16{};asm volatile("":"+v"(negm));
  const int qrel=wid*QBLK+r32;
  #define CMASK(P0,P1,t) do{}while(0)
  bool resc=false;
  #define START(P0,P1) do{ const float rm=FIXREF?bound:rowmax(P0,P1); resc=false; \
    { const float dl=rm; mhat=fadd_s(mhat,dl); \
      _Pragma("unroll") for(int r=0;r<16;++r){P0[r]=fsub_s(P0[r],dl);P1[r]=fsub_s(P1[r],dl);} \
      _Pragma("unroll") for(int r=0;r<16;++r)negm[r]=-mhat; asm volatile("":"+v"(negm)); } \
    _Pragma("unroll") for(int r=0;r<16;++r)P0[r]=__builtin_amdgcn_exp2f(P0[r]); }while(0)
  #define RESC() do{ if(resc){ asm volatile("s_waitcnt lgkmcnt(0)":::"memory"); \
      _Pragma("unroll") for(int d_=0;d_<2;++d_) _Pragma("unroll") for(int r=0;r<16;++r)o[d_][r]*=wsf[crow(r,hi)]; } }while(0)
  f32x16 pA0,pA1,pB0,pB1;
  int sl_prev=0,sl_cur=0,sl_next=SLOTB;
  #define ROT() do{sl_prev=sl_cur;sl_cur=sl_next;sl_next=(sl_next==(NSLOT-1)*SLOTB)?0:sl_next+SLOTB;}while(0)
  DMA_K(2,2*SLOTB);
  WAIT_BAR(3);
  qkt(pA0,pA1,Kbase,qr,negm,r32,hi);asm volatile("s_nop 15\n\ts_nop 7":"+v"(pA0),"+v"(pA1));CMASK(pA0,pA1,0);
  START(pA0,pA1);
  _Pragma("unroll") for(int r=0;r<16;++r)pA1[r]=__builtin_amdgcn_exp2f(pA1[r]);
  WAIT_BAR(0);
  DMA_K(3,0);DMA_V(1,SLOTB);
  ROT();
  kload8(kf,kp0+sl_cur);
  WAIT_BAR(2);
  s16x4 vlo[8],vhi[8]; u32x4 pw0,pw1,pw2,pw3;
  #define PKW(P,B) cvtpk_s(P[B],P[B+1])
  #define PAF(k) __builtin_bit_cast(bf16x8,pw##k)
  #define VFR(i) (bf16x8){vlo[i][0],vlo[i][1],vlo[i][2],vlo[i][3],vhi[i][0],vhi[i][1],vhi[i][2],vhi[i][3]}
  #define PIN(x) asm volatile("":"+v"(x))
  #define MX3(a,b,c) __builtin_fmaxf(__builtin_fmaxf((a),(b)),(c))
  #define GAPA(MF,A0,A1,A2,A3,W0,W1,PW) do{ MF; sacc+=A0; sacc+=A1; sacc+=A2; sacc+=A3; PIN(sacc); W0; W1; PIN(PW); SBAR(); }while(0)
  #define EX(v) __builtin_amdgcn_exp2f(v)
  #define GAPB(MF,X,B) do{ MF; X[B]=EX(X[B]); X[B+1]=EX(X[B+1]); X[B+2]=EX(X[B+2]); X[B+3]=EX(X[B+3]); PIN(X); SBAR(); }while(0)
  #define VRD(i) do{ vlo[i]=vtr(vp_+(((i)>>2)*4096+((i)&3)*1024)); vhi[i]=vtr(vp_+(((i)>>2)*4096+((i)&3)*1024+512)); }while(0)
  #define KRD(G,j) do{ if(G){ kload2(kf,kp0+sl_next,j); SBAR(); } }while(0)
  #define STEP(C0,C1,P0,P1,t,GK,GV,GL) do{ SBAR(); \
    const lds_cptr vp_=vp0+sl_prev; \
    VRD(0); SBAR(); float sacc=(P0[0]+P0[1]); \
    GAPA(C0=__builtin_amdgcn_mfma_f32_32x32x16_bf16(kf[0],qr[0],negm,0,0,0), P0[2],P0[3],P0[4],P0[5],     pw0[0]=PKW(P0,0), pw0[1]=PKW(P0,2), pw0); \
    VRD(4); SBAR(); GAPA(C1=__builtin_amdgcn_mfma_f32_32x32x16_bf16(kf[1],qr[0],negm,0,0,0), P0[6],P0[7],P0[8],P0[9],     pw0[2]=PKW(P0,4), pw0[3]=PKW(P0,6), pw0); \
    VRD(1); SBAR(); GAPA(C0=__builtin_amdgcn_mfma_f32_32x32x16_bf16(kf[2],qr[1],C0,0,0,0),   P0[10],P0[11],P0[12],P0[13], pw1[0]=PKW(P0,8), pw1[1]=PKW(P0,10), pw1); \
    VRD(5); SBAR(); GAPA(C1=__builtin_amdgcn_mfma_f32_32x32x16_bf16(kf[3],qr[1],C1,0,0,0),   P0[14],P0[15],P1[0],P1[1],   pw1[2]=PKW(P0,12),pw1[3]=PKW(P0,14), pw1); \
    VRD(2); SBAR(); GAPA(C0=__builtin_amdgcn_mfma_f32_32x32x16_bf16(kf[4],qr[2],C0,0,0,0),   P1[2],P1[3],P1[4],P1[5],     pw2[0]=PKW(P1,0), pw2[1]=PKW(P1,2), pw2); \
    VRD(6); SBAR(); GAPA(C1=__builtin_amdgcn_mfma_f32_32x32x16_bf16(kf[5],qr[2],C1,0,0,0),   P1[6],P1[7],P1[8],P1[9],     pw2[2]=PKW(P1,4), pw2[3]=PKW(P1,6), pw2); \
    VRD(3); SBAR(); GAPA(C0=__builtin_amdgcn_mfma_f32_32x32x16_bf16(kf[6],qr[3],C0,0,0,0),   P1[10],P1[11],P1[12],P1[13], pw3[0]=PKW(P1,8), pw3[1]=PKW(P1,10), pw3); \
    VRD(7); SBAR(); GAPA(C1=__builtin_amdgcn_mfma_f32_32x32x16_bf16(kf[7],qr[3],C1,0,0,0),   P1[14],P1[15],0.f,0.f,       pw3[2]=PKW(P1,12),pw3[3]=PKW(P1,14), pw3); \
    l_reg+=sacc; \
    if(GK){DMA_K((t)+3,sl_cur);} if(GV){DMA_V((t)+1,sl_next);} \
    CMASK(C0,C1,t); \
    if constexpr(!FIXREF){ float a=MX3(C0[0],C0[1],C1[0]),b=MX3(C0[2],C0[3],C1[1]); a=MX3(a,C1[2],C1[3]); \
      _Pragma("unroll") for(int r=4;r<16;r+=4){a=MX3(a,C0[r],C0[r+1]);b=MX3(b,C0[r+2],C0[r+3]);a=MX3(a,C1[r],C1[r+1]);b=MX3(b,C1[r+2],C1[r+3]);} \
      float rm=__builtin_fmaxf(a,b); { auto rr=__builtin_amdgcn_permlane32_swap(__float_as_uint(rm),__float_as_uint(rm),false,false); rm=__builtin_fmaxf(__uint_as_float(rr[0]),__uint_as_float(rr[1])); } \
      resc=false; \
      if(__builtin_expect(__any(rm>(float)THRL),0)){ const float dl=__builtin_fmaxf(rm,0.f); mhat+=dl; \
        _Pragma("unroll") for(int r=0;r<16;++r){C0[r]-=dl;C1[r]-=dl;} \
        _Pragma("unroll") for(int r=0;r<16;++r)negm[r]=-mhat; asm volatile("":"+v"(negm)); \
        const float f=__builtin_amdgcn_exp2f(-dl); l_reg*=f; if(hi==0)wsf[r32]=f; resc=true; } } \
    SBAR(); \
    GAPB(o[0]=__builtin_amdgcn_mfma_f32_32x32x16_bf16(PAF(0),VFR(0),o[0],0,0,0), C0,0); \
    GAPB(o[1]=__builtin_amdgcn_mfma_f32_32x32x16_bf16(PAF(0),VFR(4),o[1],0,0,0), C0,4); \
    KRD(GL,0); GAPB(o[0]=__builtin_amdgcn_mfma_f32_32x32x16_bf16(PAF(1),VFR(1),o[0],0,0,0), C0,8); \
    KRD(GL,1); GAPB(o[1]=__builtin_amdgcn_mfma_f32_32x32x16_bf16(PAF(1),VFR(5),o[1],0,0,0), C0,12); \
    KRD(GL,2); GAPB(o[0]=__builtin_amdgcn_mfma_f32_32x32x16_bf16(PAF(2),VFR(2),o[0],0,0,0), C1,0); \
    KRD(GL,3); GAPB(o[1]=__builtin_amdgcn_mfma_f32_32x32x16_bf16(PAF(2),VFR(6),o[1],0,0,0), C1,4); \
    GAPB(o[0]=__builtin_amdgcn_mfma_f32_32x32x16_bf16(PAF(3),VFR(3),o[0],0,0,0), C1,8); \
    GAPB(o[1]=__builtin_amdgcn_mfma_f32_32x32x16_bf16(PAF(3),VFR(7),o[1],0,0,0), C1,12); \
    }while(0)
  int t=1;
  #undef CMASK
  #define CMASK(P0,P1,t) do{}while(0)
  for(;t+5<NT;t+=2){
    STEP(pB0,pB1,pA0,pA1,t,true,true,true);     WAIT_BAR(2); RESC(); ROT();
    STEP(pA0,pA1,pB0,pB1,t+1,true,true,true);   WAIT_BAR(2); RESC(); ROT();
  }
  #undef CMASK
  #define CMASK(P0,P1,t) do{}while(0)
  #define ENDW(tt) do{ if((tt)+3<NT){WAIT_BAR(2);} else if((tt)+2<NT){WAIT_BAR(1);} else {WAIT_BAR(0);} }while(0)
  for(;t+1<NT;t+=2){
    STEP(pB0,pB1,pA0,pA1,t,(t+3<NT),(t+1<NT),(t+1<NT));       ENDW(t);   RESC(); ROT();
    STEP(pA0,pA1,pB0,pB1,t+1,(t+4<NT),(t+2<NT),(t+2<NT));     ENDW(t+1); RESC(); ROT();
  }
  STEP(pB0,pB1,pA0,pA1,NT-1,false,false,false); RESC();
  { float sacc=pB0[0]+pB0[1]; _Pragma("unroll") for(int r=2;r<16;++r)sacc+=pB0[r]; _Pragma("unroll") for(int r=0;r<16;++r)sacc+=pB1[r]; l_reg+=sacc;
    pw0=(u32x4){PKW(pB0,0),PKW(pB0,2),PKW(pB0,4),PKW(pB0,6)};pw1=(u32x4){PKW(pB0,8),PKW(pB0,10),PKW(pB0,12),PKW(pB0,14)};pw2=(u32x4){PKW(pB1,0),PKW(pB1,2),PKW(pB1,4),PKW(pB1,6)};pw3=(u32x4){PKW(pB1,8),PKW(pB1,10),PKW(pB1,12),PKW(pB1,14)};
    SBAR(); pv(o,vb0+sl_cur,PAF(0),PAF(1),PAF(2),PAF(3)); }
  #undef PKW
  #undef PAF
  #undef VFR
  #undef PIN
  #undef MX3
  #undef GAPA
  #undef GAPB
  #undef EX
  #undef VRD
  #undef KRD
  #undef STEP
  #undef ENDW
  {auto rr=__builtin_amdgcn_permlane32_swap(__float_as_uint(l_reg),__float_as_uint(l_reg),false,false);l_reg=__uint_as_float(rr[0])+__uint_as_float(rr[1]);}
  if(hi==0)wsf[32+r32]=l_reg;asm volatile("s_waitcnt lgkmcnt(0)":::"memory");
  float rli[16];
  #pragma unroll
  for(int r=0;r<16;++r)rli[r]=__builtin_amdgcn_rcpf(wsf[32+crow(r,hi)]);
  bf16*Ow=Oh+(long)(wid*QBLK)*OP;
  { bf16*stg=(bf16*)(shm+LDS_OST)+wid*2048;
    #pragma unroll
    for(int r=0;r<16;++r){const int orow=crow(r,hi);
      #pragma unroll
      for(int d0=0;d0<2;++d0)stg[orow*64+d0*32+r32]=__float2bfloat16(o[d0][r]*rli[r]);}
    asm volatile("s_waitcnt lgkmcnt(0)":::"memory");
    #pragma unroll
    for(int i=0;i<4;++i){const int row=i*8+(lane>>3),ch=lane&7; const u32x4 v=*(const u32x4*)(stg+row*64+ch*8); ATTN_STORE16(Ow+(long)row*OP+ch*8,v);} }
  asm volatile("s_waitcnt lgkmcnt(0)\n\ts_barrier":::"memory");
  #undef DMA_K
  #undef DMA_V
  #undef CMASK
  #undef START
  #undef RESC
  #undef ROT
}
#undef SBAR
#undef WAIT_BAR
}

__device__ __forceinline__ void attn_fast(const Params& p, int l, bool with_ctx, unsigned char* lds, int bid, int nb) {
    typedef attn_body::bf16 abf;
    const abf* P = (const abf*)(p.ws + WS_P); abf* Y = (abf*)(p.ws + WS_YMIX);
    float bound;
    { const int lane = threadIdx.x & 63; float gq = fabsf(p.in[21][l * 64 + lane]), gk = fabsf(p.in[22][l * 64 + lane]);
#pragma unroll
      for (int o = 1; o < 64; o <<= 1) { gq = fmaxf(gq, __shfl_xor(gq, o)); gk = fmaxf(gk, __shfl_xor(gk, o)); }
      bound = 64.f * gq * gk * C2 * 1.02f + 0.25f; }
    const bool fixref = bound < 40.f;
    const int nunits = with_ctx ? 520 : 512;
    for (int u = bid; u < nunits; u += nb) {
        int h, q0, k0, ntile;
        if (u < 512) { h = u >> 6; q0 = (u & 63) * 256; k0 = 0; ntile = R / 64; } else { h = u - 512; q0 = SEQ; k0 = SEQ; ntile = CTXL / 64; }
        const int kvh = h >> 2;
        const abf* Qh = P + (size_t)q0 * INC + C_AQ + h * 64; const abf* Kh = P + (size_t)k0 * INC + C_AK + kvh * 64; const abf* Vh = P + (size_t)k0 * INC + C_AV + kvh * 64; abf* Oh = Y + (size_t)q0 * D + 512 + h * 64;
        if (fixref) attn_body::attn_unit<8, true>(Qh, Kh, Vh, Oh, ntile, (char*)lds, bound);
        else attn_body::attn_unit<8, false>(Qh, Kh, Vh, Oh, ntile, (char*)lds, 0.f);
    }
}

__device__ __forceinline__ int moe_segments(const Params& p, int* seg  , int* tile_e  ) {
    const unsigned* cnt = (const unsigned*)(p.ws + WS_CTL) + CW_CNT;
    if (threadIdx.x == 0) { int s = 0; for (int e = 0; e < 8; ++e) { const int c = (int)cnt[e]; tile_e[284 + e] = c; seg[e] = s; s += ((c + 255) >> 8) << 8; } seg[8] = s; }
    __syncthreads();
    const int total = seg[8];
    for (int t = threadIdx.x; t < total / 128; t += NT) { int e = 0; while (t * 128 >= seg[e + 1]) ++e; tile_e[t] = e; }
    __syncthreads();
    return total;
}
__device__ __forceinline__ int moe_row(const Params& p, const int* seg, const int* tile_e, int s, float& gate) {
    const int e = tile_e[s >> 7], pos = s - seg[e];
    if (pos < tile_e[284 + e]) { gate = ((const float*)(p.ws + WS_ASGG))[e * SEQ + pos]; return ((const int*)(p.ws + WS_ASGT))[e * SEQ + pos]; }
    gate = 0.f; return -1;
}
__device__ __forceinline__ void ph_final(const Params& p, int bid, int nb) {
    const int lane = threadIdx.x & 63, wave = threadIdx.x >> 6;
    const bf16* Y2 = (const bf16*)(p.ws + WS_Y2); const float* g = p.in[31];
    const int rstride = nb * 8;
    for (int row0 = bid * 8 + wave; row0 < SEQ; row0 += 4 * rstride) {
        u32x2 xv[4][4], ya[4][4], yb[4][4];
#pragma unroll
        for (int k = 0; k < 4; ++k) { const int row = row0 + k * rstride;
            if (row < SEQ) { const u32x2* xr = (const u32x2*)xb_row(p, 3, row) + lane;
                const u32x2* pa = (const u32x2*)(Y2 + (size_t)(2 * row) * D) + lane; const u32x2* pb = (const u32x2*)(Y2 + (size_t)(2 * row + 1) * D) + lane;
#pragma unroll
                for (int j = 0; j < 4; ++j) { xv[k][j] = xr[64 * j]; ya[k][j] = pa[64 * j]; yb[k][j] = pb[64 * j]; } } }
#pragma unroll
        for (int k = 0; k < 4; ++k) { const int row = row0 + k * rstride;
            if (row >= SEQ) break;
            f32x4* xr = (f32x4*)(p.out + (size_t)row * D) + lane; const f32x4* m5 = (const f32x4*)mod_vec(p, 1, row, 5) + lane;
            f32x4 v[4]; float ss = 0.f;
#pragma unroll
            for (int j = 0; j < 4; ++j) { const u32x2 a = ya[k][j], b = yb[k][j]; const f32x4 m = m5[64 * j];
                const f32x4 y = (f32x4){lo16(a.x) + lo16(b.x), hi16(a.x) + hi16(b.x), lo16(a.y) + lo16(b.y), hi16(a.y) + hi16(b.y)};
                v[j] = (f32x4){lo16(xv[k][j].x), hi16(xv[k][j].x), lo16(xv[k][j].y), hi16(xv[k][j].y)} + m * y; ss += (v[j].x * v[j].x + v[j].y * v[j].y) + (v[j].z * v[j].z + v[j].w * v[j].w); }
            const float r = rsqrtf(wave_sum(ss) * (1.f / D) + EPS);
#pragma unroll
            for (int j = 0; j < 4; ++j) xr[64 * j] = v[j] * r * ((const f32x4*)g)[lane + 64 * j];
        }
    }
}

#define LAS __attribute__((address_space(3)))
#define XB_TMO      128
#define XB_XCNT(j)  (256  + 64 * (j))
#define XB_XSUB(j)  (1280 + 64 * (j))
#define XB_XGEN(j)  (2304 + 64 * (j))
#define XB_TOP      3328
#define XB_TOPGEN   3392
#define XCD_BAR_WORDS 3456
#define XB_SPIN_CAP (1u << 18)
__device__ __forceinline__ unsigned xb_ld(unsigned* p)              { return __hip_atomic_load(p, __ATOMIC_RELAXED, __HIP_MEMORY_SCOPE_AGENT); }
__device__ __forceinline__ unsigned xb_add(unsigned* p, unsigned v) { return __hip_atomic_fetch_add(p, v, __ATOMIC_RELAXED, __HIP_MEMORY_SCOPE_AGENT); }
__device__ __forceinline__ unsigned xb_xcc_id() { return (unsigned)__builtin_amdgcn_s_getreg((3 << 11) | 20) & 0xFu; }
#define XB_SPIN(cond, bar) do { unsigned _sp = 0; while (cond) { __builtin_amdgcn_s_sleep(1); \
    if ((++_sp & 255u) == 0u) { if (xb_ld(&(bar)[XB_TMO])) break; if (_sp > XB_SPIN_CAP) { atomicAdd(&(bar)[XB_TMO], 1u); break; } } } } while (0)
struct XcdBarrier { unsigned* bar; unsigned x; volatile LAS unsigned* st; };
__device__ __forceinline__ XcdBarrier xcd_barrier_post(unsigned* bar, volatile LAS unsigned* st) {
    XcdBarrier b; b.bar = bar; b.x = xb_xcc_id(); b.st = st;
    if (threadIdx.x == 0) (void)xb_add(&bar[XB_XCNT(b.x)], 1u);
    return b;
}
__device__ __forceinline__ void xcd_barrier_complete(unsigned* bar, unsigned x, unsigned& nloc, unsigned& nx) {
    const unsigned G = gridDim.x * gridDim.y * gridDim.z;
    unsigned sum, cnt, mine, sp = 0u;
    for (;;) {
        sum = 0u; cnt = 0u; mine = 0u;
#pragma unroll
        for (unsigned j = 0; j < 16; ++j) { const unsigned c = xb_ld(&bar[XB_XCNT(j)]); sum += c; cnt += (c > 0u) ? 1u : 0u; mine = (j == x) ? c : mine; }
        if (sum == G) break;
        __builtin_amdgcn_s_sleep(1);
        if ((++sp & 255u) == 0u) { if (xb_ld(&bar[XB_TMO])) break; if (sp > XB_SPIN_CAP) { atomicAdd(&bar[XB_TMO], 1u); break; } }
    }
    nloc = mine > 0u ? mine : 1u; nx = cnt > 0u ? cnt : 1u;
}
__device__ __forceinline__ void xcd_barrier(const XcdBarrier& b) {
    asm volatile("s_waitcnt vmcnt(0)" ::: "memory");
    __syncthreads();
    if (threadIdx.x == 0) {
        unsigned* bar = b.bar;
        __builtin_amdgcn_s_waitcnt(0);
        unsigned nloc = b.st[0], nx = b.st[1];
        if (nloc == 0u) { xcd_barrier_complete(bar, b.x, nloc, nx); b.st[0] = nloc; b.st[1] = nx; }
        const unsigned old = xb_add(&bar[XB_XSUB(b.x)], 1u);
        const unsigned gen = old / nloc;
        if (old + 1u == (gen + 1u) * nloc) {
            __builtin_amdgcn_fence(__ATOMIC_RELEASE, "agent");
            asm volatile("s_waitcnt vmcnt(0)" ::: "memory");
            const unsigned og = xb_add(&bar[XB_TOP], 1u);
            const unsigned tg = og / nx;
            if (og + 1u == (tg + 1u) * nx) xb_add(&bar[XB_TOPGEN], 1u);
            else XB_SPIN(xb_ld(&bar[XB_TOPGEN]) == tg, bar);
            __builtin_amdgcn_fence(__ATOMIC_ACQUIRE, "agent");
            xb_add(&bar[XB_XGEN(b.x)], 1u);
            asm volatile("s_waitcnt vmcnt(0)" ::: "memory");
        } else {
            XB_SPIN(xb_ld(&bar[XB_XGEN(b.x)]) == gen, bar);
            __builtin_amdgcn_fence(__ATOMIC_ACQUIRE, "agent");
            asm volatile("s_waitcnt vmcnt(0)" ::: "memory");
        }
    }
    __syncthreads();
}

constexpr int LDS_BYTES = 147456;
constexpr int LDS_MISC = 131072 + 8192;
constexpr int NPHASE = 21;

__global__ void __launch_bounds__(NT, 2) k_run(Params p) {
    extern __shared__ __attribute__((aligned(16))) unsigned char lds[];
    float* sm = (float*)lds;
    const int bid = blockIdx.x, nb = gridDim.x;
    volatile LAS unsigned* misc = (volatile LAS unsigned*)((LAS unsigned char*)lds + LDS_MISC);
    if (threadIdx.x < 16) misc[threadIdx.x] = 0u;
    __syncthreads();
    XcdBarrier bar; bar.bar = (unsigned*)(p.ws + WS_CTL) + CW_BAR; bar.x = 0; bar.st = nullptr;
    if (p.ph_hi - p.ph_lo > 1) bar = xcd_barrier_post((unsigned*)(p.ws + WS_CTL) + CW_BAR, misc + 8);
    const int lo = p.ph_lo, hi = p.ph_hi;
#ifndef ONLY_PH
#define ONLY_PH -1
#endif
#define IN(k) ((ONLY_PH < 0 || ONLY_PH == (k)) && lo <= (k) && (k) < hi)
#define SEAM(k) do { if (IN(k) && IN((k) + 1)) xcd_barrier(bar); } while (0)
#ifndef PROBE_LO
#define PROBE_LO -1
#define PROBE_HI -1
#endif
#ifndef PROBE_MULT
#define PROBE_MULT 4
#endif
    unsigned long long pt0 = 0ull, pt1 = 0ull;
#ifdef PROBE_SUB
#define SUBSTAMP(k) do { xcd_barrier(bar); STAMP(k); } while (0)
#else
#define SUBSTAMP(k) do {} while (0)
#endif
#define STAMP(k) do { if ((k) == PROBE_LO) pt0 = wall_clock64(); if ((k) == PROBE_HI) pt1 = wall_clock64(); } while (0)

    STAMP(0); if (IN(0)) { ph_mod(p, sm, bid, nb); ph_tw(p, bid, nb); __syncthreads();
#ifdef PROBE_SUB
        xcd_barrier(bar); STAMP(100);
#endif
        ph_filt(p, sm, bid, nb); __syncthreads();
#ifdef PROBE_SUB
        xcd_barrier(bar); STAMP(101);
#endif
        ph_wconv(p, sm, 0, WCONV_DENSE, bid, nb); } SEAM(0);
    STAMP(1); if (IN(1)) { ph_hfft(p, sm, (float*)(lds + LDS_MISC + 128), bid, nb); ph_norm(p, 0, 0, 0, R, false, bid, nb); } SEAM(1);
    STAMP(2); if (IN(2)) { PgEpiP E{(bf16*)(p.ws + WS_P), INC}; run_gemm(lds, (const bf16*)(p.ws + WS_H), (const bf16*)(p.ws + WS_WIN), R, INC, D, E, nullptr, 0, bid, nb);
        wconv_in_tail(p, sm, (R / 256) * (INC / 256), WCONV_DENSE, WCONV_DENSE + 472, bid, nb); } SEAM(2);
    STAMP(3); if (IN(3)) { prep_qk(p, 0, R, bid, nb); SUBSTAMP(110); prep_hyz(p, 0, true, sm, bid, nb); SUBSTAMP(111); prep_retu(p, 0, lds, bid, nb); } SEAM(3);
    STAMP(4); if (IN(4)) { ph_retscan(p, 0, bid, nb);
        for (int u = bid; u < 512; u += nb) { if (u < 256) hconv_unit(p, 0, u, sm); else hconv_ctx_unit(p, u - 256, sm); }
        attn_fast(p, 0, true, lds, bid, nb); } SEAM(4);
    STAMP(5); if (IN(5)) { post_ret(p, 0, NCH, lds, bid, nb); SUBSTAMP(120); post_hy(p, 0, true, sm, bid, nb); } SEAM(5);
    STAMP(6); if (IN(6)) { PgEpiRes E{&p, 0, 2, 0, 1}; run_gemm(lds, (const bf16*)(p.ws + WS_YMIX), (const bf16*)(p.ws + WS_WOUT), R, D, D, E, nullptr, 0, bid, nb);
        wconv_in_tail(p, sm, (R / 256) * (D / 256), WCONV_DENSE + 472, WCONV_DENSE + 472 + 1008, bid, nb); } SEAM(6);
    STAMP(7); if (IN(7)) { ph_norm(p, 0, 1, 1, R, false, bid, nb); } SEAM(7);
    STAMP(8); if (IN(8)) { PgEpiSwi E{(bf16*)(p.ws + WS_HID)}; run_gemm(lds, (const bf16*)(p.ws + WS_H), (const bf16*)(p.ws + WS_WGU), R, 2 * FF, D, E, nullptr, 0, bid, nb); } SEAM(8);
    STAMP(9); if (IN(9)) { PgEpiRes E{&p, 0, 5, 1, 1}; run_gemm(lds, (const bf16*)(p.ws + WS_HID), (const bf16*)(p.ws + WS_WDN), R, D, FF, E, nullptr, 0, bid, nb);
        wconv_in_tail(p, sm, (R / 256) * (D / 256), WCONV_DENSE + 472 + 1008, WCONV_ALL, bid, nb); } SEAM(9);
    STAMP(10); if (IN(10)) { ph_norm(p, 1, 0, 1, R, false, bid, nb); } SEAM(10);
    STAMP(11); if (IN(11)) { PgEpiP E{(bf16*)(p.ws + WS_P), INC}; run_gemm(lds, (const bf16*)(p.ws + WS_H), (const bf16*)(p.ws + WS_WIN) + (size_t)INC * D, R, INC, D, E, nullptr, 0, bid, nb); } SEAM(11);
    STAMP(12); if (IN(12)) { prep_qk(p, 1, R, bid, nb); prep_hyz(p, 1, false, sm, bid, nb); prep_retu(p, 1, lds, bid, nb); } SEAM(12);
    STAMP(13); if (IN(13)) { ph_retscan(p, 1, bid, nb);
        for (int u = bid; u < 256; u += nb) hconv_unit(p, 1, u, sm);
        attn_fast(p, 1, false, lds, bid, nb); } SEAM(13);
    STAMP(14); if (IN(14)) { post_ret(p, 1, 128, lds, bid, nb); post_hy(p, 1, false, sm, bid, nb); } SEAM(14);
    STAMP(15); if (IN(15)) { PgEpiRes E{&p, 1, 2, 1, 3}; run_gemm(lds, (const bf16*)(p.ws + WS_YMIX), (const bf16*)(p.ws + WS_WOUT) + (size_t)D * D, SEQ, D, D, E, nullptr, 0, bid, nb); } SEAM(15);
    STAMP(16); if (IN(16)) { ph_norm(p, 1, 1, 3, SEQ, true, bid, nb, sm, WS_H2);
        if (bid == 0) ((u32x4*)((bf16*)(p.ws + WS_H2) + (size_t)SEQ * D))[threadIdx.x & 127] = (u32x4){0u, 0u, 0u, 0u}; } SEAM(16);
    STAMP(17);
    STAMP(18); if (IN(18)) { int* ism = (int*)(lds + LDS_MISC + 256); const int total = moe_segments(p, ism, ism + 16);
        PgEpiSwi E{(bf16*)(p.ws + WS_HIDM)}; run_gemm_gather(lds, (const bf16*)(p.ws + WS_H2), (const bf16*)(p.ws + WS_MOEW), total, 2 * FF, D, E, ism + 16, MOEW_E * 2, p, ism, bid, nb); } SEAM(18);
    STAMP(19); if (IN(19)) { int* ism = (int*)(lds + LDS_MISC + 256); const int total = moe_segments(p, ism, ism + 16);
        run_gemm_moedown(lds, (const bf16*)(p.ws + WS_HIDM), (const bf16*)(p.ws + WS_MOEW) + (size_t)5632 * 1024, total, D, FF, (bf16*)(p.ws + WS_Y2), ism + 16, MOEW_E * 2, p, ism, bid, nb); } SEAM(19);
    STAMP(20); if (IN(20)) { ph_final(p, bid, nb); }
STAMP(21);
    if (PROBE_LO >= 0 && bid == 0 && threadIdx.x == 0) { const unsigned long long te = wall_clock64(), dt = (pt1 - pt0) * PROBE_MULT; while (wall_clock64() - te < dt) __builtin_amdgcn_s_sleep(8); }
#undef IN
#undef SEAM
}

extern "C" void kernel_launch(void* const* d_in, const int* in_sizes, int n_in, void* d_out, int out_size, void* d_ws, size_t ws_size, hipStream_t stream) {
    static int grid = 0;
    if (grid == 0) {
        if (n_in != 32 || out_size != SEQ * D || ws_size < WS_END) { fprintf(stderr, "kernel_launch: unexpected problem (n_in %d out %d ws %zu)\n", n_in, out_size, ws_size); grid = -1; return; }
        int dev = 0, cus = 0;
        if (hipGetDevice(&dev) != hipSuccess || hipDeviceGetAttribute(&cus, hipDeviceAttributeMultiprocessorCount, dev) != hipSuccess) { grid = -1; return; }
        if (hipFuncSetAttribute((const void*)k_run, hipFuncAttributeMaxDynamicSharedMemorySize, LDS_BYTES) != hipSuccess) { fprintf(stderr, "kernel_launch: LDS attribute failed\n"); grid = -1; return; }
        int per_cu = 0; (void)hipOccupancyMaxActiveBlocksPerMultiprocessor(&per_cu, (const void*)k_run, NT, LDS_BYTES); (void)hipGetLastError();
        grid = cus > 0 ? cus : 256;
    }
    if (grid < 0) return;
    (void)hipMemsetAsync((char*)d_ws + WS_CTL, 0, 65536, stream);
    Params p; memset(&p, 0, sizeof(p));
    for (int i = 0; i < 32; ++i) p.in[i] = (const float*)d_in[i];
    p.out = (float*)d_out; p.ws = (unsigned char*)d_ws;
#if N_LAUNCH_MODE == 1
    p.ph_lo = 0; p.ph_hi = NPHASE;
    hipLaunchKernelGGL(k_run, dim3(grid), dim3(NT), LDS_BYTES, stream, p);
#else
    for (int ph = 0; ph < NPHASE; ++ph) { p.ph_lo = ph; p.ph_hi = ph + 1; hipLaunchKernelGGL(k_run, dim3(grid), dim3(NT), LDS_BYTES, stream, p); }
#endif
}
```

```cpp
#include <hip/hip_runtime.h>
#include <cstdio>
#include <cstdint>
#include <cstring>

typedef unsigned short bf16;
typedef unsigned u32x4 __attribute__((ext_vector_type(4)));
typedef unsigned u32x2 __attribute__((ext_vector_type(2)));
typedef float f32x4 __attribute__((ext_vector_type(4)));
typedef float f32x2 __attribute__((ext_vector_type(2)));

#ifndef N_LAUNCH_MODE
#define N_LAUNCH_MODE 1
#endif

constexpr int D = 1024, SEQ = 16384, CTXL = 256, R = SEQ + CTXL;
constexpr int INC = 2560, FF = 2816, NE = 8;
constexpr int C_HX0 = 0, C_HX1 = 256, C_HV = 512, C_RQ = 768, C_RK = 1024, C_RV = 1280, C_RG = 1536, C_AQ = 1792, C_AK = 2304, C_AV = 2432;
constexpr int FN = 32768, FM = 16384;
constexpr int NCH = 130;
constexpr float EPS = 1e-6f;
constexpr float C2 = 0.125f * 1.4426950408889634f;
constexpr int NT = 512;
constexpr int MOE_MAXROWS = 34560;

constexpr size_t MiB = 1u << 20;
constexpr size_t WS_CTL = 0, CTL_BYTES = MiB;
constexpr size_t WS_MOD = 1 * MiB;
constexpr size_t WS_TW = 1 * MiB + 128 * 1024;
constexpr size_t WS_TWN = 1 * MiB + 256 * 1024;
constexpr size_t WS_XC = 2 * MiB;
constexpr size_t WS_ASGT = 3 * MiB;
constexpr size_t WS_ASGG = 3 * MiB + 512 * 1024;
constexpr size_t WS_ROWD = 4 * MiB;
constexpr size_t WS_ROWG = 4 * MiB + 256 * 1024;
constexpr size_t WS_TAPSC = 5 * MiB;
constexpr size_t WS_ZC = 5 * MiB + 512 * 1024;
constexpr size_t WS_HSPEC = 8 * MiB;
constexpr size_t WS_ZT = 72 * MiB;
constexpr size_t WS_RU = 88 * MiB;
constexpr size_t WS_WIN = 105 * MiB;
constexpr size_t WS_WOUT = 115 * MiB;
constexpr size_t WS_WGU = 119 * MiB;
constexpr size_t WS_WDN = 130 * MiB;
constexpr size_t WS_H = 136 * MiB;
constexpr size_t WS_P = 169 * MiB;
constexpr size_t WS_YMIX = 251 * MiB;
constexpr size_t WS_HID = 169 * MiB;
constexpr size_t WS_MOEW = 306 * MiB;
constexpr size_t WS_H2 = 8 * MiB;
constexpr size_t WS_ROWS16 = 4 * MiB + 512 * 1024;
constexpr size_t WS_Y2 = 8 * MiB;
constexpr size_t WS_HIDM = 105 * MiB;
constexpr size_t WS_SPLITROW = 4 * MiB + 768 * 1024;
constexpr int PART_ROWS = 7 * 256;
constexpr size_t WS_PART = 291 * MiB;
constexpr size_t WS_END = 438 * MiB;
constexpr size_t MOEW_E = (size_t)(5632 * 1024 + 1024 * 2816);
static_assert(WS_HIDM + (size_t)MOE_MAXROWS * FF * 2 <= WS_MOEW, "map");
static_assert(WS_H2 + (size_t)(SEQ + 1) * D * 2 <= WS_HIDM, "map");
static_assert(WS_MOEW + 8 * MOEW_E * 2 <= WS_END, "map");
static_assert(WS_HIDM + (size_t)MOE_MAXROWS * FF * 2 <= WS_PART && WS_PART + (size_t)7 * PART_ROWS * D * 2 <= WS_MOEW + (size_t)5632 * 1024 * 2 && MOE_MAXROWS <= (128 + 7) * 256, "map");

constexpr int CW_CNT = 64;
constexpr int CW_BAR = 4096;

struct Params { const float* in[32]; float* out; unsigned char* ws; int ph_lo, ph_hi; };

__device__ __forceinline__ float bf2f(bf16 v) { return __uint_as_float((unsigned)v << 16); }
__device__ __forceinline__ unsigned pk2(float lo, float hi) { unsigned r; asm("v_cvt_pk_bf16_f32 %0, %1, %2" : "=v"(r) : "v"(lo), "v"(hi)); return r; }
__device__ __forceinline__ unsigned f2bf(float f) { return pk2(f, f) & 0xffffu; }
__device__ __forceinline__ float lo16(unsigned w) { return __uint_as_float(w << 16); }
__device__ __forceinline__ float hi16(unsigned w) { return __uint_as_float(w & 0xffff0000u); }
__device__ __forceinline__ void st16_wt(void* ptr, u32x4 v) { asm volatile("global_store_dwordx4 %0, %1, off sc1\n\ts_nop 1" :: "v"(ptr), "v"(v) : "memory"); }
__device__ __forceinline__ float wave_sum(float v) {
#pragma unroll
    for (int o = 1; o < 64; o <<= 1) v += __shfl_xor(v, o);
    return v;
}
__device__ __forceinline__ float silu_f(float x) { return x * __builtin_amdgcn_rcpf(1.f + __expf(-x)); }
__device__ __forceinline__ const float* xrow_f32(const Params& p, int xmode, int row) {
    if (xmode == 0) return row < SEQ ? p.in[0] + (size_t)row * D : p.in[2] + (size_t)(row - SEQ) * D;
    return row < SEQ ? p.out + (size_t)row * D : (const float*)(p.ws + WS_XC) + (size_t)(row - SEQ) * D;
}
__device__ __forceinline__ bf16* xb_row(const Params& p, int xmode, int row) { return (bf16*)(p.ws + (xmode == 3 ? WS_ZT : WS_HSPEC)) + (size_t)row * D; }
__device__ __forceinline__ const float* mod_vec(const Params& p, int l, int row, int j) {
    return (const float*)(p.ws + WS_MOD) + (size_t)((l * 2 + (row >= SEQ ? 1 : 0)) * 6 + j) * D;
}

__device__ __forceinline__ void ph_mod(const Params& p, float* sm, int bid, int nb) {
    const float* c = p.in[1]; const float* cc = p.in[3]; const float* W = p.in[4]; const float* B = p.in[5];
    float* MOD = (float*)(p.ws + WS_MOD);
    float* sc = sm; float* scc = sm + 1024; float* red = sm + 2048;
    const int tid = threadIdx.x;
    for (int i = tid; i < 1024; i += NT) { sc[i] = silu_f(c[i]); scc[i] = silu_f(cc[i]); }
    __syncthreads();
    for (int it = bid; it < 192; it += nb) {
        const int l = it / 96, cl = tid & 63, col = (it % 96) * 64 + cl, kg = tid >> 6;
        const float* w = W + (size_t)l * 1024 * 6144 + col;
        float a0 = 0.f, a1 = 0.f;
#pragma unroll 8
        for (int k = kg * 128; k < kg * 128 + 128; ++k) { const float wv = w[(size_t)k * 6144]; a0 += sc[k] * wv; a1 += scc[k] * wv; }
        red[(kg * 64 + cl) * 2] = a0; red[(kg * 64 + cl) * 2 + 1] = a1;
        __syncthreads();
        if (tid < 128) { const int c2 = tid & 63, s = tid >> 6; float sum = 0.f;
            for (int g = 0; g < 8; ++g) sum += red[(g * 64 + c2) * 2 + s];
            const int colg = (it % 96) * 64 + c2; MOD[(size_t)(l * 2 + s) * 6144 + colg] = sum + B[l * 6144 + colg]; }
        __syncthreads();
    }
}
__device__ __forceinline__ void ph_tw(const Params& p, int bid, int nb) {
    f32x2* TW = (f32x2*)(p.ws + WS_TW); f32x2* TWN = (f32x2*)(p.ws + WS_TWN);
    for (int k = bid * NT + threadIdx.x; k <= FM / 2; k += nb * NT) {
        float s, c;
        if (k < FM / 2) { const float x = (float)k * (2.0f / FM); s = sinpif(x); c = cospif(x); TW[k] = (f32x2){c, -s}; }
        { const float x = (float)k * (2.0f / FN); s = sinpif(x); c = cospif(x); TWN[k] = (f32x2){c, -s}; }
    }
}
__device__ __forceinline__ int gu_row(int n, int up) { return (n >> 7) * 256 + (n & 127) + (up ? 128 : 0); }
struct WcItem { const float* W; bf16* WT; int K, N, k0, n0, gu; };
constexpr int WCONV_DENSE = 2 * 160 + 2 * 64 + 3 * 176, WCONV_ALL = WCONV_DENSE + 8 * 3 * 176;
__device__ __forceinline__ WcItem wc_decode(const Params& p, int it) {
    constexpr int I_IN = 8 * 20, I_OUT = 8 * 8, I_GU = 8 * 22, PER_FFN = 3 * I_GU;
    WcItem d; int r = it;
    if (r < 2 * I_IN) { const int l = r / I_IN; r %= I_IN; d.W = p.in[8] + (size_t)l * D * INC; d.WT = (bf16*)(p.ws + WS_WIN) + (size_t)l * INC * D; d.K = D; d.N = INC; d.k0 = (r / 20) * 128; d.n0 = (r % 20) * 128; d.gu = -1; return d; }
    r -= 2 * I_IN;
    if (r < 2 * I_OUT) { const int l = r / I_OUT; r %= I_OUT; d.W = p.in[9] + (size_t)l * D * D; d.WT = (bf16*)(p.ws + WS_WOUT) + (size_t)l * D * D; d.K = D; d.N = D; d.k0 = (r / 8) * 128; d.n0 = (r % 8) * 128; d.gu = -1; return d; }
    r -= 2 * I_OUT;
    const int f = r / PER_FFN; r %= PER_FFN; const int which = r / I_GU; r %= I_GU;
    bf16* dgu; bf16* ddn;
    if (f == 0) { d.W = p.in[23 + which]; dgu = (bf16*)(p.ws + WS_WGU); ddn = (bf16*)(p.ws + WS_WDN); }
    else { d.W = p.in[28 + which] + (size_t)(f - 1) * D * FF; dgu = (bf16*)(p.ws + WS_MOEW) + (size_t)(f - 1) * MOEW_E; ddn = dgu + (size_t)5632 * 1024; }
    if (which < 2) { d.WT = dgu; d.K = D; d.N = FF; d.k0 = (r / 22) * 128; d.n0 = (r % 22) * 128; d.gu = which; }
    else { d.WT = ddn; d.K = FF; d.N = D; d.k0 = (r / 8) * 128; d.n0 = (r % 8) * 128; d.gu = -1; }
    return d;
}
__device__ __forceinline__ void ph_wconv(const Params& p, float* sm, int it_lo, int it_hi, int bid, int nb) {
    const int tid = threadIdx.x, lane = tid & 63, wave = tid >> 6;
    for (int it = it_lo + bid; it < it_hi; it += nb) {
        const WcItem d = wc_decode(p, it);
        float tv[32];
#pragma unroll
        for (int i = 0; i < 16; ++i)
#pragma unroll
            for (int j = 0; j < 2; ++j) tv[i * 2 + j] = d.W[(size_t)(d.k0 + wave * 16 + i) * d.N + d.n0 + lane + 64 * j];
#pragma unroll
        for (int i = 0; i < 16; ++i)
#pragma unroll
            for (int j = 0; j < 2; ++j) sm[(wave * 16 + i) * 129 + lane + 64 * j] = tv[i * 2 + j];
        __syncthreads();
        const int c = tid & 15;
#pragma unroll
        for (int j = 0; j < 4; ++j) { const int n = (tid >> 4) + 32 * j; const float* sp = sm + (8 * c) * 129 + n;
            const u32x4 o = (u32x4){pk2(sp[0 * 129], sp[1 * 129]), pk2(sp[2 * 129], sp[3 * 129]), pk2(sp[4 * 129], sp[5 * 129]), pk2(sp[6 * 129], sp[7 * 129])};
            const int dr = (d.gu < 0) ? (d.n0 + n) : gu_row(d.n0 + n, d.gu);
            *(u32x4*)(d.WT + (size_t)dr * d.K + d.k0 + 8 * c) = o; }
        __syncthreads();
    }
}
__device__ __forceinline__ void wconv_in_tail(const Params& p, float* sm, int nwg, int it_lo, int it_hi, int bid, int nb) {
    const int rounds = (nwg + nb - 1) / nb, busy_last = nwg - (rounds - 1) * nb;
    if (busy_last >= nb) { ph_wconv(p, sm, it_lo, it_hi, bid, nb); return; }
    if (bid >= busy_last) ph_wconv(p, sm, it_lo, it_hi, bid - busy_last, nb - busy_last);
}
typedef float f32x16_f __attribute__((ext_vector_type(16)));
typedef short bf16x8_f __attribute__((ext_vector_type(8)));
__device__ __forceinline__ void ph_filt(const Params& p, float* sm, int bid, int nb) {
    const float dlo = -4.605170185988091f / 1.5f, dhi = -4.605170185988091f / 0.3f;
    float* tile = sm; float* featL = sm; float* h1L = sm + 128 * 37; float* h2L = sm + 32 * 513;
    const int tid = threadIdx.x, lane = tid & 63, wave = tid >> 6, r = lane & 31, hh = lane >> 5;
    for (int it = bid; it < 264; it += nb) {
        int which, n_base, nsub;
        if (it < 256) { which = it >> 7; n_base = (it & 127) * 128; nsub = 4; } else { which = 2; n_base = (it - 256) * 32; nsub = 1; }
        const int l = (which == 2) ? 0 : which; const int Lf = (which == 2) ? CTXL : SEQ; const int NN = 2 * Lf;
        float* taps = (which == 2) ? (float*)(p.ws + WS_TAPSC) : (float*)(p.ws + WS_HSPEC) + (size_t)which * 256 * FN;
        const int cstride = (which == 2) ? NN : 2 * NN;
        const float* w1 = p.in[12] + l * 33 * 64; const float* w2 = p.in[14] + l * 4096; const float* w3 = p.in[16] + l * 64 * 512;
        const int t12 = wave & 1, sw = wave >> 1;
        float* w1L = h2L + 128 * 65; float* w2L = w1L + 34 * 64;
        bf16* h2b = (bf16*)w1L;
        {   float t1[5], t2[8];
#pragma unroll
            for (int q = 0; q < 5; ++q) { const int i = tid + q * NT; t1[q] = (i < 33 * 64) ? w1[i] : 0.f; }
#pragma unroll
            for (int q = 0; q < 8; ++q) t2[q] = w2[tid + q * NT];
#pragma unroll
            for (int q = 0; q < 5; ++q) { const int i = tid + q * NT; if (i < 34 * 64) w1L[i] = t1[q]; }
#pragma unroll
            for (int q = 0; q < 8; ++q) w2L[tid + q * NT] = t2[q]; }
        bf16x8_f w3f[2][4];
        {   float wv[2][4][8];
#pragma unroll
            for (int T = 0; T < 2; ++T)
#pragma unroll
                for (int ks = 0; ks < 4; ++ks)
#pragma unroll
                    for (int i = 0; i < 8; ++i) wv[T][ks][i] = w3[(16 * ks + 8 * hh + i) * 512 + wave * 64 + 32 * T + r];
#pragma unroll
            for (int T = 0; T < 2; ++T)
#pragma unroll
                for (int ks = 0; ks < 4; ++ks) { const u32x4 w = (u32x4){pk2(wv[T][ks][0], wv[T][ks][1]), pk2(wv[T][ks][2], wv[T][ks][3]), pk2(wv[T][ks][4], wv[T][ks][5]), pk2(wv[T][ks][6], wv[T][ks][7])};
                    w3f[T][ks] = __builtin_bit_cast(bf16x8_f, w); } }
        const float b1c = p.in[13][l * 64 + 32 * t12 + r], b2c = p.in[15][l * 64 + 32 * t12 + r];
        const float b3a = p.in[17][l * 512 + wave * 64 + r], b3b = p.in[17][l * 512 + wave * 64 + 32 + r];
        const float* frq = p.in[18] + l * 64;
        const float invL1 = 1.f / (float)(Lf - 1);
        const int npos = nsub * 32;
        {
            for (int q = 0; q < nsub; ++q) { const int pos = (tid >> 4) + 32 * q, b = tid & 15, n = n_base + pos; const float band = 1e-4f + (float)b * ((15.f - 1e-4f) / 15.f);
                const float rev2 = (2.0f / (float)Lf) * (float)n * band;
                featL[pos * 37 + 1 + b] = cospif(rev2); featL[pos * 37 + 17 + b] = -sinpif(rev2);
                if (b == 0) { featL[pos * 37] = (float)n * invL1; featL[pos * 37 + 33] = 0.f; } }
        }
        __syncthreads();
        if (sw < nsub) {
            f32x16_f acc;
#pragma unroll
            for (int g = 0; g < 16; ++g) acc[g] = b1c;
#pragma unroll
            for (int ks = 0; ks < 17; ++ks) { const int k = 2 * ks + hh;
                acc = __builtin_amdgcn_mfma_f32_32x32x2f32(featL[(32 * sw + r) * 37 + k], w1L[k * 64 + 32 * t12 + r], acc, 0, 0, 0); }
#pragma unroll
            for (int g = 0; g < 16; ++g) h1L[(32 * sw + (g & 3) + 8 * (g >> 2) + 4 * hh) * 65 + 32 * t12 + r] = acc[g];
        }
        __syncthreads();
        for (int e = tid; e < npos * 64; e += NT) { const int pos = e >> 6, j = e & 63; h1L[pos * 65 + j] = sinpif(frq[j] * 0.3183098861837907f * h1L[pos * 65 + j]); }
        __syncthreads();
        if (sw < nsub) {
            f32x16_f acc;
#pragma unroll
            for (int g = 0; g < 16; ++g) acc[g] = b2c;
#pragma unroll
            for (int ks = 0; ks < 32; ++ks) acc = __builtin_amdgcn_mfma_f32_32x32x2f32(h1L[(32 * sw + r) * 65 + 2 * ks + hh], w2L[(2 * ks + hh) * 64 + 32 * t12 + r], acc, 0, 0, 0);
#pragma unroll
            for (int g = 0; g < 16; ++g) h2L[(32 * sw + (g & 3) + 8 * (g >> 2) + 4 * hh) * 65 + 32 * t12 + r] = acc[g];
        }
        __syncthreads();
        for (int e = tid; e < npos * 64; e += NT) { const int pos = e >> 6, j = e & 63; h2b[pos * 72 + j] = (bf16)f2bf(sinpif(frq[j] * 0.3183098861837907f * h2L[pos * 65 + j])); }
        __syncthreads();
#pragma unroll 1
        for (int sc = 0; sc < nsub; ++sc) {
            const int n0 = n_base + sc * 32; const bf16* h2s = h2b + (sc * 32 + r) * 72 + 8 * hh;
            {
#pragma unroll
                for (int T = 0; T < 2; ++T) { f32x16_f acc;
#pragma unroll
                    for (int g = 0; g < 16; ++g) acc[g] = T ? b3b : b3a;
#pragma unroll
                    for (int ks = 0; ks < 4; ++ks) acc = __builtin_amdgcn_mfma_f32_32x32x16_bf16(*(const bf16x8_f*)(h2s + 16 * ks), w3f[T][ks], acc, 0, 0, 0);
#pragma unroll
                    for (int g = 0; g < 16; ++g) tile[((g & 3) + 8 * (g >> 2) + 4 * hh) * 513 + wave * 64 + 32 * T + r] = acc[g]; }
            }
            __syncthreads();
            {
                const int pos = tid & 31, jg = tid >> 5, n = n0 + pos; const float t = (float)n * invL1;
#pragma unroll 4
                for (int jj = 0; jj < 32; ++jj) { const int j = jg * 32 + jj, dir = j >> 8, ch = j & 255;
                    const float delta = fabsf(dlo + (float)ch * ((dhi - dlo) / 255.f));
                    const float v = tile[pos * 513 + j] * __expf(-t * delta);
                    bf16* tb = (bf16*)taps + (size_t)ch * cstride; const bf16 vb = (bf16)f2bf(v);
                    if (dir == 0) tb[n] = vb; else { if (n >= 1) tb[NN - n] = vb; else tb[Lf] = 0; } }
            }
            __syncthreads();
        }
    }
}

__device__ __forceinline__ int brev14(int k) { return (int)(__brev((unsigned)k) >> 18); }
__device__ __forceinline__ int fphys(int i) { return i + (i >> 5) + (i >> 8); }
constexpr int FBUF = FM + FM / 32 + FM / 256;
constexpr float R32C[16] = {1.000000000f, 0.980785280f, 0.923879533f, 0.831469612f, 0.707106781f, 0.555570233f, 0.382683432f, 0.195090322f, 0.000000000f, -0.195090322f, -0.382683432f, -0.555570233f, -0.707106781f, -0.831469612f, -0.923879533f, -0.980785280f};
constexpr float R32S[16] = {0.000000000f, 0.195090322f, 0.382683432f, 0.555570233f, 0.707106781f, 0.831469612f, 0.923879533f, 0.980785280f, 1.000000000f, 0.980785280f, 0.923879533f, 0.831469612f, 0.707106781f, 0.555570233f, 0.382683432f, 0.195090322f};
__device__ __forceinline__ f32x2 cmul(f32x2 a, f32x2 b) { return (f32x2){a.x * b.x - a.y * b.y, a.x * b.y + a.y * b.x}; }
__device__ __forceinline__ f32x2 cmulc(f32x2 a, f32x2 b) { return (f32x2){a.x * b.x + a.y * b.y, a.y * b.x - a.x * b.y}; }
template <int NP, bool HAS_T> __device__ __forceinline__ void reg_dif(f32x2 (&x)[NP], const f32x2* Th) {
    constexpr int L = (NP == 32) ? 5 : 4;
#pragma unroll
    for (int s2 = 0; s2 < L; ++s2) { const int hl = NP >> (s2 + 1), lh = L - 1 - s2;
#pragma unroll
        for (int a = 0; a < NP; ++a) { if (a & hl) continue; const int q = a & (hl - 1), m = q * (16 / hl);
            const f32x2 u = x[a], v = x[a + hl]; x[a] = u + v; f32x2 d = u - v;
            if (HAS_T) d = cmul(d, cmul((f32x2){R32C[m], -R32S[m]}, Th[lh]));
            else if (q != 0) d = cmul(d, (f32x2){R32C[m], -R32S[m]});
            x[a + hl] = d; } }
}
template <int NP, bool HAS_T> __device__ __forceinline__ void reg_dit(f32x2 (&x)[NP], const f32x2* Th) {
    constexpr int L = (NP == 32) ? 5 : 4;
#pragma unroll
    for (int s2 = 0; s2 < L; ++s2) { const int hl = 1 << s2;
#pragma unroll
        for (int a = 0; a < NP; ++a) { if (a & hl) continue; const int q = a & (hl - 1), m = q * (16 / hl);
            const f32x2 u = x[a]; f32x2 v = x[a + hl];
            if (HAS_T) v = cmulc(v, cmul((f32x2){R32C[m], -R32S[m]}, Th[s2]));
            else if (q != 0) v = cmulc(v, (f32x2){R32C[m], -R32S[m]});
            x[a] = u + v; x[a + hl] = u - v; } }
}
__device__ __forceinline__ void fft_dif(f32x2* buf, const f32x2* TW) {
    const int tid = threadIdx.x;
#pragma unroll 1
    for (int c2 = 0; c2 < 2; ++c2) { const int j = tid + 512 * c2, base = j + (j >> 5) + (j >> 8); f32x2 x[16], Th[4];
#pragma unroll
        for (int lh = 0; lh < 4; ++lh) Th[lh] = TW[(j * 8) >> lh];
#pragma unroll
        for (int a = 0; a < 16; ++a) x[a] = buf[a * 1060 + base];
        reg_dif<16, true>(x, Th);
#pragma unroll
        for (int a = 0; a < 16; ++a) buf[a * 1060 + base] = x[a]; }
    __syncthreads();
    { const int g = tid >> 5, jp = tid & 31, base = g * 1060 + jp; f32x2 x[32], Th[5];
#pragma unroll
        for (int lh = 0; lh < 5; ++lh) Th[lh] = TW[(jp * 256) >> lh];
#pragma unroll
        for (int a = 0; a < 32; ++a) x[a] = buf[base + a * 33 + (a >> 3)];
        reg_dif<32, true>(x, Th);
#pragma unroll
        for (int a = 0; a < 32; ++a) buf[base + a * 33 + (a >> 3)] = x[a]; }
    __syncthreads();
    { const int base = tid * 33 + (tid >> 3); f32x2 x[32];
#pragma unroll
        for (int a = 0; a < 32; ++a) x[a] = buf[base + a];
        reg_dif<32, false>(x, nullptr);
#pragma unroll
        for (int a = 0; a < 32; ++a) buf[base + a] = x[a]; }
    __syncthreads();
}
__device__ __forceinline__ void fft_dit_inv(f32x2* buf, const f32x2* TW) {
    const int tid = threadIdx.x;
    { const int base = tid * 33 + (tid >> 3); f32x2 x[32];
#pragma unroll
        for (int a = 0; a < 32; ++a) x[a] = buf[base + a];
        reg_dit<32, false>(x, nullptr);
#pragma unroll
        for (int a = 0; a < 32; ++a) buf[base + a] = x[a]; }
    __syncthreads();
    { const int g = tid >> 5, jp = tid & 31, base = g * 1060 + jp; f32x2 x[32], Th[5];
#pragma unroll
        for (int lh = 0; lh < 5; ++lh) Th[lh] = TW[(jp * 256) >> lh];
#pragma unroll
        for (int a = 0; a < 32; ++a) x[a] = buf[base + a * 33 + (a >> 3)];
        reg_dit<32, true>(x, Th);
#pragma unroll
        for (int a = 0; a < 32; ++a) buf[base + a * 33 + (a >> 3)] = x[a]; }
    __syncthreads();
#pragma unroll 1
    for (int c2 = 0; c2 < 2; ++c2) { const int j = tid + 512 * c2, base = j + (j >> 5) + (j >> 8); f32x2 x[16], Th[4];
#pragma unroll
        for (int lh = 0; lh < 4; ++lh) Th[lh] = TW[(j * 8) >> lh];
#pragma unroll
        for (int a = 0; a < 16; ++a) x[a] = buf[a * 1060 + base];
        reg_dit<16, true>(x, Th);
#pragma unroll
        for (int a = 0; a < 16; ++a) buf[a * 1060 + base] = x[a]; }
    __syncthreads();
}
__device__ __forceinline__ void ph_hfft(const Params& p, float* sm, float* red, int bid, int nb) {
    f32x2* buf = (f32x2*)sm;
    const f32x2* TW = (const f32x2*)(p.ws + WS_TW); const f32x2* TWN = (const f32x2*)(p.ws + WS_TWN);
    const int tid = threadIdx.x;
    for (int u = bid; u < 512; u += nb) {
        unsigned* g = (unsigned*)((float*)(p.ws + WS_HSPEC) + (size_t)u * FN);
        float asum = 0.f;
        {   u32x4 tw4[8];
#pragma unroll
            for (int q = 0; q < 8; ++q) tw4[q] = ((const u32x4*)g)[tid + q * NT];
#pragma unroll
            for (int q = 0; q < 8; ++q)
#pragma unroll
                for (int j = 0; j < 4; ++j) { const unsigned w = tw4[q][j]; const f32x2 v = (f32x2){lo16(w), hi16(w)}; buf[fphys(4 * (tid + q * NT) + j)] = v; asum += fabsf(v.x) + fabsf(v.y); } }
        asum = wave_sum(asum);
        if ((tid & 63) == 0) red[tid >> 6] = asum;
        __syncthreads();
        float tot = 0.f;
#pragma unroll
        for (int w = 0; w < 8; ++w) tot += red[w];
        const float sc = 0.5f / (tot + EPS);
        fft_dif(buf, TW);
#pragma unroll 4
        for (int k = tid; k <= FM / 2; k += NT) {
            if (k == 0) { const f32x2 a = buf[0]; g[0] = pk2((a.x + a.y) * 2.f * sc, (a.x - a.y) * 2.f * sc); continue; }
            const int kk = FM - k; const f32x2 a = buf[fphys(brev14(k))], b = buf[fphys(brev14(kk))], w = TWN[k];
            const f32x2 E = (f32x2){a.x + b.x, a.y - b.y}, O = (f32x2){a.y + b.y, b.x - a.x};
            const f32x2 T = (f32x2){w.x * O.x - w.y * O.y, w.x * O.y + w.y * O.x};
            g[k] = pk2((E.x + T.x) * sc, (E.y + T.y) * sc);
            g[kk] = pk2((E.x - T.x) * sc, -(E.y - T.y) * sc);
        }
        __syncthreads();
    }
}
__device__ __forceinline__ void hconv_unit(const Params& p, int l, int ch, float* sm) {
    f32x2* buf = (f32x2*)sm;
    const f32x2* TW = (const f32x2*)(p.ws + WS_TW); const f32x2* TWN = (const f32x2*)(p.ws + WS_TWN);
    const unsigned* H = (const unsigned*)((const float*)(p.ws + WS_HSPEC) + (size_t)(l * 256 + ch) * FN);
    f32x2* z = (f32x2*)((float*)(p.ws + WS_ZT) + (size_t)ch * SEQ);
    const int tid = threadIdx.x;
    {   f32x4 z4[8];
#pragma unroll
        for (int q = 0; q < 8; ++q) z4[q] = ((const f32x4*)z)[tid + q * NT];
#pragma unroll
        for (int q = 0; q < 8; ++q) { const int n = 2 * (tid + q * NT); buf[fphys(n)] = (f32x2){z4[q].x, z4[q].y}; buf[fphys(n + 1)] = (f32x2){z4[q].z, z4[q].w}; }
#pragma unroll 8
        for (int n = SEQ / 2 + tid; n < FM; n += NT) buf[fphys(n)] = (f32x2){0.f, 0.f}; }
    __syncthreads();
    fft_dif(buf, TW);
#pragma unroll 8
    for (int k = tid; k <= FM / 2; k += NT) {
        if (k == 0) { const f32x2 a = buf[0]; const unsigned hw = H[0]; const f32x2 h = (f32x2){lo16(hw), hi16(hw)}; const float y0 = (a.x + a.y) * h.x, ym = (a.x - a.y) * h.y; buf[0] = (f32x2){0.5f * (y0 + ym), 0.5f * (y0 - ym)}; continue; }
        const int kk = FM - k, rk = fphys(brev14(k)), rkk = fphys(brev14(kk));
        const unsigned hw0 = H[k], hw1 = H[kk]; const f32x2 a = buf[rk], b = buf[rkk], w = TWN[k], hk = (f32x2){lo16(hw0), hi16(hw0)}, hkk = (f32x2){lo16(hw1), hi16(hw1)};
        const f32x2 E = (f32x2){0.5f * (a.x + b.x), 0.5f * (a.y - b.y)}, O = (f32x2){0.5f * (a.y + b.y), 0.5f * (b.x - a.x)};
        const f32x2 T = (f32x2){w.x * O.x - w.y * O.y, w.x * O.y + w.y * O.x};
        const f32x2 Xk = E + T, Xkk = (f32x2){E.x - T.x, -(E.y - T.y)};
        const f32x2 Yk = (f32x2){Xk.x * hk.x - Xk.y * hk.y, Xk.x * hk.y + Xk.y * hk.x};
        const f32x2 Ykk = (f32x2){Xkk.x * hkk.x - Xkk.y * hkk.y, Xkk.x * hkk.y + Xkk.y * hkk.x};
        const f32x2 Ey = (f32x2){0.5f * (Yk.x + Ykk.x), 0.5f * (Yk.y - Ykk.y)};
        const f32x2 Dy = (f32x2){0.5f * (Yk.x - Ykk.x), 0.5f * (Yk.y + Ykk.y)};
        const f32x2 Oy = (f32x2){w.x * Dy.x + w.y * Dy.y, w.x * Dy.y - w.y * Dy.x};
        buf[rk] = (f32x2){Ey.x - Oy.y, Ey.y + Oy.x};
        if (kk != k) buf[rkk] = (f32x2){Ey.x + Oy.y, -(Ey.y - Oy.x)};
    }
    __syncthreads();
    fft_dit_inv(buf, TW);
    const float inv = 1.f / (float)FM;
#pragma unroll 8
    for (int n = tid; n < SEQ / 2; n += NT) { const f32x2 v = buf[fphys(n)]; z[n] = (f32x2){v.x * inv, v.y * inv}; }
    __syncthreads();
}
__device__ __forceinline__ void hconv_ctx_unit(const Params& p, int ch, float* sm) {
    float* zc = (float*)(p.ws + WS_ZC) + ch * CTXL; const bf16* tc = (const bf16*)(p.ws + WS_TAPSC) + ch * 512;
    float* zs = sm; float* ts = sm + 256; float* red = sm + 768;
    const int tid = threadIdx.x;
    if (tid < 256) zs[tid] = zc[tid];
    const float tv = bf2f(tc[tid]); ts[tid] = tv;
    const float a = wave_sum(fabsf(tv)); if ((tid & 63) == 0) red[tid >> 6] = a;
    __syncthreads();
    if (tid < 256) { float tot = 0.f;
#pragma unroll
        for (int w = 0; w < 8; ++w) tot += red[w];
        float acc = 0.f;
        for (int m = 0; m < 256; ++m) { const int lag = tid - m; acc += zs[m] * ts[lag >= 0 ? lag : 512 + lag]; }
        zc[tid] = acc / (tot + EPS); }
    __syncthreads();
}

__device__ __forceinline__ void ph_norm(const Params& p, int l, int which, int xmode, int nrows, bool route, int bid, int nb, float* sm = nullptr, size_t ws_out = WS_H) {
    const int lane = threadIdx.x & 63, wave = threadIdx.x >> 6;
    unsigned* lcnt = (unsigned*)sm; unsigned* lbase = lcnt + 8; int* r_row = (int*)sm + 16; int* r_e = r_row + 2048; int* r_pos = r_e + 4096; float* r_g = (float*)(r_pos + 4096);
    int nloc = 0; const int nloc_max = (nrows + nb * 8 - 1) / (nb * 8);
    float* rwL = sm + 16384;
    if (route) { if (threadIdx.x < 8) lcnt[threadIdx.x] = 0u; for (int i = threadIdx.x; i < 2048; i += NT) r_row[i] = -1;
        const float* rw = p.in[26];
        for (int i = threadIdx.x; i < 8192; i += NT) rwL[(i & 7) * 1024 + (i >> 3)] = rw[i];
        __syncthreads(); }
    const float* g = p.in[which ? 7 : 6] + l * D;
    bf16* H = (bf16*)(p.ws + ws_out);
    const int rstride = nb * 8;
    auto process_row = [&](f32x4 (&vv)[4], const int row) {
            const f32x4* sh = (const f32x4*)mod_vec(p, l, row, which ? 3 : 0) + lane; const f32x4* scv = (const f32x4*)mod_vec(p, l, row, which ? 4 : 1) + lane;
            float ss = 0.f;
#pragma unroll
            for (int j = 0; j < 4; ++j) ss += (vv[j].x * vv[j].x + vv[j].y * vv[j].y) + (vv[j].z * vv[j].z + vv[j].w * vv[j].w);
            const float r = rsqrtf(wave_sum(ss) * (1.f / D) + EPS);
            u32x2* o8 = (u32x2*)(H + (size_t)row * D) + lane;
#pragma unroll
            for (int j = 0; j < 4; ++j) { const f32x4 gg = ((const f32x4*)g)[lane + 64 * j], s1 = scv[64 * j], s0 = sh[64 * j];
                vv[j] = vv[j] * r * gg * (s1 + 1.f) + s0;
                o8[64 * j] = (u32x2){pk2(vv[j].x, vv[j].y), pk2(vv[j].z, vv[j].w)}; }
            if (route) {
                const float* rb = p.in[27];
                float lg[8];
#pragma unroll
                for (int e = 0; e < 8; ++e) { float a = 0.f;
#pragma unroll
                    for (int j = 0; j < 4; ++j) { const f32x4 w = *(const f32x4*)(rwL + e * 1024 + 4 * lane + 256 * j); a += (vv[j].x * w.x + vv[j].y * w.y) + (vv[j].z * w.z + vv[j].w * w.w); }
                    lg[e] = a; }
                {
                    float t4[4], t2[2], t1;
#pragma unroll
                    for (int e = 0; e < 4; ++e) { const float keep = (lane & 4) ? lg[e + 4] : lg[e], send = (lane & 4) ? lg[e] : lg[e + 4]; t4[e] = keep + __shfl_xor(send, 4); }
#pragma unroll
                    for (int e = 0; e < 2; ++e) { const float keep = (lane & 2) ? t4[e + 2] : t4[e], send = (lane & 2) ? t4[e] : t4[e + 2]; t2[e] = keep + __shfl_xor(send, 2); }
                    { const float keep = (lane & 1) ? t2[1] : t2[0], send = (lane & 1) ? t2[0] : t2[1]; t1 = keep + __shfl_xor(send, 1); }
                    t1 += __shfl_xor(t1, 8); t1 += __shfl_xor(t1, 16); t1 += __shfl_xor(t1, 32);
#pragma unroll
                    for (int e = 0; e < 8; ++e) lg[e] = __shfl(t1, e) + rb[e];
                }
                int i1 = 0; float v1 = lg[0];
#pragma unroll
                for (int e = 1; e < 8; ++e) if (lg[e] > v1) { v1 = lg[e]; i1 = e; }
                int i2 = -1; float v2 = -3.0e38f;
#pragma unroll
                for (int e = 0; e < 8; ++e) if (e != i1 && lg[e] > v2) { v2 = lg[e]; i2 = e; }
                if (i2 < 0) { i2 = (i1 + 1) & 7; v2 = v1; }
                const float ex = __expf(v2 - v1), g1 = 1.f / (1.f + ex), g2 = ex * g1;
                if (lane == 0 && nloc < 256) {
                    const int sl = nloc * 8 + wave;
                    r_e[2 * sl] = i1; r_e[2 * sl + 1] = i2; r_g[2 * sl] = g1; r_g[2 * sl + 1] = g2; r_row[sl] = row;
                    r_pos[2 * sl] = (int)atomicAdd(&lcnt[i1], 1u); r_pos[2 * sl + 1] = (int)atomicAdd(&lcnt[i2], 1u);
                }
                ++nloc;
            }
    };
    if (xmode & 1) {
        const int nlat = nrows < SEQ ? nrows : SEQ, nbat = route ? 4 : 8;
        for (int row0 = bid * 8 + wave; row0 < nlat; row0 += nbat * rstride) {
            u32x2 raw[8][4];
#pragma unroll
            for (int k = 0; k < 8; ++k) { const int row = row0 + k * rstride;
                if (k < nbat && row < nlat) { const u32x2* xb = (const u32x2*)xb_row(p, xmode, row) + lane;
#pragma unroll
                    for (int j = 0; j < 4; ++j) raw[k][j] = xb[64 * j]; } }
#pragma unroll
            for (int k = 0; k < 8; ++k) { const int row = row0 + k * rstride;
                if (k < nbat && row < nlat) { f32x4 vv[4];
#pragma unroll
                    for (int j = 0; j < 4; ++j) { const u32x2 w = raw[k][j]; vv[j] = (f32x4){lo16(w.x), hi16(w.x), lo16(w.y), hi16(w.y)}; }
                    process_row(vv, row); } }
        }
        for (int row = SEQ + bid * 8 + wave; row < nrows; row += rstride) {
            f32x4 vv[4]; const f32x4* xr = (const f32x4*)xrow_f32(p, xmode, row) + lane;
#pragma unroll
            for (int j = 0; j < 4; ++j) vv[j] = xr[64 * j];
            process_row(vv, row); }
    } else {
        for (int row0 = bid * 8 + wave; row0 < nrows; row0 += 4 * rstride) {
            f32x4 v[4][4];
#pragma unroll
            for (int k = 0; k < 4; ++k) { const int row = row0 + k * rstride;
                if (row < nrows) { const f32x4* xr = (const f32x4*)xrow_f32(p, xmode, row) + lane;
#pragma unroll
                    for (int j = 0; j < 4; ++j) v[k][j] = xr[64 * j]; } }
#pragma unroll
            for (int k = 0; k < 4; ++k) { const int row = row0 + k * rstride;
                if (row < nrows) process_row(v[k], row); }
        }
    }
    if (route) {
        __syncthreads();
        if (threadIdx.x < 8) lbase[threadIdx.x] = atomicAdd((unsigned*)(p.ws + WS_CTL) + CW_CNT + threadIdx.x, lcnt[threadIdx.x]);
        __syncthreads();
        int* at = (int*)(p.ws + WS_ASGT); float* ag = (float*)(p.ws + WS_ASGG);
        const int nslot = nloc_max * 8;
        for (int a2 = threadIdx.x; a2 < nslot * 2; a2 += NT) { const int sl = a2 >> 1, k = a2 & 1; const int row = r_row[sl];
            if (row >= 0) { const int e = r_e[a2]; const unsigned pos = lbase[e] + (unsigned)r_pos[a2]; at[e * SEQ + pos] = row * 2 + k; ag[e * SEQ + pos] = r_g[a2]; } }
        __syncthreads();
    }
}

namespace pg8 {
#define PG8_LAS __attribute__((address_space(3)))
typedef unsigned short bf16_t;
typedef short bf16x8 __attribute__((ext_vector_type(8)));
typedef float f32x4 __attribute__((ext_vector_type(4)));
typedef unsigned u32x4 __attribute__((ext_vector_type(4)));
constexpr int BM = 256, BK = 64, HALF = 128, HTB = HALF * BK * 2  , STAGE_BYTES = 8 * HTB, NXCD = 8, WGM = 8;

__host__ __device__ __forceinline__ int lds_byte(int r, int c) { const int st = (r >> 4) * 2 + (c >> 5), rr = r & 15, cc = c & 31, ob = rr * 64 + cc * 2; return st * 1024 + (ob ^ (((ob >> 9) & 1) << 5)); }
__host__ __device__ __forceinline__ void stage_rc(int b, int& R, int& C) { const int st = b / 1024, sb = b % 1024, swz = sb ^ (((sb >> 9) & 1) << 5); R = (st >> 1) * 16 + swz / 64; C = (st & 1) * 32 + (swz % 64) / 2; }
__host__ __device__ __forceinline__ int perm32(int rho) { const int n = rho >> 4, i = rho & 15; return 8 * (i >> 2) + 4 * n + (i & 3); }

struct Unit { int pm, pn, idx, ks; };
struct Gemm { const bf16_t* A; const bf16_t* Bt; int M, N, K; };

struct StaticOrder {
    int nM, nN, nwg, G, c; const int* tile_e = nullptr; size_t estride = 0;
    __host__ __device__ void init(int M, int N, int G_, int c_) { nM = M / BM; nN = N / BM; nwg = nM * nN; G = G_; c = c_; }
    __host__ __device__ bool next(int i, Unit& u) const {
        const long L = (long)i * G + c; if (L >= nwg) return false;
        int wgid = (int)L; { const int q = nwg / NXCD, r = nwg % NXCD, xcd = wgid % NXCD, off = wgid / NXCD; wgid = (xcd < r ? xcd * (q + 1) : r * (q + 1) + (xcd - r) * q) + off; }
        const int nig = WGM * nN, gid = wgid / nig, fm = gid * WGM, gsz = (nM - fm) < WGM ? (nM - fm) : WGM;
        u.pm = fm + ((wgid % nig) % gsz); u.pn = (wgid % nig) / gsz; u.idx = i; return true;
    }
    __device__ __forceinline__ size_t b_extra(const Unit& u) const { return tile_e ? (size_t)tile_e[2 * u.pm] * estride : (size_t)0; }
    __device__ __forceinline__ void a_ready(const Unit&) const {}
    __device__ __forceinline__ void done(const Unit&) const {}
    __device__ __forceinline__ int kt0(const Unit&) const { return 0; }
    __device__ __forceinline__ int ntl(const Unit&, int nt) const { return nt; }
};
struct SplitOrder : StaticOrder {
    int nMall;
    __device__ void init_split(int M, int N, int G_, int c_) { nMall = M / BM; const int mf = nMall < 128 ? nMall : 128; init(mf * BM, N, G_, c_); }
    __device__ bool next(int i, Unit& u) const {
        if (i < 2) { u.ks = -1; return StaticOrder::next(i, u); }
        if (i > 2) return false;
        const int q = c, nleft = nMall - nM; if (q >= nleft * 32) return false;
        u.pm = nM + (q >> 5); u.pn = (q >> 3) & 3; u.ks = q & 7; u.idx = 2; return true;
    }
    __device__ __forceinline__ int kt0(const Unit& u) const { return u.ks <= 0 ? 0 : (u.ks < 7 ? 6 * u.ks : 40); }
    __device__ __forceinline__ int ntl(const Unit& u, int nt) const { return u.ks < 0 ? nt : (u.ks < 6 ? 6 : 4); }
};

__device__ __forceinline__ unsigned cvt_pk_bf16(float lo, float hi) { unsigned r; asm volatile("v_cvt_pk_bf16_f32 %0, %1, %2" : "=v"(r) : "v"(lo), "v"(hi)); return r; }
template <class Epi, class Sched, bool ALIGN_EPI = false, bool SP2 = false, bool GATHER = false>
__device__ __forceinline__ void gemm_phase(PG8_LAS unsigned char* lds, const Gemm g, const Sched& S, const Epi& E, const PG8_LAS unsigned short* grows = nullptr) {
    static_assert(!GATHER || SP2, "GATHER is wired into the SP2 loop only");
    int tid_ = threadIdx.x; asm volatile("" : "+v"(tid_));
    const int tid = tid_ & 511, wid = __builtin_amdgcn_readfirstlane(tid >> 6), lane = tid & 63, wr = wid >> 2, wc = wid & 3, fr = lane & 15, fq = lane >> 4;
    const int K = g.K, nt = K / BK;
    unsigned voffA[2], voffB[2]; int Rl[2], Cl[2];
#pragma unroll
    for (int i = 0; i < 2; ++i) { int R, C; stage_rc(tid * 16 + i * 8192, R, C); const int Rb = Epi::PERM ? ((R & ~31) + perm32(R & 31)) : R; Rl[i] = R; Cl[i] = C;
        voffA[i] = (unsigned)(R * K + C) * 2u; voffB[i] = (unsigned)(Rb * K + C) * 2u; }
    unsigned gc[2][2] = {{0u, 0u}, {0u, 0u}}, gn[2][2] = {{0u, 0u}, {0u, 0u}};
#define PG8_GOFF(dst, ui_) do { _Pragma("unroll") for (int _h = 0; _h < 2; ++_h) _Pragma("unroll") for (int _i = 0; _i < 2; ++_i) \
        dst[_h][_i] = (unsigned)grows[(ui_) * 256 + _h * HALF + Rl[_i]] * (unsigned)(K * 2) + (unsigned)Cl[_i] * 2u; } while (0)
    const size_t kstep = (size_t)(BK * 2);
    const size_t hstep = (size_t)HALF * K * 2;
    const size_t tstep = 2 * hstep;
    const unsigned ldsw = (unsigned)wid * 1024u;
    const int aoff = lds_byte(wr * 64 + fr, fq * 8), boff = lds_byte(wc * 32 + fr, fq * 8);
#define PG8_SA(b, h) (((b) * 2 + (h)) * HTB)
#define PG8_SB(b, h) ((4 + (b) * 2 + (h)) * HTB)
#define PG8_STAGE(bufoff, gbase, voff) do { _Pragma("unroll") for (int _i = 0; _i < 2; ++_i) \
        __builtin_amdgcn_global_load_lds((const unsigned*)((const char*)(gbase) + (voff)[_i]), (PG8_LAS unsigned*)(lds + (bufoff) + ldsw + _i * 8192), 16, 0, 0); } while (0)
#define PG8_STAGE_A(bufoff, ptr, half, nextsel) do { if constexpr (GATHER) { if (nextsel) PG8_STAGE(bufoff, ptr, gn[half]); else PG8_STAGE(bufoff, ptr, gc[half]); } \
        else PG8_STAGE(bufoff, (ptr) + (size_t)(half) * hstep, voffA); } while (0)
#define PG8_LDA(dst, b, h) do { _Pragma("unroll") for (int m = 0; m < 4; ++m) _Pragma("unroll") for (int k = 0; k < 2; ++k) dst[m][k] = *(const PG8_LAS bf16x8*)(lds + PG8_SA(b, h) + aoff + m * 2048 + k * 1024); } while (0)
#define PG8_LDB(dst, b, h) do { _Pragma("unroll") for (int n = 0; n < 2; ++n) _Pragma("unroll") for (int k = 0; k < 2; ++k) dst[n][k] = *(const PG8_LAS bf16x8*)(lds + PG8_SB(b, h) + boff + n * 2048 + k * 1024); } while (0)
#define PG8_MMA(ai, bj, At, Bt) do { __builtin_amdgcn_s_setprio(1); _Pragma("unroll") for (int m = 0; m < 4; ++m) _Pragma("unroll") for (int n = 0; n < 2; ++n) _Pragma("unroll") for (int k = 0; k < 2; ++k) \
        acc[ai][bj][m][n] = __builtin_amdgcn_mfma_f32_16x16x32_bf16(Bt[n][k], At[m][k], acc[ai][bj][m][n], 0, 0, 0); __builtin_amdgcn_s_setprio(0); } while (0)
#define PG8_WAIT_V(n) asm volatile("s_waitcnt vmcnt(" #n ")" ::: "memory")
#define PG8_WAIT_L(n) asm volatile("s_waitcnt lgkmcnt(" #n ")" ::: "memory")
#define PG8_BAR __builtin_amdgcn_s_barrier()
#define PG8_SCHED __builtin_amdgcn_sched_barrier(0)
    Unit cur, nxt; int ui = 0;
    if (!S.next(0, cur)) return;
    f32x4 acc[2][2][4][2];
#pragma unroll
    for (int a = 0; a < 2; ++a)
#pragma unroll
        for (int b = 0; b < 2; ++b)
#pragma unroll
            for (int m = 0; m < 4; ++m)
#pragma unroll
                for (int n = 0; n < 2; ++n) acc[a][b][m][n] = (f32x4){0.f, 0.f, 0.f, 0.f};
    bf16x8 At[4][2], B0[2][2], B1[2][2];
    const char* cA = (const char*)g.A + (GATHER ? (size_t)0 : (size_t)cur.pm * tstep) + (size_t)S.kt0(cur) * kstep; const char* cB = (const char*)g.Bt + (size_t)cur.pn * tstep + S.b_extra(cur) + (size_t)S.kt0(cur) * kstep;
    if constexpr (GATHER) { PG8_GOFF(gc, 0); }
    S.a_ready(cur);
    if constexpr (SP2) {
        PG8_STAGE(PG8_SB(0, 0), cB, voffB); PG8_STAGE(PG8_SB(0, 1), cB + hstep, voffB); PG8_STAGE_A(PG8_SA(0, 0), cA, 0, false); PG8_STAGE_A(PG8_SA(0, 1), cA, 1, false);
        if (wr == 1) PG8_BAR;
        PG8_WAIT_V(2); PG8_BAR;
        PG8_STAGE(PG8_SB(1, 0), cB + kstep, voffB); PG8_STAGE_A(PG8_SA(1, 0), cA + kstep, 0, false); PG8_STAGE(PG8_SB(1, 1), cB + hstep + kstep, voffB);
        PG8_WAIT_V(6); PG8_BAR;
    } else {
        PG8_STAGE(PG8_SB(0, 0), cB, voffB); PG8_STAGE(PG8_SA(0, 0), cA, voffA); PG8_STAGE(PG8_SB(0, 1), cB + hstep, voffB); PG8_STAGE(PG8_SA(0, 1), cA + hstep, voffA);
        if (wr == 1) PG8_BAR;
        PG8_WAIT_V(4); PG8_BAR;
        PG8_STAGE(PG8_SB(1, 0), cB + kstep, voffB); PG8_STAGE(PG8_SA(1, 0), cA + kstep, voffA); PG8_STAGE(PG8_SB(1, 1), cB + hstep + kstep, voffB);
        PG8_WAIT_V(6); PG8_BAR;
    }
    for (;;) {
        const bool has_next = S.next(ui + 1, nxt);
        const char* nA = has_next ? (const char*)g.A + (GATHER ? (size_t)0 : (size_t)nxt.pm * tstep) + (size_t)S.kt0(nxt) * kstep : cA; const char* nB = has_next ? (const char*)g.Bt + (size_t)nxt.pn * tstep + S.b_extra(nxt) + (size_t)S.kt0(nxt) * kstep : cB;
        const int ntc = S.ntl(cur, nt);
        for (int t = 0; t < ntc; t += 2) {
            const bool last = (t == ntc - 2);
            const char* a1 = cA + (size_t)(t + 1) * kstep;
            const char* a2 = last ? nA : cA + (size_t)(t + 2) * kstep; const char* b2 = last ? nB : cB + (size_t)(t + 2) * kstep;
            const char* a3 = a2 + kstep; const char* b3 = b2 + kstep;
            if (last && has_next) S.a_ready(nxt);
            if constexpr (GATHER) { if (last) { if (has_next) PG8_GOFF(gn, ui + 1); else { gn[0][0] = gc[0][0]; gn[0][1] = gc[0][1]; gn[1][0] = gc[1][0]; gn[1][1] = gc[1][1]; } } }
            if constexpr (SP2) {
            PG8_LDB(B0, 0, 0); PG8_LDB(B1, 0, 1); PG8_SCHED; PG8_LDA(At, 0, 0); PG8_STAGE_A(PG8_SA(1, 1), a1, 1, false);
            PG8_WAIT_V(8); PG8_WAIT_L(0); PG8_BAR; PG8_MMA(0, 0, At, B0); PG8_MMA(0, 1, At, B1); PG8_BAR; PG8_SCHED;
            PG8_LDA(At, 0, 1); PG8_STAGE(PG8_SB(0, 0), b2, voffB); PG8_STAGE(PG8_SB(0, 1), b2 + hstep, voffB); PG8_STAGE_A(PG8_SA(0, 0), a2, 0, last);
            PG8_WAIT_V(8); PG8_WAIT_L(0); PG8_BAR; PG8_MMA(1, 0, At, B0); PG8_MMA(1, 1, At, B1); PG8_BAR; PG8_SCHED;
            PG8_LDB(B0, 1, 0); PG8_LDB(B1, 1, 1); PG8_SCHED; PG8_LDA(At, 1, 0); PG8_STAGE_A(PG8_SA(0, 1), a2, 1, last);
            PG8_WAIT_V(8); PG8_WAIT_L(0); PG8_BAR; PG8_MMA(0, 0, At, B0); PG8_MMA(0, 1, At, B1); PG8_BAR; PG8_SCHED;
            PG8_LDA(At, 1, 1); PG8_STAGE(PG8_SB(1, 0), b3, voffB); PG8_STAGE(PG8_SB(1, 1), b3 + hstep, voffB); PG8_STAGE_A(PG8_SA(1, 0), a3, 0, last);
            PG8_WAIT_V(8); PG8_WAIT_L(0); PG8_BAR; PG8_MMA(1, 0, At, B0); PG8_MMA(1, 1, At, B1); PG8_BAR; PG8_SCHED;
            } else {
            PG8_LDB(B0, 0, 0); PG8_SCHED; PG8_LDA(At, 0, 0); PG8_STAGE(PG8_SA(1, 1), a1 + hstep, voffA);
            PG8_WAIT_L(8); PG8_BAR; PG8_WAIT_L(0); PG8_MMA(0, 0, At, B0); PG8_BAR; PG8_SCHED;
            PG8_LDB(B1, 0, 1); PG8_STAGE(PG8_SB(0, 0), b2, voffB);
            PG8_BAR; PG8_WAIT_L(0); PG8_MMA(0, 1, At, B1); PG8_BAR;
            PG8_LDA(At, 0, 1); PG8_STAGE(PG8_SA(0, 0), a2, voffA);
            PG8_BAR; PG8_WAIT_L(0); PG8_MMA(1, 0, At, B0); PG8_BAR; PG8_SCHED;
            PG8_STAGE(PG8_SB(0, 1), b2 + hstep, voffB);
            PG8_WAIT_V(6); PG8_BAR; PG8_MMA(1, 1, At, B1); PG8_BAR;
            PG8_LDB(B0, 1, 0); PG8_SCHED; PG8_LDA(At, 1, 0); PG8_STAGE(PG8_SA(0, 1), a2 + hstep, voffA);
            PG8_WAIT_L(8); PG8_BAR; PG8_WAIT_L(0); PG8_MMA(0, 0, At, B0); PG8_BAR; PG8_SCHED;
            PG8_LDB(B1, 1, 1); PG8_STAGE(PG8_SB(1, 0), b3, voffB);
            PG8_BAR; PG8_WAIT_L(0); PG8_MMA(0, 1, At, B1); PG8_BAR;
            PG8_LDA(At, 1, 1); PG8_STAGE(PG8_SA(1, 0), a3, voffA);
            PG8_BAR; PG8_WAIT_L(0); PG8_MMA(1, 0, At, B0); PG8_BAR; PG8_SCHED;
            PG8_STAGE(PG8_SB(1, 1), b3 + hstep, voffB);
            PG8_WAIT_V(6); PG8_BAR; PG8_MMA(1, 1, At, B1); PG8_BAR;
            }
        }
        if constexpr (ALIGN_EPI) { if (wr == 0) PG8_BAR; }
        if constexpr (!Epi::AFTER_DRAIN) { E(acc, cur, wr, wc, fr, fq); S.done(cur); }
        if (!has_next) break;
#pragma unroll
        for (int a = 0; a < 2; ++a)
#pragma unroll
            for (int b = 0; b < 2; ++b)
#pragma unroll
                for (int m = 0; m < 4; ++m)
#pragma unroll
                    for (int n = 0; n < 2; ++n) acc[a][b][m][n] = (f32x4){0.f, 0.f, 0.f, 0.f};
        cur = nxt; cA = nA; cB = nB; ++ui;
        if constexpr (GATHER) { gc[0][0] = gn[0][0]; gc[0][1] = gn[0][1]; gc[1][0] = gn[1][0]; gc[1][1] = gn[1][1]; }
        if constexpr (ALIGN_EPI) { if (wr == 1) PG8_BAR; }
    }
    PG8_WAIT_V(0);
    if constexpr (!ALIGN_EPI) { if (wr == 0) PG8_BAR; }
    PG8_BAR;
    if constexpr (Epi::AFTER_DRAIN) { E.fused(acc, cur, wr, wc, fr, fq, lds, wid, lane); S.done(cur); }
#undef PG8_SA
#undef PG8_SB
#undef PG8_STAGE
#undef PG8_STAGE_A
#undef PG8_GOFF
#undef PG8_LDA
#undef PG8_LDB
#undef PG8_MMA
#undef PG8_WAIT_V
#undef PG8_WAIT_L
#undef PG8_BAR
#undef PG8_SCHED
}
}
struct PgEpiP {
    static constexpr bool PERM = true, AFTER_DRAIN = false; bf16* O; int ldc;
    __device__ __forceinline__ void operator()(const pg8::f32x4 (&acc)[2][2][4][2], const pg8::Unit& u, int wr, int wc, int fr, int fq) const {
        const int row0 = u.pm * 256 + wr * 64 + fr, col0 = u.pn * 256 + wc * 32 + 8 * fq;
#pragma unroll
        for (int ai = 0; ai < 2; ++ai)
#pragma unroll
            for (int m = 0; m < 4; ++m) { bf16* rowp = O + (size_t)(row0 + ai * 128 + m * 16) * ldc + col0;
#pragma unroll
                for (int bj = 0; bj < 2; ++bj) { const f32x4 v0 = acc[ai][bj][m][0], v1 = acc[ai][bj][m][1];
                    st16_wt(rowp + bj * 128, (u32x4){pg8::cvt_pk_bf16(v0[0], v0[1]), pg8::cvt_pk_bf16(v0[2], v0[3]), pg8::cvt_pk_bf16(v1[0], v1[1]), pg8::cvt_pk_bf16(v1[2], v1[3])}); } }
    }
};
struct PgEpiRes {
    static constexpr bool PERM = true, AFTER_DRAIN = false; const Params* p; int l, gj, smode, dmode;
    __device__ __forceinline__ void operator()(const pg8::f32x4 (&acc)[2][2][4][2], const pg8::Unit& u, int wr, int wc, int fr, int fq) const {
        const int row0 = u.pm * 256 + wr * 64 + fr, col0 = u.pn * 256 + wc * 32 + 8 * fq;
        const bool lat = u.pm * 256 < SEQ;
        f32x4 mm[2][2];
        { const float* md = mod_vec(*p, l, u.pm * 256, gj) + col0;
#pragma unroll
          for (int bj = 0; bj < 2; ++bj)
#pragma unroll
              for (int n = 0; n < 2; ++n) mm[bj][n] = *(const f32x4*)(md + bj * 128 + 4 * n); }
#pragma unroll
        for (int ai = 0; ai < 2; ++ai)
#pragma unroll
            for (int m = 0; m < 4; ++m) { const int row = row0 + ai * 128 + m * 16;
#pragma unroll
                for (int bj = 0; bj < 2; ++bj) { const int col = col0 + bj * 128;
                    f32x4 s0, s1;
                    if ((smode & 1) && lat) { const u32x4 w = *(const u32x4*)(xb_row(*p, smode, row) + col);
                        s0 = (f32x4){lo16(w.x), hi16(w.x), lo16(w.y), hi16(w.y)}; s1 = (f32x4){lo16(w.z), hi16(w.z), lo16(w.w), hi16(w.w)}; }
                    else { const float* src = xrow_f32(*p, smode, row) + col; s0 = *(const f32x4*)src; s1 = *(const f32x4*)(src + 4); }
                    const f32x4 r0 = s0 + mm[bj][0] * acc[ai][bj][m][0], r1 = s1 + mm[bj][1] * acc[ai][bj][m][1];
                    if ((dmode & 1) && lat) st16_wt(xb_row(*p, dmode, row) + col, (u32x4){pk2(r0.x, r0.y), pk2(r0.z, r0.w), pk2(r1.x, r1.y), pk2(r1.z, r1.w)});
                    else { float* dst = (lat ? p->out + (size_t)row * D : (float*)(p->ws + WS_XC) + (size_t)(row - SEQ) * D) + col; *(f32x4*)dst = r0; *(f32x4*)(dst + 4) = r1; } } }
    }
};
struct PgEpiSwi {
    static constexpr bool PERM = true, AFTER_DRAIN = false; bf16* Hd;
    __device__ __forceinline__ void operator()(const pg8::f32x4 (&acc)[2][2][4][2], const pg8::Unit& u, int wr, int wc, int fr, int fq) const {
        const int row0 = u.pm * 256 + wr * 64 + fr, col0 = u.pn * 128 + wc * 32 + 8 * fq;
#pragma unroll
        for (int ai = 0; ai < 2; ++ai)
#pragma unroll
            for (int m = 0; m < 4; ++m) { const f32x4 g0 = acc[ai][0][m][0], g1 = acc[ai][0][m][1], u0 = acc[ai][1][m][0], u1 = acc[ai][1][m][1];
                st16_wt(Hd + (size_t)(row0 + ai * 128 + m * 16) * FF + col0, (u32x4){pg8::cvt_pk_bf16(silu_f(g0[0]) * u0[0], silu_f(g0[1]) * u0[1]), pg8::cvt_pk_bf16(silu_f(g0[2]) * u0[2], silu_f(g0[3]) * u0[3]),
                    pg8::cvt_pk_bf16(silu_f(g1[0]) * u1[0], silu_f(g1[1]) * u1[1]), pg8::cvt_pk_bf16(silu_f(g1[2]) * u1[2], silu_f(g1[3]) * u1[3])}); }
    }
};
struct PgEpiMoeDown {
    static constexpr bool PERM = true, AFTER_DRAIN = false; bf16* Y2; const int* rowd; const float* rowg; bf16* PART;
    __device__ __forceinline__ void operator()(const pg8::f32x4 (&acc)[2][2][4][2], const pg8::Unit& u, int wr, int wc, int fr, int fq) const {
        const int row0 = u.pm * 256 + wr * 64 + fr, col0 = u.pn * 256 + wc * 32 + 8 * fq;
#pragma unroll
        for (int ai = 0; ai < 2; ++ai)
#pragma unroll
            for (int m = 0; m < 4; ++m) { const int lr = u.idx * 256 + wr * 64 + fr + ai * 128 + m * 16; const int d = rowd[lr]; if (d < 0) continue; const float g = rowg[lr];
                bf16* rowp = (u.ks > 0 ? PART + (size_t)((u.ks - 1) * PART_ROWS + (u.pm - 128) * 256 + (lr - u.idx * 256)) * D : Y2 + (size_t)d * D) + col0;
#pragma unroll
                for (int bj = 0; bj < 2; ++bj) { const f32x4 v0 = acc[ai][bj][m][0] * g, v1 = acc[ai][bj][m][1] * g;
                    st16_wt(rowp + bj * 128, (u32x4){pg8::cvt_pk_bf16(v0[0], v0[1]), pg8::cvt_pk_bf16(v0[2], v0[3]), pg8::cvt_pk_bf16(v1[0], v1[1]), pg8::cvt_pk_bf16(v1[2], v1[3])}); } }
    }
};
__device__ __forceinline__ int moe_row(const Params& p, const int* seg, const int* tile_e, int s, float& gate);
template <class Epi>
__device__ __forceinline__ void run_gemm_gather(unsigned char* lds, const bf16* A, const bf16* Bt, int M, int N, int K, const Epi& E, const int* tile_e, size_t estride, const Params& p, const int* seg, int bid, int nb) {
    pg8::Gemm g{A, Bt, M, N, K}; pg8::StaticOrder S; S.init(M, N, nb, bid); S.tile_e = tile_e; S.estride = estride;
    __attribute__((address_space(3))) unsigned short* gr = (__attribute__((address_space(3))) unsigned short*)((__attribute__((address_space(3))) unsigned char*)lds + 131072);
    {
        int dd[12];
#pragma unroll
        for (int i = 0; i < 12; ++i) { pg8::Unit u; float gt; dd[i] = (S.next(i, u) && threadIdx.x < 256) ? moe_row(p, seg, tile_e, u.pm * 256 + threadIdx.x, gt) : -1; }
#pragma unroll
        for (int i = 0; i < 12; ++i) if (threadIdx.x < 256) gr[i * 256 + threadIdx.x] = (unsigned short)(dd[i] >= 0 ? (dd[i] >> 1) : SEQ);
    }
    __syncthreads();
    pg8::gemm_phase<Epi, pg8::StaticOrder, true, true, true>((__attribute__((address_space(3))) unsigned char*)lds, g, S, E, gr);
}
__device__ __forceinline__ void run_gemm_moedown(unsigned char* lds, const bf16* A, const bf16* Bt, int M, int N, int K, bf16* Y2, const int* tile_e, size_t estride, const Params& p, const int* seg, int bid, int nb) {
    pg8::Gemm g{A, Bt, M, N, K}; pg8::SplitOrder S; S.init_split(M, N, nb, bid); S.tile_e = tile_e; S.estride = estride;
    int* rd = (int*)(lds + 131072); float* rg = (float*)(lds + 131072 + 3 * 1024);
    {
        int dd[3]; float gg[3];
#pragma unroll
        for (int i = 0; i < 3; ++i) { pg8::Unit u; gg[i] = 0.f; const bool ok = S.next(i, u); dd[i] = (ok && threadIdx.x < 256) ? moe_row(p, seg, tile_e, u.pm * 256 + threadIdx.x, gg[i]) : -1;
            if (i == 2 && ok && u.ks == 0 && u.pn == 0 && threadIdx.x < 256 && dd[i] >= 0) ((int*)(p.ws + WS_SPLITROW))[dd[i]] = (u.pm - 128) * 256 + threadIdx.x; }
#pragma unroll
        for (int i = 0; i < 3; ++i) if (threadIdx.x < 256) { rd[i * 256 + threadIdx.x] = dd[i]; rg[i * 256 + threadIdx.x] = gg[i]; }
    }
    __syncthreads();
    PgEpiMoeDown E{Y2, rd, rg, (bf16*)(p.ws + WS_PART)};
    pg8::gemm_phase<PgEpiMoeDown, pg8::SplitOrder, true, true>((__attribute__((address_space(3))) unsigned char*)lds, g, S, E);
}
template <class Epi>
__device__ __forceinline__ void run_gemm(unsigned char* lds, const bf16* A, const bf16* Bt, int M, int N, int K, const Epi& E, const int* tile_e, size_t estride, int bid, int nb) {
    pg8::Gemm g{A, Bt, M, N, K}; pg8::StaticOrder S; S.init(M, N, nb, bid); S.tile_e = tile_e; S.estride = estride;
    pg8::gemm_phase<Epi, pg8::StaticOrder, true, true>((__attribute__((address_space(3))) unsigned char*)lds, g, S, E);
}

__device__ __forceinline__ u32x4 qk_head(u32x4 v, int row, const float (&g)[8], const float* tab, int sec, int ib, bool lowhalf, bool isq) {
    float x[8];
#pragma unroll
    for (int w = 0; w < 4; ++w) { x[2 * w] = lo16(v[w]); x[2 * w + 1] = hi16(v[w]); }
    float ss = 0.f;
#pragma unroll
    for (int e = 0; e < 8; ++e) ss += x[e] * x[e];
    ss += __shfl_xor(ss, 1); ss += __shfl_xor(ss, 2); ss += __shfl_xor(ss, 4);
    const float rs = rsqrtf(ss * (1.f / 64.f) + EPS);
#pragma unroll
    for (int e = 0; e < 8; ++e) x[e] = x[e] * rs * g[e];
    if (row < SEQ) {
        const int pos = sec ? (row & 63) : (row >> 6); const f32x4* tb = (const f32x4*)(tab + (pos * 16 + ib) * 2);
        const f32x4 t0 = tb[0], t1 = tb[1], t2 = tb[2], t3 = tb[3];
        const float cs[8] = {t0.x, t0.z, t1.x, t1.z, t2.x, t2.z, t3.x, t3.z}, sn[8] = {t0.y, t0.w, t1.y, t1.w, t2.y, t2.w, t3.y, t3.w};
#pragma unroll
        for (int e = 0; e < 8; ++e) { const float o = __shfl_xor(x[e], 2); x[e] = lowhalf ? x[e] * cs[e] - o * sn[e] : x[e] * cs[e] + o * sn[e]; }
    }
    if (isq) {
#pragma unroll
        for (int e = 0; e < 8; ++e) x[e] *= C2; }
    return (u32x4){pk2(x[0], x[1]), pk2(x[2], x[3]), pk2(x[4], x[5]), pk2(x[6], x[7])};
}
__device__ __forceinline__ void prep_qk(const Params& p, int l, int nrows, float* sm, int bid, int nb) {
    const int tid = threadIdx.x, lane = tid & 63, wave = tid >> 6, l8 = lane & 7;
    bf16* P = (bf16*)(p.ws + WS_P);
    for (int e = tid; e < 256 * 16; e += NT) { const int pos = e >> 4, i = e & 15; const float x = (float)pos * (exp2f(-(float)i * (13.287712379549449f / 16.f)) * 0.3183098861837907f);
        sm[2 * e] = cospif(x); sm[2 * e + 1] = sinpif(x); }
    float gq[8], gk[8];
#pragma unroll
    for (int e = 0; e < 8; ++e) { gq[e] = p.in[21][l * 64 + l8 * 8 + e]; gk[e] = p.in[22][l * 64 + l8 * 8 + e]; }
    __syncthreads();
    const int sec = l8 >> 2, ib = (l8 & 1) * 8; const bool lowhalf = !(l8 & 2);
    const int rstride = nb * 8;
    for (int row0 = bid * 8 + wave; row0 < nrows; row0 += 4 * rstride) {
        u32x4 qv[4], kv = (u32x4){0u, 0u, 0u, 0u};
#pragma unroll
        for (int k = 0; k < 4; ++k) { const int row = row0 + k * rstride; qv[k] = (u32x4){0u, 0u, 0u, 0u}; if (row < nrows) qv[k] = *(const u32x4*)(P + (size_t)row * INC + C_AQ + lane * 8); }
        const int krow = row0 + (lane >> 4) * rstride; const bool kok = krow < nrows;
        if (kok) kv = *(const u32x4*)(P + (size_t)krow * INC + C_AK + (lane & 15) * 8);
#pragma unroll
        for (int k = 0; k < 4; ++k) { const int row = row0 + k * rstride;
            if (row < nrows) *(u32x4*)(P + (size_t)row * INC + C_AQ + lane * 8) = qk_head(qv[k], row, gq, sm, sec, ib, lowhalf, true); }
        if (kok) *(u32x4*)(P + (size_t)krow * INC + C_AK + (lane & 15) * 8) = qk_head(kv, krow, gk, sm, sec, ib, lowhalf, false);
    }
    __syncthreads();
}
__device__ __forceinline__ float conv3(const bf16* P, const float* cw, const float* cb, int t, int lo, int hi, int col) {
    float a = cb[col] + cw[768 + col] * bf2f(P[(size_t)t * INC + col]);
    if (t - 1 >= lo) a += cw[col] * bf2f(P[(size_t)(t - 1) * INC + col]);
    if (t + 1 < hi) a += cw[1536 + col] * bf2f(P[(size_t)(t + 1) * INC + col]);
    return a;
}
__device__ __forceinline__ void prep_hyz(const Params& p, int l, bool with_ctx, float* sm, int bid, int nb) {
    const bf16* P = (const bf16*)(p.ws + WS_P);
    const float* cw = p.in[10] + l * 3 * 768; const float* cb = p.in[11] + l * 768;
    const int nitem = with_ctx ? 272 : 256, tid = threadIdx.x, cg = tid & 31, rg = tid >> 5, c0 = cg * 8;
    float* wsm = sm + 64 * 260;
    for (int e = tid; e < 3072; e += NT) wsm[e] = e < 2304 ? cw[e] : cb[e - 2304];
    __syncthreads();
    for (int item = nb - 1 - bid; item < nitem; item += nb) {
        const bool lat = item < 256; const int t0 = lat ? item * 64 : SEQ + (item - 256) * 16, nrows = lat ? 64 : 16, qs = lat ? 4 : 2;
        const int lo = lat ? 0 : SEQ, hi = lat ? SEQ : R;
        if (rg * 4 < nrows) {
            const int tr = t0 + rg * 4;
            u32x4 xv[2][6];
#pragma unroll
            for (int k = 0; k < 2; ++k)
#pragma unroll
                for (int i = 0; i < 6; ++i) { const int t = tr - 1 + i; xv[k][i] = (t >= lo && t < hi) ? *(const u32x4*)(P + (size_t)t * INC + (k ? C_HV : C_HX1) + c0) : (u32x4){0u, 0u, 0u, 0u}; }
            float z[4][8];
#pragma unroll
            for (int k = 0; k < 2; ++k) { const int cb0 = (k ? C_HV : C_HX1) + c0;
                float w[4][8];
#pragma unroll
                for (int a = 0; a < 4; ++a) { const f32x4 wa = *(const f32x4*)(wsm + a * 768 + cb0), wb2 = *(const f32x4*)(wsm + a * 768 + cb0 + 4);
                    w[a][0] = wa.x; w[a][1] = wa.y; w[a][2] = wa.z; w[a][3] = wa.w; w[a][4] = wb2.x; w[a][5] = wb2.y; w[a][6] = wb2.z; w[a][7] = wb2.w; }
#pragma unroll
                for (int r = 0; r < 4; ++r)
#pragma unroll
                    for (int j = 0; j < 8; ++j) { const unsigned x0 = xv[k][r][j >> 1], x1 = xv[k][r + 1][j >> 1], x2 = xv[k][r + 2][j >> 1];
                        const float a0 = (j & 1) ? hi16(x0) : lo16(x0), a1 = (j & 1) ? hi16(x1) : lo16(x1), a2 = (j & 1) ? hi16(x2) : lo16(x2);
                        const float u = w[3][j] + w[0][j] * a0 + w[1][j] * a1 + w[2][j] * a2;
                        z[r][j] = k ? z[r][j] * u : u; } }
#pragma unroll
            for (int r = 0; r < 4; ++r) { float* zr = sm + (rg * 4 + r) * 260 + c0; *(f32x4*)zr = (f32x4){z[r][0], z[r][1], z[r][2], z[r][3]}; *(f32x4*)(zr + 4) = (f32x4){z[r][4], z[r][5], z[r][6], z[r][7]}; }
        }
        __syncthreads();
#pragma unroll
        for (int k = 0; k < 8; ++k) { const int e4 = tid + k * NT, c2 = e4 >> qs, q = e4 & ((1 << qs) - 1);
            if (lat || k < 2) { const float* d = sm + (q * 4) * 260 + c2; const f32x4 v = (f32x4){d[0], d[260], d[520], d[780]};
                *(f32x4*)(lat ? (float*)(p.ws + WS_ZT) + (size_t)c2 * SEQ + t0 + q * 4 : (float*)(p.ws + WS_ZC) + c2 * CTXL + (t0 - SEQ) + q * 4) = v; } }
        __syncthreads();
    }
}
typedef short bf16x8_t __attribute__((ext_vector_type(8)));
typedef float f32x16_t __attribute__((ext_vector_type(16)));
__device__ __forceinline__ int crow32(int r, int hi) { return (r & 3) + 8 * (r >> 2) + 4 * hi; }
__device__ __forceinline__ void prep_retu(const Params& p, int l, unsigned char* smb, int bid, int nb) {
    const bf16* P = (const bf16*)(p.ws + WS_P);
    bf16* Ktf = (bf16*)smb; bf16* Ktb = Ktf + 64 * 136; bf16* Vt = Ktb + 64 * 136; float* wf = (float*)(Vt + 64 * 136); float* wb = wf + 128;
    const int tid = threadIdx.x, lane = tid & 63, wave = tid >> 6, r = lane & 31, hh = lane >> 5;
    for (int it = bid; it < NCH * 4; it += nb) {
        const int c = it >> 2, h = it & 3; const int r0 = c * 128;
        const float lgf = -__expf(p.in[20][l * 8 + h]), lgb = -__expf(p.in[20][l * 8 + 4 + h]);
        if (tid < 128) { wf[tid] = __expf(lgf * (float)(127 - tid)) * 0.125f; wb[tid] = __expf(lgb * (float)tid) * 0.125f; }
        __syncthreads();
        for (int e = tid; e < 128 * 8; e += NT) { const int m = e & 127, dc = (e >> 7) * 8;        const bf16* pr = P + (size_t)(r0 + m) * INC + h * 64 + dc;
            const u32x4 kw = *(const u32x4*)(pr + C_RK), vw = *(const u32x4*)(pr + C_RV); const float sf = wf[m], sb = wb[m];
#pragma unroll
            for (int w = 0; w < 4; ++w) { const float k0 = lo16(kw[w]), k1 = hi16(kw[w]);
                Ktf[(dc + 2 * w) * 136 + m] = (bf16)f2bf(k0 * sf); Ktf[(dc + 2 * w + 1) * 136 + m] = (bf16)f2bf(k1 * sf);
                Ktb[(dc + 2 * w) * 136 + m] = (bf16)f2bf(k0 * sb); Ktb[(dc + 2 * w + 1) * 136 + m] = (bf16)f2bf(k1 * sb);
                Vt[(dc + 2 * w) * 136 + m] = (bf16)(vw[w] & 0xffffu); Vt[(dc + 2 * w + 1) * 136 + m] = (bf16)(vw[w] >> 16); } }
        __syncthreads();
        {   const int dir = wave >> 2, ti = (wave >> 1) & 1, tj = wave & 1;
            const bf16* Ak = (dir ? Ktb : Ktf) + (32 * ti + r) * 136 + 8 * hh; const bf16* Bv = Vt + (32 * tj + r) * 136 + 8 * hh;
            f32x16_t acc = {0.f, 0.f, 0.f, 0.f, 0.f, 0.f, 0.f, 0.f, 0.f, 0.f, 0.f, 0.f, 0.f, 0.f, 0.f, 0.f};
#pragma unroll
            for (int ks = 0; ks < 8; ++ks) acc = __builtin_amdgcn_mfma_f32_32x32x16_bf16(*(const bf16x8_t*)(Ak + 16 * ks), *(const bf16x8_t*)(Bv + 16 * ks), acc, 0, 0, 0);
            float* U = (float*)(p.ws + WS_RU) + ((size_t)(dir * 4 + h) * NCH + c) * 4096;
#pragma unroll
            for (int g = 0; g < 16; ++g) U[(32 * ti + crow32(g, hh)) * 64 + 32 * tj + r] = acc[g];
        }
        __syncthreads();
    }
}
__device__ __forceinline__ void ph_retscan(const Params& p, int l, float* sm, int bid, int nb) {
    float* U = (float*)(p.ws + WS_RU);
    const int lane = threadIdx.x & 63, g = threadIdx.x >> 6;
    for (int ps = bid; ps < 512; ps += nb) {
        const int dh = ps >> 6, dir = dh >> 2, h = dh & 3, e = (ps & 63) * 64 + lane;
        const float lg = -__expf(p.in[20][l * 8 + dir * 4 + h]); const float Dc = __expf(lg * 128.f);
        float* u = U + (size_t)(dir * 4 + h) * NCH * 4096 + e;
        const float uc0 = u[(size_t)128 * 4096], uc1 = u[(size_t)129 * 4096];
        float* q = dir == 0 ? u : u + (size_t)127 * 4096; const long step = dir == 0 ? 4096 : -4096;
        float x[16];
#pragma unroll
        for (int i = 0; i < 16; ++i) x[i] = q[(long)(16 * g + i) * step];
        float t[16], acc = 0.f;
#pragma unroll
        for (int i = 0; i < 16; ++i) { t[i] = acc; acc = Dc * acc + x[i]; }
        sm[g * 64 + lane] = acc;
        __syncthreads();
        float D16 = Dc * Dc; D16 *= D16; D16 *= D16; D16 *= D16;
        float S = dir == 0 ? Dc * uc0 + uc1 : uc0 + Dc * uc1;
        for (int gg = 0; gg < g; ++gg) S = D16 * S + sm[gg * 64 + lane];
        float pw = 1.f;
#pragma unroll
        for (int i = 0; i < 16; ++i) { q[(long)(16 * g + i) * step] = pw * S + t[i]; pw *= Dc; }
        if (g == 0) { if (dir == 0) { u[(size_t)128 * 4096] = 0.f; u[(size_t)129 * 4096] = uc0; } else { u[(size_t)129 * 4096] = 0.f; u[(size_t)128 * 4096] = uc1; } }
        __syncthreads();
    }
}

__device__ __forceinline__ void post_ret(const Params& p, int l, int nchunks, unsigned char* smb, int bid, int nb) {
    const bf16* P = (const bf16*)(p.ws + WS_P); bf16* Y = (bf16*)(p.ws + WS_YMIX);
    bf16* Qs = (bf16*)smb; bf16* Ks = Qs + 128 * 72; bf16* Vt = Ks + 128 * 72; bf16* SPt = Vt + 64 * 136;
    bf16* Sb = SPt + 2 * 64 * 72; float* Of = (float*)Sb;
    float* pf = (float*)(Sb + 128 * 136); float* pb = pf + 128;
    const int tid = threadIdx.x, lane = tid & 63, wave = tid >> 6, r = lane & 31, hh = lane >> 5;
    for (int it = bid; it < nchunks * 4; it += nb) {
        const int c = it >> 2, h = it & 3, r0 = c * 128;
        const float lgf = -__expf(p.in[20][l * 8 + h]), lgb = -__expf(p.in[20][l * 8 + 4 + h]);
        if (tid < 128) { pf[tid] = __expf(lgf * (float)tid); pb[tid] = __expf(lgb * (float)tid); }
        const bf16* gr = P + (size_t)(r0 + (tid >> 2)) * INC + C_RG + h * 64 + (tid & 3) * 16;
        const u32x4 g0 = *(const u32x4*)gr, g1 = *(const u32x4*)(gr + 8);
        for (int e = tid; e < 128 * 8; e += NT) { const int m = e >> 3, dc = (e & 7) * 8; const bf16* pr = P + (size_t)(r0 + m) * INC + h * 64 + dc;
            *(u32x4*)(Qs + m * 72 + dc) = *(const u32x4*)(pr + C_RQ); *(u32x4*)(Ks + m * 72 + dc) = *(const u32x4*)(pr + C_RK);
            const u32x4 vw = *(const u32x4*)(pr + C_RV);
#pragma unroll
            for (int w = 0; w < 4; ++w) { Vt[(dc + 2 * w) * 136 + (m ^ dc)] = (bf16)(vw[w] & 0xffffu); Vt[(dc + 2 * w + 1) * 136 + (m ^ dc)] = (bf16)(vw[w] >> 16); } }
        for (int e = tid; e < 2 * 64 * 16; e += NT) { const int dir = e >> 10, d = (e >> 4) & 63, e4 = (e & 15) * 4;
            const f32x4 v = *(const f32x4*)((const float*)(p.ws + WS_RU) + ((size_t)(dir * 4 + h) * NCH + c) * 4096 + d * 64 + e4);
            bf16* dst = SPt + (dir * 64 + e4) * 72 + d; dst[0] = (bf16)f2bf(v.x); dst[72] = (bf16)f2bf(v.y); dst[144] = (bf16)f2bf(v.z); dst[216] = (bf16)f2bf(v.w); }
        __syncthreads();
        {
            const int ti = wave >> 1, tj0 = (wave & 1) * 2;
            const bf16* Aq = Qs + (32 * ti + r) * 72 + 8 * hh;
#pragma unroll
            for (int t2 = 0; t2 < 2; ++t2) { const int tj = tj0 + t2; const bf16* Bk = Ks + (32 * tj + r) * 72 + 8 * hh;
                f32x16_t acc = {0.f, 0.f, 0.f, 0.f, 0.f, 0.f, 0.f, 0.f, 0.f, 0.f, 0.f, 0.f, 0.f, 0.f, 0.f, 0.f};
#pragma unroll
                for (int ks = 0; ks < 4; ++ks) acc = __builtin_amdgcn_mfma_f32_32x32x16_bf16(*(const bf16x8_t*)(Aq + 16 * ks), *(const bf16x8_t*)(Bk + 16 * ks), acc, 0, 0, 0);
                const int m = 32 * tj + r;
#pragma unroll
                for (int g = 0; g < 16; ++g) { const int n = 32 * ti + crow32(g, hh);
                    const float f = (n > m) ? pf[n - m] : ((n < m) ? pb[m - n] : 2.f);
                    Sb[n * 136 + m] = (bf16)f2bf(acc[g] * 0.125f * f); } }
        }
        __syncthreads();
        f32x16_t accI = {0.f, 0.f, 0.f, 0.f, 0.f, 0.f, 0.f, 0.f, 0.f, 0.f, 0.f, 0.f, 0.f, 0.f, 0.f, 0.f}, accF = accI, accB = accI;
        const int ti = wave >> 1, tj = wave & 1;
        {   const bf16* As = Sb + (32 * ti + r) * 136 + 8 * hh; const bf16* Bv = Vt + (32 * tj + r) * 136; const int vsw = (((32 * tj + r) >> 3) & 7) << 3;
#pragma unroll
            for (int ks = 0; ks < 8; ++ks) accI = __builtin_amdgcn_mfma_f32_32x32x16_bf16(*(const bf16x8_t*)(As + 16 * ks), *(const bf16x8_t*)(Bv + ((16 * ks + 8 * hh) ^ vsw)), accI, 0, 0, 0);
            const bf16* Aq = Qs + (32 * ti + r) * 72 + 8 * hh; const bf16* Bf = SPt + (32 * tj + r) * 72 + 8 * hh; const bf16* Bb = SPt + (64 + 32 * tj + r) * 72 + 8 * hh;
#pragma unroll
            for (int ks = 0; ks < 4; ++ks) { const bf16x8_t aq = *(const bf16x8_t*)(Aq + 16 * ks);
                accF = __builtin_amdgcn_mfma_f32_32x32x16_bf16(aq, *(const bf16x8_t*)(Bf + 16 * ks), accF, 0, 0, 0);
                accB = __builtin_amdgcn_mfma_f32_32x32x16_bf16(aq, *(const bf16x8_t*)(Bb + 16 * ks), accB, 0, 0, 0); }
        }
        __syncthreads();
#pragma unroll
        for (int g = 0; g < 16; ++g) { const int n = 32 * ti + crow32(g, hh);
            const float xif = pf[n] * pf[1], xib = pb[127 - n] * pb[1];
            Of[n * 68 + 32 * tj + r] = accI[g] + xif * accF[g] + xib * accB[g]; }
        __syncthreads();
        {
            const int n = tid >> 2, eq = tid & 3;
            float acc[16];
#pragma unroll
            for (int w = 0; w < 4; ++w) { const f32x4 v = *(const f32x4*)(Of + n * 68 + eq * 16 + 4 * w); acc[4 * w] = v.x; acc[4 * w + 1] = v.y; acc[4 * w + 2] = v.z; acc[4 * w + 3] = v.w; }
            float sm1 = 0.f;
#pragma unroll
            for (int e = 0; e < 16; ++e) sm1 += acc[e];
            sm1 += __shfl_xor(sm1, 1); sm1 += __shfl_xor(sm1, 2);
            const float mu = sm1 * (1.f / 64.f); float vs = 0.f;
#pragma unroll
            for (int e = 0; e < 16; ++e) { acc[e] -= mu; vs += acc[e] * acc[e]; }
            vs += __shfl_xor(vs, 1); vs += __shfl_xor(vs, 2);
            const float rs = rsqrtf(vs * (1.f / 64.f) + EPS);
            u32x4 o0, o1;
#pragma unroll
            for (int w = 0; w < 4; ++w) { o0[w] = pk2(silu_f(lo16(g0[w])) * acc[2 * w] * rs, silu_f(hi16(g0[w])) * acc[2 * w + 1] * rs);
                o1[w] = pk2(silu_f(lo16(g1[w])) * acc[8 + 2 * w] * rs, silu_f(hi16(g1[w])) * acc[9 + 2 * w] * rs); }
            bf16* yo = Y + (size_t)(r0 + n) * D + 256 + h * 64 + eq * 16;
            *(u32x4*)yo = o0; *(u32x4*)(yo + 8) = o1;
        }
        __syncthreads();
    }
}
__device__ __forceinline__ void post_hy(const Params& p, int l, bool with_ctx, float* sm, int bid, int nb) {
    const bf16* P = (const bf16*)(p.ws + WS_P); bf16* Y = (bf16*)(p.ws + WS_YMIX);
    const float* cw = p.in[10] + l * 3 * 768; const float* cb = p.in[11] + l * 768;
    const int nitem = with_ctx ? 272 : 256, tid = threadIdx.x, cg = tid & 31, rg = tid >> 5, c0 = cg * 8;
    float* wsm = sm + 64 * 260;
    for (int e = tid; e < 3328; e += NT) wsm[e] = e < 2304 ? cw[e] : (e < 3072 ? cb[e - 2304] : p.in[19][l * 256 + e - 3072]);
    for (int item = nb - 1 - bid; item < nitem; item += nb) {
        const bool lat = item < 256; const int t0 = lat ? item * 64 : SEQ + (item - 256) * 16, nrows = lat ? 64 : 16, qs = lat ? 4 : 2;
        const int lo = lat ? 0 : SEQ, hi = lat ? SEQ : R;
        {   f32x4 zv[8];
#pragma unroll
            for (int k = 0; k < 8; ++k) { const int e4 = tid + k * NT, c2 = e4 >> qs, q = e4 & ((1 << qs) - 1);
                if (lat || k < 2) zv[k] = *(const f32x4*)(lat ? (const float*)(p.ws + WS_ZT) + (size_t)c2 * SEQ + t0 + q * 4 : (const float*)(p.ws + WS_ZC) + c2 * CTXL + (t0 - SEQ) + q * 4); }
#pragma unroll
            for (int k = 0; k < 8; ++k) { const int e4 = tid + k * NT, c2 = e4 >> qs, q = e4 & ((1 << qs) - 1);
                if (lat || k < 2) { float* d = sm + (q * 4) * 260 + c2; d[0] = zv[k].x; d[260] = zv[k].y; d[520] = zv[k].z; d[780] = zv[k].w; } } }
        __syncthreads();
        if (rg * 4 < nrows) {
            const int tr = t0 + rg * 4;
            u32x4 xv[3][6];
#pragma unroll
            for (int k = 0; k < 3; ++k)
#pragma unroll
                for (int i = 0; i < 6; ++i) { const int t = tr - 1 + i; xv[k][i] = (t >= lo && t < hi) ? *(const u32x4*)(P + (size_t)t * INC + k * 256 + c0) : (u32x4){0u, 0u, 0u, 0u}; }
            float prod[4][8];
#pragma unroll
            for (int kk = 0; kk < 3; ++kk) { const int k = kk == 2 ? 0 : kk + 1;
                float w[4][8];
#pragma unroll
                for (int a = 0; a < 4; ++a) { const f32x4 wa = *(const f32x4*)(wsm + a * 768 + k * 256 + c0), wb2 = *(const f32x4*)(wsm + a * 768 + k * 256 + c0 + 4);
                    w[a][0] = wa.x; w[a][1] = wa.y; w[a][2] = wa.z; w[a][3] = wa.w; w[a][4] = wb2.x; w[a][5] = wb2.y; w[a][6] = wb2.z; w[a][7] = wb2.w; }
                float hb[8];
                if (k == 0) { const f32x4 ha = *(const f32x4*)(wsm + 3072 + c0), hb2 = *(const f32x4*)(wsm + 3072 + c0 + 4); hb[0] = ha.x; hb[1] = ha.y; hb[2] = ha.z; hb[3] = ha.w; hb[4] = hb2.x; hb[5] = hb2.y; hb[6] = hb2.z; hb[7] = hb2.w; }
#pragma unroll
                for (int r = 0; r < 4; ++r) { float u[8];
#pragma unroll
                    for (int j = 0; j < 8; ++j) { const unsigned x0 = xv[k][r][j >> 1], x1 = xv[k][r + 1][j >> 1], x2 = xv[k][r + 2][j >> 1];
                        const float a0 = (j & 1) ? hi16(x0) : lo16(x0), a1 = (j & 1) ? hi16(x1) : lo16(x1), a2 = (j & 1) ? hi16(x2) : lo16(x2);
                        u[j] = w[3][j] + w[0][j] * a0 + w[1][j] * a1 + w[2][j] * a2; }
                    if (k == 1) {
#pragma unroll
                        for (int j = 0; j < 8; ++j) prod[r][j] = u[j]; }
                    else if (k == 2) {
#pragma unroll
                        for (int j = 0; j < 8; ++j) prod[r][j] *= u[j]; }
                    else { const float* zr = sm + (rg * 4 + r) * 260 + c0; const f32x4 za = *(const f32x4*)zr, zb = *(const f32x4*)(zr + 4);
                        const float zz[8] = {za.x, za.y, za.z, za.w, zb.x, zb.y, zb.z, zb.w}; float o[8];
#pragma unroll
                        for (int j = 0; j < 8; ++j) o[j] = u[j] * (zz[j] + hb[j] * prod[r][j]);
                        *(u32x4*)(Y + (size_t)(tr + r) * D + c0) = (u32x4){pk2(o[0], o[1]), pk2(o[2], o[3]), pk2(o[4], o[5]), pk2(o[6], o[7])}; } } }
        }
        __syncthreads();
    }
}

#include <hip/hip_bf16.h>
#include <cmath>
namespace attn_body {
using bf16=__hip_bfloat16;
using bf16x8=__attribute__((ext_vector_type(8)))short;
using s16x4=__attribute__((ext_vector_type(4)))short;
using f32x16=__attribute__((ext_vector_type(16)))float;
using u32x4=__attribute__((ext_vector_type(4)))unsigned;
constexpr int D=64;
constexpr int NW=8,QBLK=32,QB=QBLK*NW,KVBLK=64;
constexpr int QP=2560,KP=2560,OP=1024;
__device__ __forceinline__ int crow(int r,int hi){return (r&3)+8*(r>>2)+4*hi;}
#define SBAR() __builtin_amdgcn_sched_barrier(0)
__device__ __forceinline__ void cmask(f32x16&p0,f32x16&p1,int jb,int qrel,int hi){
  const float NEG=-INFINITY; int kb=64*jb+4*hi;
  #pragma unroll
  for(int r=0;r<16;++r){int kv=kb+(r&3)+8*(r>>2); if(kv>qrel)p0[r]=NEG; if(kv+32>qrel)p1[r]=NEG;}
}

constexpr int NSLOT=3, SLOTB=8192;
constexpr int LDS_K=0, LDS_V=NSLOT*SLOTB, LDS_WS=2*NSLOT*SLOTB, LDS_OST=LDS_WS+NW*64*4, LDS_BYTES=LDS_OST+NW*4096;
constexpr float C2=0.125f*1.4426950408889634f;
__device__ __forceinline__ void glds16(const void*gsrc,unsigned lds_dst){unsigned keep;
  asm volatile("s_mov_b32 %0, m0\n\ts_mov_b32 m0, %2\n\ts_nop 0\n\tglobal_load_lds_dwordx4 %1, off\n\ts_mov_b32 m0, %0":"=&s"(keep):"v"(gsrc),"s"(lds_dst):"memory");}
__device__ __forceinline__ float max3f(float a,float b,float c){float r;asm("v_max3_f32 %0, %1, %2, %3":"=v"(r):"v"(a),"v"(b),"v"(c));return r;}
__device__ __forceinline__ float max2f(float a,float b){float r;asm("v_max_f32_e32 %0, %1, %2":"=v"(r):"v"(a),"v"(b));return r;}
__device__ __forceinline__ float fadd_s(float a,float b){float r;asm("v_add_f32_e32 %0, %1, %2":"=v"(r):"v"(a),"v"(b));return r;}
__device__ __forceinline__ float fsub_s(float a,float b){float r;asm("v_sub_f32_e32 %0, %1, %2":"=v"(r):"v"(a),"v"(b));return r;}
typedef float f32x2_t __attribute__((ext_vector_type(2))); typedef __bf16 bf16x2_t __attribute__((ext_vector_type(2)));
__device__ __forceinline__ unsigned cvtpk_s(float lo,float hi){f32x2_t v={lo,hi};bf16x2_t b=__builtin_convertvector(v,bf16x2_t);return __builtin_bit_cast(unsigned,b);}
#define WAIT_BAR(N) asm volatile("s_waitcnt vmcnt(" #N ") lgkmcnt(0)\n\ts_barrier":::"memory")

__device__ __forceinline__ void qkt(f32x16&p0,f32x16&p1,const char*Kslot,const bf16x8*qr,const f32x16&negm,int r32,int hi){
  const char*kb=Kslot+hi*1024+r32*16;
  #pragma unroll
  for(int d0=0;d0<4;++d0){
    const bf16x8 b0=*reinterpret_cast<const bf16x8*>(kb+d0*2048);
    const bf16x8 b1=*reinterpret_cast<const bf16x8*>(kb+d0*2048+512);
    if(d0==0){p0=__builtin_amdgcn_mfma_f32_32x32x16_bf16(b0,qr[0],negm,0,0,0);p1=__builtin_amdgcn_mfma_f32_32x32x16_bf16(b1,qr[0],negm,0,0,0);}
    else{p0=__builtin_amdgcn_mfma_f32_32x32x16_bf16(b0,qr[d0],p0,0,0,0);p1=__builtin_amdgcn_mfma_f32_32x32x16_bf16(b1,qr[d0],p1,0,0,0);}}
}
typedef __attribute__((address_space(3))) const char* lds_cptr;
typedef short v4i16_t __attribute__((ext_vector_type(4)));
__device__ __forceinline__ void kload8(bf16x8*kf,lds_cptr kp){
  kf[0]=*(const __attribute__((address_space(3))) bf16x8*)(kp);      kf[1]=*(const __attribute__((address_space(3))) bf16x8*)(kp+512);
  kf[2]=*(const __attribute__((address_space(3))) bf16x8*)(kp+2048); kf[3]=*(const __attribute__((address_space(3))) bf16x8*)(kp+2560);
  kf[4]=*(const __attribute__((address_space(3))) bf16x8*)(kp+4096); kf[5]=*(const __attribute__((address_space(3))) bf16x8*)(kp+4608);
  kf[6]=*(const __attribute__((address_space(3))) bf16x8*)(kp+6144); kf[7]=*(const __attribute__((address_space(3))) bf16x8*)(kp+6656);
}
__device__ __forceinline__ void kload2(bf16x8*kf,lds_cptr kp,int j){ kf[2*j]=*(const __attribute__((address_space(3))) bf16x8*)(kp+j*2048); kf[2*j+1]=*(const __attribute__((address_space(3))) bf16x8*)(kp+j*2048+512); }
__device__ __forceinline__ s16x4 vtr(lds_cptr p){ return __builtin_bit_cast(s16x4,__builtin_amdgcn_ds_read_tr16_b64_v4i16((__attribute__((address_space(3))) v4i16_t*)p)); }
__device__ __forceinline__ float rowmax(const f32x16&p0,const f32x16&p1){
  float a=max3f(p0[0],p0[1],p1[0]),b=max3f(p0[2],p0[3],p1[1]);a=max3f(a,p1[2],p1[3]);
  #pragma unroll
  for(int r=4;r<16;r+=4){a=max3f(a,p0[r],p0[r+1]);b=max3f(b,p0[r+2],p0[r+3]);a=max3f(a,p1[r],p1[r+1]);b=max3f(b,p1[r+2],p1[r+3]);}
  const float m=max2f(a,b);
  auto rr=__builtin_amdgcn_permlane32_swap(__float_as_uint(m),__float_as_uint(m),false,false);
  return max2f(__uint_as_float(rr[0]),__uint_as_float(rr[1]));
}
__device__ __forceinline__ void pv(f32x16*o,int vb,bf16x8 pa0,bf16x8 pa1,bf16x8 pa2,bf16x8 pa3){
  #pragma unroll
  for(int d0=0;d0<2;++d0){s16x4 lo[4],hi[4];
    #pragma unroll
    for(int ks=0;ks<4;++ks){
      asm volatile("ds_read_b64_tr_b16 %0,%1 offset:%c2":"=&v"(lo[ks]):"v"(vb),"i"(d0*4096+ks*1024):"memory");
      asm volatile("ds_read_b64_tr_b16 %0,%1 offset:%c2":"=&v"(hi[ks]):"v"(vb),"i"(d0*4096+ks*1024+512):"memory");}
    asm volatile("s_waitcnt lgkmcnt(0)":::"memory");SBAR();
    #define PK(k) (bf16x8){lo[k][0],lo[k][1],lo[k][2],lo[k][3],hi[k][0],hi[k][1],hi[k][2],hi[k][3]}
    o[d0]=__builtin_amdgcn_mfma_f32_32x32x16_bf16(pa0,PK(0),o[d0],0,0,0);
    o[d0]=__builtin_amdgcn_mfma_f32_32x32x16_bf16(pa1,PK(1),o[d0],0,0,0);
    o[d0]=__builtin_amdgcn_mfma_f32_32x32x16_bf16(pa2,PK(2),o[d0],0,0,0);
    o[d0]=__builtin_amdgcn_mfma_f32_32x32x16_bf16(pa3,PK(3),o[d0],0,0,0);
    #undef PK
  }
}

#ifndef ATTN_STORE16
#define ATTN_STORE16(p,v) asm volatile("global_store_dwordx4 %0, %1, off sc1\n\ts_nop 1" :: "v"(p), "v"(v) : "memory")
#endif
template<int THRL,bool FIXREF> __device__ __forceinline__ void attn_unit(const bf16*Qh,const bf16*__restrict__ Kh,const bf16*__restrict__ Vh,bf16*Oh,const int NT,char*shm,const float bound){
  const int tid=threadIdx.x,lane=tid&63,r32=lane&31,hi=lane>>5; const int wid=__builtin_amdgcn_readfirstlane(tid>>6);
  const bf16*Qw=Qh+(long)(wid*QBLK)*QP;
  const unsigned lds0=(unsigned)(uintptr_t)shm;
  float*wsf=(float*)(shm+LDS_WS)+wid*64;
  const bf16*ksrc=Kh+(long)lane*KP+wid*8;
  const bf16*vsrc=Vh+(long)(16*(wid&3)+(lane>>2))*KP+(wid>>2)*32+(lane&3)*8;
  const unsigned kdst=lds0+LDS_K+wid*1024, vdst=lds0+LDS_V+wid*1024;
  #define DMA_K(t,slot) glds16(ksrc+(long)(t)*KVBLK*KP,(unsigned)__builtin_amdgcn_readfirstlane(kdst+(slot)))
  #define DMA_V(t,slot) glds16(vsrc+(long)(t)*KVBLK*KP,(unsigned)__builtin_amdgcn_readfirstlane(vdst+(slot)))
  const int vb0=(int)(lds0+LDS_V)+((lane>>4)&1)*32+(lane&3)*8+(4*hi+((lane&15)>>2))*64;
  const char*Kbase=shm+LDS_K; bf16x8 kf[8];
  const lds_cptr shm3=(lds_cptr)shm; const lds_cptr kp0=shm3+LDS_K+hi*1024+r32*16; const lds_cptr vp0=shm3+LDS_V+((lane>>4)&1)*32+(lane&3)*8+(4*hi+((lane&15)>>2))*64;
  DMA_K(0,0);DMA_V(0,0);DMA_K(1,SLOTB);
  bf16x8 qr[4];
  #pragma unroll
  for(int d0=0;d0<4;++d0)qr[d0]=*reinterpret_cast<const bf16x8*>(&Qw[(long)r32*QP+d0*16+hi*8]);
  float mhat=0.f,l_reg=0.f;f32x16 o[2];o[0]=f32x16{};o[1]=f32x16{};f32x16 negm=f32x16{};asm volatile("":"+v"(negm));
  const int qrel=wid*QBLK+r32;
  #define CMASK(P0,P1,t) do{}while(0)
  bool resc=false;
  #define START(P0,P1) do{ const float rm=FIXREF?bound:rowmax(P0,P1); resc=false; \
    { const float dl=rm; mhat=fadd_s(mhat,dl); \
      _Pragma("unroll") for(int r=0;r<16;++r){P0[r]=fsub_s(P0[r],dl);P1[r]=fsub_s(P1[r],dl);} \
      _Pragma("unroll") for(int r=0;r<16;++r)negm[r]=-mhat; asm volatile("":"+v"(negm)); } \
    _Pragma("unroll") for(int r=0;r<16;++r)P0[r]=__builtin_amdgcn_exp2f(P0[r]); }while(0)
  #define RESC() do{ if(resc){ asm volatile("s_waitcnt lgkmcnt(0)":::"memory"); \
      _Pragma("unroll") for(int d_=0;d_<2;++d_) _Pragma("unroll") for(int r=0;r<16;++r)o[d_][r]*=wsf[crow(r,hi)]; } }while(0)
  f32x16 pA0,pA1,pB0,pB1;
  int sl_prev=0,sl_cur=0,sl_next=SLOTB;
  #define ROT() do{sl_prev=sl_cur;sl_cur=sl_next;sl_next=(sl_next==(NSLOT-1)*SLOTB)?0:sl_next+SLOTB;}while(0)
  DMA_K(2,2*SLOTB);
  WAIT_BAR(3);
  qkt(pA0,pA1,Kbase,qr,negm,r32,hi);asm volatile("s_nop 15\n\ts_nop 7":"+v"(pA0),"+v"(pA1));CMASK(pA0,pA1,0);
  START(pA0,pA1);
  _Pragma("unroll") for(int r=0;r<16;++r)pA1[r]=__builtin_amdgcn_exp2f(pA1[r]);
  WAIT_BAR(0);
  DMA_K(3,0);DMA_V(1,SLOTB);
  ROT();
  kload8(kf,kp0+sl_cur);
  WAIT_BAR(2);
  s16x4 vlo[8],vhi[8]; u32x4 pw0,pw1,pw2,pw3;
  #define PKW(P,B) cvtpk_s(P[B],P[B+1])
  #define PAF(k) __builtin_bit_cast(bf16x8,pw##k)
  #define VFR(i) (bf16x8){vlo[i][0],vlo[i][1],vlo[i][2],vlo[i][3],vhi[i][0],vhi[i][1],vhi[i][2],vhi[i][3]}
  #define PIN(x) asm volatile("":"+v"(x))
  #define MX3(a,b,c) __builtin_fmaxf(__builtin_fmaxf((a),(b)),(c))
  #define GAPA(MF,A0,A1,A2,A3,W0,W1,PW) do{ MF; sacc+=A0; sacc+=A1; sacc+=A2; sacc+=A3; PIN(sacc); W0; W1; PIN(PW); SBAR(); }while(0)
  #define EX(v) __builtin_amdgcn_exp2f(v)
  #define GAPB(MF,X,B) do{ MF; X[B]=EX(X[B]); X[B+1]=EX(X[B+1]); X[B+2]=EX(X[B+2]); X[B+3]=EX(X[B+3]); PIN(X); SBAR(); }while(0)
  #define VRD(i) do{ vlo[i]=vtr(vp_+(((i)>>2)*4096+((i)&3)*1024)); vhi[i]=vtr(vp_+(((i)>>2)*4096+((i)&3)*1024+512)); }while(0)
  #define KRD(G,j) do{ if(G){ kload2(kf,kp0+sl_next,j); SBAR(); } }while(0)
  #define STEP(C0,C1,P0,P1,t,GK,GV,GL) do{ SBAR(); \
    const lds_cptr vp_=vp0+sl_prev; \
    VRD(0); SBAR(); float sacc=(P0[0]+P0[1]); \
    GAPA(C0=__builtin_amdgcn_mfma_f32_32x32x16_bf16(kf[0],qr[0],negm,0,0,0), P0[2],P0[3],P0[4],P0[5],     pw0[0]=PKW(P0,0), pw0[1]=PKW(P0,2), pw0); \
    VRD(4); SBAR(); GAPA(C1=__builtin_amdgcn_mfma_f32_32x32x16_bf16(kf[1],qr[0],negm,0,0,0), P0[6],P0[7],P0[8],P0[9],     pw0[2]=PKW(P0,4), pw0[3]=PKW(P0,6), pw0); \
    VRD(1); SBAR(); GAPA(C0=__builtin_amdgcn_mfma_f32_32x32x16_bf16(kf[2],qr[1],C0,0,0,0),   P0[10],P0[11],P0[12],P0[13], pw1[0]=PKW(P0,8), pw1[1]=PKW(P0,10), pw1); \
    VRD(5); SBAR(); GAPA(C1=__builtin_amdgcn_mfma_f32_32x32x16_bf16(kf[3],qr[1],C1,0,0,0),   P0[14],P0[15],P1[0],P1[1],   pw1[2]=PKW(P0,12),pw1[3]=PKW(P0,14), pw1); \
    VRD(2); SBAR(); GAPA(C0=__builtin_amdgcn_mfma_f32_32x32x16_bf16(kf[4],qr[2],C0,0,0,0),   P1[2],P1[3],P1[4],P1[5],     pw2[0]=PKW(P1,0), pw2[1]=PKW(P1,2), pw2); \
    VRD(6); SBAR(); GAPA(C1=__builtin_amdgcn_mfma_f32_32x32x16_bf16(kf[5],qr[2],C1,0,0,0),   P1[6],P1[7],P1[8],P1[9],     pw2[2]=PKW(P1,4), pw2[3]=PKW(P1,6), pw2); \
    VRD(3); SBAR(); GAPA(C0=__builtin_amdgcn_mfma_f32_32x32x16_bf16(kf[6],qr[3],C0,0,0,0),   P1[10],P1[11],P1[12],P1[13], pw3[0]=PKW(P1,8), pw3[1]=PKW(P1,10), pw3); \
    VRD(7); SBAR(); GAPA(C1=__builtin_amdgcn_mfma_f32_32x32x16_bf16(kf[7],qr[3],C1,0,0,0),   P1[14],P1[15],0.f,0.f,       pw3[2]=PKW(P1,12),pw3[3]=PKW(P1,14), pw3); \
    l_reg+=sacc; \
    if(GK){DMA_K((t)+3,sl_cur);} if(GV){DMA_V((t)+1,sl_next);} \
    CMASK(C0,C1,t); \
    if constexpr(!FIXREF){ float a=MX3(C0[0],C0[1],C1[0]),b=MX3(C0[2],C0[3],C1[1]); a=MX3(a,C1[2],C1[3]); \
      _Pragma("unroll") for(int r=4;r<16;r+=4){a=MX3(a,C0[r],C0[r+1]);b=MX3(b,C0[r+2],C0[r+3]);a=MX3(a,C1[r],C1[r+1]);b=MX3(b,C1[r+2],C1[r+3]);} \
      float rm=__builtin_fmaxf(a,b); { auto rr=__builtin_amdgcn_permlane32_swap(__float_as_uint(rm),__float_as_uint(rm),false,false); rm=__builtin_fmaxf(__uint_as_float(rr[0]),__uint_as_float(rr[1])); } \
      resc=false; \
      if(__builtin_expect(__any(rm>(float)THRL),0)){ const float dl=__builtin_fmaxf(rm,0.f); mhat+=dl; \
        _Pragma("unroll") for(int r=0;r<16;++r){C0[r]-=dl;C1[r]-=dl;} \
        _Pragma("unroll") for(int r=0;r<16;++r)negm[r]=-mhat; asm volatile("":"+v"(negm)); \
        const float f=__builtin_amdgcn_exp2f(-dl); l_reg*=f; if(hi==0)wsf[r32]=f; resc=true; } } \
    SBAR(); \
    GAPB(o[0]=__builtin_amdgcn_mfma_f32_32x32x16_bf16(PAF(0),VFR(0),o[0],0,0,0), C0,0); \
    GAPB(o[1]=__builtin_amdgcn_mfma_f32_32x32x16_bf16(PAF(0),VFR(4),o[1],0,0,0), C0,4); \
    KRD(GL,0); GAPB(o[0]=__builtin_amdgcn_mfma_f32_32x32x16_bf16(PAF(1),VFR(1),o[0],0,0,0), C0,8); \
    KRD(GL,1); GAPB(o[1]=__builtin_amdgcn_mfma_f32_32x32x16_bf16(PAF(1),VFR(5),o[1],0,0,0), C0,12); \
    KRD(GL,2); GAPB(o[0]=__builtin_amdgcn_mfma_f32_32x32x16_bf16(PAF(2),VFR(2),o[0],0,0,0), C1,0); \
    KRD(GL,3); GAPB(o[1]=__builtin_amdgcn_mfma_f32_32x32x16_bf16(PAF(2),VFR(6),o[1],0,0,0), C1,4); \
    GAPB(o[0]=__builtin_amdgcn_mfma_f32_32x32x16_bf16(PAF(3),VFR(3),o[0],0,0,0), C1,8); \
    GAPB(o[1]=__builtin_amdgcn_mfma_f32_32x32x16_bf16(PAF(3),VFR(7),o[1],0,0,0), C1,12); \
    }while(0)
  int t=1;
  #undef CMASK
  #define CMASK(P0,P1,t) do{}while(0)
  for(;t+5<NT;t+=2){
    STEP(pB0,pB1,pA0,pA1,t,true,true,true);     WAIT_BAR(2); RESC(); ROT();
    STEP(pA0,pA1,pB0,pB1,t+1,true,true,true);   WAIT_BAR(2); RESC(); ROT();
  }
  #undef CMASK
  #define CMASK(P0,P1,t) do{}while(0)
  #define ENDW(tt) do{ if((tt)+3<NT){WAIT_BAR(2);} else if((tt)+2<NT){WAIT_BAR(1);} else {WAIT_BAR(0);} }while(0)
  for(;t+1<NT;t+=2){
    STEP(pB0,pB1,pA0,pA1,t,(t+3<NT),(t+1<NT),(t+1<NT));       ENDW(t);   RESC(); ROT();
    STEP(pA0,pA1,pB0,pB1,t+1,(t+4<NT),(t+2<NT),(t+2<NT));     ENDW(t+1); RESC(); ROT();
  }
  STEP(pB0,pB1,pA0,pA1,NT-1,false,false,false); RESC();
  { float sacc=pB0[0]+pB0[1]; _Pragma("unroll") for(int r=2;r<16;++r)sacc+=pB0[r]; _Pragma("unroll") for(int r=0;r<16;++r)sacc+=pB1[r]; l_reg+=sacc;
    pw0=(u32x4){PKW(pB0,0),PKW(pB0,2),PKW(pB0,4),PKW(pB0,6)};pw1=(u32x4){PKW(pB0,8),PKW(pB0,10),PKW(pB0,12),PKW(pB0,14)};pw2=(u32x4){PKW(pB1,0),PKW(pB1,2),PKW(pB1,4),PKW(pB1,6)};pw3=(u32x4){PKW(pB1,8),PKW(pB1,10),PKW(pB1,12),PKW(pB1,14)};
    SBAR(); pv(o,vb0+sl_cur,PAF(0),PAF(1),PAF(2),PAF(3)); }
  #undef PKW
  #undef PAF
  #undef VFR
  #undef PIN
  #undef MX3
  #undef GAPA
  #undef GAPB
  #undef EX
  #undef VRD
  #undef KRD
  #undef STEP
  #undef ENDW
  {auto rr=__builtin_amdgcn_permlane32_swap(__float_as_uint(l_reg),__float_as_uint(l_reg),false,false);l_reg=__uint_as_float(rr[0])+__uint_as_float(rr[1]);}
  if(hi==0)wsf[32+r32]=l_reg;asm volatile("s_waitcnt lgkmcnt(0)":::"memory");
  float rli[16];
  #pragma unroll
  for(int r=0;r<16;++r)rli[r]=__builtin_amdgcn_rcpf(wsf[32+crow(r,hi)]);
  bf16*Ow=Oh+(long)(wid*QBLK)*OP;
  { bf16*stg=(bf16*)(shm+LDS_OST)+wid*2048;
    #pragma unroll
    for(int r=0;r<16;++r){const int orow=crow(r,hi);
      #pragma unroll
      for(int d0=0;d0<2;++d0)stg[orow*64+d0*32+r32]=__float2bfloat16(o[d0][r]*rli[r]);}
    asm volatile("s_waitcnt lgkmcnt(0)":::"memory");
    #pragma unroll
    for(int i=0;i<4;++i){const int row=i*8+(lane>>3),ch=lane&7; const u32x4 v=*(const u32x4*)(stg+row*64+ch*8); ATTN_STORE16(Ow+(long)row*OP+ch*8,v);} }
  asm volatile("s_waitcnt lgkmcnt(0)\n\ts_barrier":::"memory");
  #undef DMA_K
  #undef DMA_V
  #undef CMASK
  #undef START
  #undef RESC
  #undef ROT
}
#undef SBAR
#undef WAIT_BAR
}

__device__ __forceinline__ void attn_fast(const Params& p, int l, bool with_ctx, unsigned char* lds, int bid, int nb) {
    typedef attn_body::bf16 abf;
    const abf* P = (const abf*)(p.ws + WS_P); abf* Y = (abf*)(p.ws + WS_YMIX);
    float bound;
    { const int lane = threadIdx.x & 63; float gq = fabsf(p.in[21][l * 64 + lane]), gk = fabsf(p.in[22][l * 64 + lane]);
#pragma unroll
      for (int o = 1; o < 64; o <<= 1) { gq = fmaxf(gq, __shfl_xor(gq, o)); gk = fmaxf(gk, __shfl_xor(gk, o)); }
      bound = 64.f * gq * gk * C2 * 1.02f + 0.25f; }
    const bool fixref = bound < 40.f;
    const int nunits = with_ctx ? 520 : 512;
    for (int u = bid; u < nunits; u += nb) {
        int h, q0, k0, ntile;
        if (u < 512) { h = u >> 6; q0 = (u & 63) * 256; k0 = 0; ntile = R / 64; } else { h = u - 512; q0 = SEQ; k0 = SEQ; ntile = CTXL / 64; }
        const int kvh = h >> 2;
        const abf* Qh = P + (size_t)q0 * INC + C_AQ + h * 64; const abf* Kh = P + (size_t)k0 * INC + C_AK + kvh * 64; const abf* Vh = P + (size_t)k0 * INC + C_AV + kvh * 64; abf* Oh = Y + (size_t)q0 * D + 512 + h * 64;
        if (fixref) attn_body::attn_unit<8, true>(Qh, Kh, Vh, Oh, ntile, (char*)lds, bound);
        else attn_body::attn_unit<8, false>(Qh, Kh, Vh, Oh, ntile, (char*)lds, 0.f);
    }
}

__device__ __forceinline__ int moe_segments(const Params& p, int* seg  , int* tile_e  ) {
    const unsigned* cnt = (const unsigned*)(p.ws + WS_CTL) + CW_CNT;
    if (threadIdx.x == 0) { int s = 0; for (int e = 0; e < 8; ++e) { const int c = (int)cnt[e]; tile_e[284 + e] = c; seg[e] = s; s += ((c + 255) >> 8) << 8; } seg[8] = s; }
    __syncthreads();
    const int total = seg[8];
    for (int t = threadIdx.x; t < total / 128; t += NT) { int e = 0; while (t * 128 >= seg[e + 1]) ++e; tile_e[t] = e; }
    __syncthreads();
    return total;
}
__device__ __forceinline__ int moe_row(const Params& p, const int* seg, const int* tile_e, int s, float& gate) {
    const int e = tile_e[s >> 7], pos = s - seg[e];
    if (pos < tile_e[284 + e]) { gate = ((const float*)(p.ws + WS_ASGG))[e * SEQ + pos]; return ((const int*)(p.ws + WS_ASGT))[e * SEQ + pos]; }
    gate = 0.f; return -1;
}
__device__ __forceinline__ void ph_final(const Params& p, int bid, int nb) {
    const int lane = threadIdx.x & 63, wave = threadIdx.x >> 6;
    const bf16* Y2 = (const bf16*)(p.ws + WS_Y2); const float* g = p.in[31];
    const int rstride = nb * 8;
    for (int row0 = bid * 8 + wave; row0 < SEQ; row0 += 4 * rstride) {
        u32x2 xv[4][4], ya[4][4], yb[4][4];
#pragma unroll
        for (int k = 0; k < 4; ++k) { const int row = row0 + k * rstride;
            if (row < SEQ) { const u32x2* xr = (const u32x2*)xb_row(p, 3, row) + lane;
                const u32x2* pa = (const u32x2*)(Y2 + (size_t)(2 * row) * D) + lane; const u32x2* pb = (const u32x2*)(Y2 + (size_t)(2 * row + 1) * D) + lane;
#pragma unroll
                for (int j = 0; j < 4; ++j) { xv[k][j] = xr[64 * j]; ya[k][j] = pa[64 * j]; yb[k][j] = pb[64 * j]; } } }
#pragma unroll
        for (int k = 0; k < 4; ++k) { const int row = row0 + k * rstride;
            if (row >= SEQ) break;
            f32x4* xr = (f32x4*)(p.out + (size_t)row * D) + lane; const f32x4* m5 = (const f32x4*)mod_vec(p, 1, row, 5) + lane;
            f32x4 v[4]; float ss = 0.f;
            const int sp0 = __builtin_amdgcn_readfirstlane(((const int*)(p.ws + WS_SPLITROW))[2 * row]), sp1 = __builtin_amdgcn_readfirstlane(((const int*)(p.ws + WS_SPLITROW))[2 * row + 1]);
#pragma unroll
            for (int j = 0; j < 4; ++j) { const u32x2 a = ya[k][j], b = yb[k][j]; const f32x4 m = m5[64 * j];
                f32x4 y = (f32x4){lo16(a.x) + lo16(b.x), hi16(a.x) + hi16(b.x), lo16(a.y) + lo16(b.y), hi16(a.y) + hi16(b.y)};
#pragma unroll
                for (int e = 0; e < 2; ++e) { const int si = e ? sp1 : sp0;
                    if (si >= 0) {
#pragma unroll
                        for (int q = 0; q < 7; ++q) { const u32x2 w = ((const u32x2*)((const bf16*)(p.ws + WS_PART) + (size_t)(q * PART_ROWS + si) * D) + lane)[64 * j];
                            y += (f32x4){lo16(w.x), hi16(w.x), lo16(w.y), hi16(w.y)}; } } }
                v[j] = (f32x4){lo16(xv[k][j].x), hi16(xv[k][j].x), lo16(xv[k][j].y), hi16(xv[k][j].y)} + m * y; ss += (v[j].x * v[j].x + v[j].y * v[j].y) + (v[j].z * v[j].z + v[j].w * v[j].w); }
            const float r = rsqrtf(wave_sum(ss) * (1.f / D) + EPS);
#pragma unroll
            for (int j = 0; j < 4; ++j) xr[64 * j] = v[j] * r * ((const f32x4*)g)[lane + 64 * j];
        }
    }
}

#define LAS __attribute__((address_space(3)))
#define XB_TMO      128
#define XB_XCNT(j)  (256  + 64 * (j))
#define XB_XSUB(j)  (1280 + 64 * (j))
#define XB_XGEN(j)  (2304 + 64 * (j))
#define XB_TOP      3328
#define XB_TOPGEN   3392
#define XCD_BAR_WORDS 3456
#define XB_SPIN_CAP (1u << 18)
__device__ __forceinline__ unsigned xb_ld(unsigned* p)              { return __hip_atomic_load(p, __ATOMIC_RELAXED, __HIP_MEMORY_SCOPE_AGENT); }
__device__ __forceinline__ unsigned xb_add(unsigned* p, unsigned v) { return __hip_atomic_fetch_add(p, v, __ATOMIC_RELAXED, __HIP_MEMORY_SCOPE_AGENT); }
__device__ __forceinline__ unsigned xb_xcc_id() { return (unsigned)__builtin_amdgcn_s_getreg((3 << 11) | 20) & 0xFu; }
#define XB_SPIN(cond, bar) do { unsigned _sp = 0; while (cond) { __builtin_amdgcn_s_sleep(1); \
    if ((++_sp & 255u) == 0u) { if (xb_ld(&(bar)[XB_TMO])) break; if (_sp > XB_SPIN_CAP) { atomicAdd(&(bar)[XB_TMO], 1u); break; } } } } while (0)
struct XcdBarrier { unsigned* bar; unsigned x; volatile LAS unsigned* st; };
__device__ __forceinline__ XcdBarrier xcd_barrier_post(unsigned* bar, volatile LAS unsigned* st) {
    XcdBarrier b; b.bar = bar; b.x = xb_xcc_id(); b.st = st;
    if (threadIdx.x == 0) (void)xb_add(&bar[XB_XCNT(b.x)], 1u);
    return b;
}
__device__ __forceinline__ void xcd_barrier_complete(unsigned* bar, unsigned x, unsigned& nloc, unsigned& nx) {
    const unsigned G = gridDim.x * gridDim.y * gridDim.z;
    unsigned sum, cnt, mine, sp = 0u;
    for (;;) {
        sum = 0u; cnt = 0u; mine = 0u;
#pragma unroll
        for (unsigned j = 0; j < 16; ++j) { const unsigned c = xb_ld(&bar[XB_XCNT(j)]); sum += c; cnt += (c > 0u) ? 1u : 0u; mine = (j == x) ? c : mine; }
        if (sum == G) break;
        __builtin_amdgcn_s_sleep(1);
        if ((++sp & 255u) == 0u) { if (xb_ld(&bar[XB_TMO])) break; if (sp > XB_SPIN_CAP) { atomicAdd(&bar[XB_TMO], 1u); break; } }
    }
    nloc = mine > 0u ? mine : 1u; nx = cnt > 0u ? cnt : 1u;
}
__device__ __forceinline__ void xcd_barrier(const XcdBarrier& b) {
    asm volatile("s_waitcnt vmcnt(0)" ::: "memory");
    __syncthreads();
    if (threadIdx.x == 0) {
        unsigned* bar = b.bar;
        __builtin_amdgcn_s_waitcnt(0);
        unsigned nloc = b.st[0], nx = b.st[1];
        if (nloc == 0u) { xcd_barrier_complete(bar, b.x, nloc, nx); b.st[0] = nloc; b.st[1] = nx; }
        const unsigned old = xb_add(&bar[XB_XSUB(b.x)], 1u);
        const unsigned gen = old / nloc;
        if (old + 1u == (gen + 1u) * nloc) {
            __builtin_amdgcn_fence(__ATOMIC_RELEASE, "agent");
            asm volatile("s_waitcnt vmcnt(0)" ::: "memory");
            const unsigned og = xb_add(&bar[XB_TOP], 1u);
            const unsigned tg = og / nx;
            if (og + 1u == (tg + 1u) * nx) xb_add(&bar[XB_TOPGEN], 1u);
            else XB_SPIN(xb_ld(&bar[XB_TOPGEN]) == tg, bar);
            __builtin_amdgcn_fence(__ATOMIC_ACQUIRE, "agent");
            xb_add(&bar[XB_XGEN(b.x)], 1u);
            asm volatile("s_waitcnt vmcnt(0)" ::: "memory");
        } else {
            XB_SPIN(xb_ld(&bar[XB_XGEN(b.x)]) == gen, bar);
            __builtin_amdgcn_fence(__ATOMIC_ACQUIRE, "agent");
            asm volatile("s_waitcnt vmcnt(0)" ::: "memory");
        }
    }
    __syncthreads();
}

constexpr int LDS_BYTES = 147456;
constexpr int LDS_MISC = 131072 + 8192;
constexpr int NPHASE = 21;

__global__ void __launch_bounds__(NT, 2) k_run(Params p) {
    extern __shared__ __attribute__((aligned(16))) unsigned char lds[];
    float* sm = (float*)lds;
    const int bid = blockIdx.x, nb = gridDim.x;
    volatile LAS unsigned* misc = (volatile LAS unsigned*)((LAS unsigned char*)lds + LDS_MISC);
    if (threadIdx.x < 16) misc[threadIdx.x] = 0u;
    __syncthreads();
    XcdBarrier bar; bar.bar = (unsigned*)(p.ws + WS_CTL) + CW_BAR; bar.x = 0; bar.st = nullptr;
    if (p.ph_hi - p.ph_lo > 1) bar = xcd_barrier_post((unsigned*)(p.ws + WS_CTL) + CW_BAR, misc + 8);
    const int lo = p.ph_lo, hi = p.ph_hi;
#ifndef ONLY_PH
#define ONLY_PH -1
#endif
#define IN(k) ((ONLY_PH < 0 || ONLY_PH == (k)) && lo <= (k) && (k) < hi)
#define SEAM(k) do { if (IN(k) && IN((k) + 1)) { asm volatile("s_waitcnt vmcnt(0)" ::: "memory"); xcd_barrier(bar); } } while (0)
#ifndef PROBE_LO
#define PROBE_LO -1
#define PROBE_HI -1
#endif
#ifndef PROBE_MULT
#define PROBE_MULT 4
#endif
    unsigned long long pt0 = 0ull, pt1 = 0ull;
#ifdef PROBE_SUB
#define SUBSTAMP(k) do { xcd_barrier(bar); STAMP(k); } while (0)
#else
#define SUBSTAMP(k) do {} while (0)
#endif
#define STAMP(k) do { if ((k) == PROBE_LO && threadIdx.x == 0) *(volatile unsigned long long*)(lds + LDS_MISC + 96) = wall_clock64(); if ((k) == PROBE_HI && threadIdx.x == 0) *(volatile unsigned long long*)(lds + LDS_MISC + 104) = wall_clock64(); } while (0)

    STAMP(0); if (IN(0)) { ph_mod(p, sm, bid, nb); ph_tw(p, bid, nb); __syncthreads();
#ifdef PROBE_SUB
        xcd_barrier(bar); STAMP(100);
#endif
        ph_filt(p, sm, bid, nb); __syncthreads();
#ifdef PROBE_SUB
        xcd_barrier(bar); STAMP(101);
#endif
        ph_wconv(p, sm, 0, WCONV_DENSE, bid, nb); } SEAM(0);
    STAMP(1); if (IN(1)) { ph_hfft(p, sm, (float*)(lds + LDS_MISC + 128), bid, nb); ph_norm(p, 0, 0, 0, R, false, bid, nb); } SEAM(1);
    STAMP(2); if (IN(2)) { PgEpiP E{(bf16*)(p.ws + WS_P), INC}; run_gemm(lds, (const bf16*)(p.ws + WS_H), (const bf16*)(p.ws + WS_WIN), R, INC, D, E, nullptr, 0, bid, nb);
        wconv_in_tail(p, sm, (R / 256) * (INC / 256), WCONV_DENSE, WCONV_DENSE + 472, bid, nb); } SEAM(2);
    STAMP(3); if (IN(3)) { prep_qk(p, 0, R, sm, bid, nb); SUBSTAMP(110); prep_hyz(p, 0, true, sm, bid, nb); SUBSTAMP(111); prep_retu(p, 0, lds, bid, nb); } SEAM(3);
    STAMP(4); if (IN(4)) { ph_retscan(p, 0, sm, bid, nb);
        for (int u = bid; u < 512; u += nb) { if (u < 256) hconv_unit(p, 0, u, sm); else { const int cu = u - 256;
            if (cu >= 8) hconv_ctx_unit(p, cu, sm); if (cu >= 8 && cu < 16) hconv_ctx_unit(p, cu - 8, sm); } }
        attn_fast(p, 0, true, lds, bid, nb); } SEAM(4);
    STAMP(5); if (IN(5)) { post_ret(p, 0, NCH, lds, bid, nb); SUBSTAMP(120); post_hy(p, 0, true, sm, bid, nb); } SEAM(5);
    STAMP(6); if (IN(6)) { PgEpiRes E{&p, 0, 2, 0, 1}; run_gemm(lds, (const bf16*)(p.ws + WS_YMIX), (const bf16*)(p.ws + WS_WOUT), R, D, D, E, nullptr, 0, bid, nb);
        wconv_in_tail(p, sm, (R / 256) * (D / 256), WCONV_DENSE + 472, WCONV_DENSE + 472 + 1008, bid, nb); } SEAM(6);
    STAMP(7); if (IN(7)) { ph_norm(p, 0, 1, 1, R, false, bid, nb); } SEAM(7);
    STAMP(8); if (IN(8)) { PgEpiSwi E{(bf16*)(p.ws + WS_HID)}; run_gemm(lds, (const bf16*)(p.ws + WS_H), (const bf16*)(p.ws + WS_WGU), R, 2 * FF, D, E, nullptr, 0, bid, nb); } SEAM(8);
    STAMP(9); if (IN(9)) { PgEpiRes E{&p, 0, 5, 1, 1}; run_gemm(lds, (const bf16*)(p.ws + WS_HID), (const bf16*)(p.ws + WS_WDN), R, D, FF, E, nullptr, 0, bid, nb);
        wconv_in_tail(p, sm, (R / 256) * (D / 256), WCONV_DENSE + 472 + 1008, WCONV_ALL, bid, nb); } SEAM(9);
    STAMP(10); if (IN(10)) { ph_norm(p, 1, 0, 1, R, false, bid, nb); } SEAM(10);
    STAMP(11); if (IN(11)) { PgEpiP E{(bf16*)(p.ws + WS_P), INC}; run_gemm(lds, (const bf16*)(p.ws + WS_H), (const bf16*)(p.ws + WS_WIN) + (size_t)INC * D, R, INC, D, E, nullptr, 0, bid, nb); } SEAM(11);
    STAMP(12); if (IN(12)) { prep_qk(p, 1, R, sm, bid, nb); prep_hyz(p, 1, false, sm, bid, nb); prep_retu(p, 1, lds, bid, nb); } SEAM(12);
    STAMP(13); if (IN(13)) { ph_retscan(p, 1, sm, bid, nb);
        for (int u = bid; u < 256; u += nb) hconv_unit(p, 1, u, sm);
        attn_fast(p, 1, false, lds, bid, nb); } SEAM(13);
    STAMP(14); if (IN(14)) { post_ret(p, 1, 128, lds, bid, nb); post_hy(p, 1, false, sm, bid, nb); } SEAM(14);
    STAMP(15); if (IN(15)) { PgEpiRes E{&p, 1, 2, 1, 3}; run_gemm(lds, (const bf16*)(p.ws + WS_YMIX), (const bf16*)(p.ws + WS_WOUT) + (size_t)D * D, SEQ, D, D, E, nullptr, 0, bid, nb); } SEAM(15);
    STAMP(16); if (IN(16)) { ph_norm(p, 1, 1, 3, SEQ, true, bid, nb, sm, WS_H2);
        if (bid == 0) ((u32x4*)((bf16*)(p.ws + WS_H2) + (size_t)SEQ * D))[threadIdx.x & 127] = (u32x4){0u, 0u, 0u, 0u}; } SEAM(16);
    STAMP(17);
    STAMP(18); if (IN(18)) { int* ism = (int*)(lds + LDS_MISC + 256); const int total = moe_segments(p, ism, ism + 16);
        for (int i = bid * NT + threadIdx.x; i < 2 * SEQ; i += nb * NT) ((int*)(p.ws + WS_SPLITROW))[i] = -1;
        PgEpiSwi E{(bf16*)(p.ws + WS_HIDM)}; run_gemm_gather(lds, (const bf16*)(p.ws + WS_H2), (const bf16*)(p.ws + WS_MOEW), total, 2 * FF, D, E, ism + 16, MOEW_E * 2, p, ism, bid, nb); } SEAM(18);
    STAMP(19); if (IN(19)) { int* ism = (int*)(lds + LDS_MISC + 256); const int total = moe_segments(p, ism, ism + 16);
        run_gemm_moedown(lds, (const bf16*)(p.ws + WS_HIDM), (const bf16*)(p.ws + WS_MOEW) + (size_t)5632 * 1024, total, D, FF, (bf16*)(p.ws + WS_Y2), ism + 16, MOEW_E * 2, p, ism, bid, nb); } SEAM(19);
    STAMP(20); if (IN(20)) { ph_final(p, bid, nb); }
STAMP(21);
    if (PROBE_LO >= 0 && bid == 0 && threadIdx.x == 0) { pt0 = *(volatile unsigned long long*)(lds + LDS_MISC + 96); pt1 = *(volatile unsigned long long*)(lds + LDS_MISC + 104); const unsigned long long te = wall_clock64(), dt = (pt1 - pt0) * PROBE_MULT; while (wall_clock64() - te < dt) __builtin_amdgcn_s_sleep(8); }
#undef IN
#undef SEAM
}

extern "C" void kernel_launch(void* const* d_in, const int* in_sizes, int n_in, void* d_out, int out_size, void* d_ws, size_t ws_size, hipStream_t stream) {
    static int grid = 0;
    if (grid == 0) {
        if (n_in != 32 || out_size != SEQ * D || ws_size < WS_END) { fprintf(stderr, "kernel_launch: unexpected problem (n_in %d out %d ws %zu)\n", n_in, out_size, ws_size); grid = -1; return; }
        int dev = 0, cus = 0;
        if (hipGetDevice(&dev) != hipSuccess || hipDeviceGetAttribute(&cus, hipDeviceAttributeMultiprocessorCount, dev) != hipSuccess) { grid = -1; return; }
        if (hipFuncSetAttribute((const void*)k_run, hipFuncAttributeMaxDynamicSharedMemorySize, LDS_BYTES) != hipSuccess) { fprintf(stderr, "kernel_launch: LDS attribute failed\n"); grid = -1; return; }
        int per_cu = 0; (void)hipOccupancyMaxActiveBlocksPerMultiprocessor(&per_cu, (const void*)k_run, NT, LDS_BYTES); (void)hipGetLastError();
        grid = cus > 0 ? cus : 256;
    }
    if (grid < 0) return;
    (void)hipMemsetAsync((char*)d_ws + WS_CTL, 0, 65536, stream);
    Params p; memset(&p, 0, sizeof(p));
    for (int i = 0; i < 32; ++i) p.in[i] = (const float*)d_in[i];
    p.out = (float*)d_out; p.ws = (unsigned char*)d_ws;
#if N_LAUNCH_MODE == 1
    p.ph_lo = 0; p.ph_hi = NPHASE;
    hipLaunchKernelGGL(k_run, dim3(grid), dim3(NT), LDS_BYTES, stream, p);
#else
    for (int ph = 0; ph < NPHASE; ++ph) { p.ph_lo = ph; p.ph_hi = ph + 1; hipLaunchKernelGGL(k_run, dim3(grid), dim3(NT), LDS_BYTES, stream, p); }
#endif
}
```
